# Optimizing an MI355X kernel written in HIP

```python
import math
import jax
import jax.numpy as jnp
from jax import lax
import numpy as np

D_MODEL = 1024
BATCH = 8
SEQ = 4096
DEPTH = 4

CHUNK = 64
Q_BLOCK = 128
NORM_EPS = 1e-6

DA_HEADS = 4
DA_HEAD_DIM = 64
DA_V_DIM = 2 * DA_HEAD_DIM
DA_WIDTH = DA_HEADS * DA_V_DIM
ROT_DIM = DA_HEAD_DIM // 4
ROPE_THETA = 500000.0

SSM_GROUP = 16
SSM_GROUPS = 16
SSM_WIDTH = SSM_GROUP * SSM_GROUPS
SSM_STATE = 64

RW_HEADS = 4
RW_HEAD_DIM = 64
RW_WIDTH = RW_HEADS * RW_HEAD_DIM
RW_DECAY_RANK = 32
RW_AAA_RANK = 32
RW_GATE_RANK = 64
RW_LN_EPS = 64e-5

MIX_WIDTH = DA_WIDTH + SSM_WIDTH + RW_WIDTH
DA_COLS = 3 * DA_WIDTH
RW_COLS = 3 * RW_WIDTH + RW_DECAY_RANK + RW_AAA_RANK + RW_GATE_RANK
IN_COLS = DA_COLS + SSM_WIDTH + RW_COLS

PEER_HEADS = 8
N_KEYS = 128
N_EXPERTS = N_KEYS * N_KEYS
PEER_KEY_DIM = 128
PEER_TOPK = 16
PEER_TOKEN_BLOCK = 128

kernel_name = 'hybrid_diffattn_s5_rwkv7_peer'


def rms_norm(x, g, eps=NORM_EPS):
    xf = x.astype(jnp.float32)
    y = xf * lax.rsqrt(jnp.mean(xf * xf, axis=-1, keepdims=True) + eps)
    return (y * g.astype(jnp.float32)).astype(x.dtype)


def partial_rope(t, cos, sin):
    half = ROT_DIM // 2
    c = cos[:, :, None, None, :].astype(t.dtype)
    s = sin[:, :, None, None, :].astype(t.dtype)
    r1, r2, rest = t[..., :half], t[..., half:ROT_DIM], t[..., ROT_DIM:]
    return jnp.concatenate([r1 * c - r2 * s, r2 * c + r1 * s, rest], axis=-1)


def diff_attention(cols, cos, sin, q_norm, k_norm, lam, subln, layer):
    bsz, seq, _ = cols.shape
    dt = cols.dtype
    q = cols[..., :DA_WIDTH].reshape(bsz, seq, DA_HEADS, 2, DA_HEAD_DIM)
    k = cols[..., DA_WIDTH:2 * DA_WIDTH].reshape(bsz, seq, DA_HEADS, 2, DA_HEAD_DIM)
    v = cols[..., 2 * DA_WIDTH:].reshape(bsz, seq, DA_HEADS, DA_V_DIM)
    q = partial_rope(rms_norm(q, q_norm), cos, sin)
    k = partial_rope(rms_norm(k, k_norm), cos, sin)
    lam_init = 0.8 - 0.6 * math.exp(-0.3 * layer)
    lf = lam.astype(jnp.float32)
    lam_full = jnp.exp(jnp.sum(lf[0] * lf[1])) - jnp.exp(jnp.sum(lf[2] * lf[3])) + lam_init
    scale = DA_HEAD_DIM ** -0.5
    outs = []
    for blk in range(seq // Q_BLOCK):
        q0 = blk * Q_BLOCK
        kv_end = q0 + Q_BLOCK
        s = jnp.einsum('bqhmd,bkhmd->bhmqk', q[:, q0:kv_end], k[:, :kv_end]).astype(jnp.float32) * scale
        q_chunk = (q0 + jnp.arange(Q_BLOCK)) // CHUNK
        k_chunk = jnp.arange(kv_end) // CHUNK
        s = jnp.where(k_chunk[None, :] <= q_chunk[:, None], s, -jnp.inf)
        p = jax.nn.softmax(s, axis=-1)
        a = p[:, :, 0] - lam_full * p[:, :, 1]
        outs.append(jnp.einsum('bhqk,bkhe->bqhe', a.astype(dt), v[:, :kv_end]))
    o = jnp.concatenate(outs, axis=1)
    o = rms_norm(o, subln) * (1.0 - lam_init)
    return o.reshape(bsz, seq, DA_WIDTH)


def _complex_affine_combine(e1, e2):
    a1r, a1i, b1r, b1i = e1
    a2r, a2i, b2r, b2i = e2
    ar = a2r * a1r - a2i * a1i
    ai = a2r * a1i + a2i * a1r
    br = a2r * b1r - a2i * b1i + b2r
    bi = a2r * b1i + a2i * b1r + b2i
    return (ar, ai, br, bi)


def s5_mixer(u, lam_re, lam_im, b_re, b_im, c_re, c_im, d_skip, log_dt, w_glu, b_glu, out_norm):
    bsz, seq, _ = u.shape
    f32 = jnp.float32
    uf = u.astype(f32).reshape(bsz, seq, SSM_GROUPS, SSM_GROUP)
    lr = jnp.minimum(lam_re.astype(f32), -1e-4)
    li = lam_im.astype(f32)
    step = jnp.exp(log_dt.astype(f32))[:, None]
    mag = jnp.exp(lr * step)
    abar_re = mag * jnp.cos(li * step)
    abar_im = mag * jnp.sin(li * step)
    den = lr * lr + li * li
    coef_re = ((abar_re - 1.0) * lr + abar_im * li) / den
    coef_im = (abar_im * lr - (abar_re - 1.0) * li) / den
    br, bi = b_re.astype(f32), b_im.astype(f32)
    bbar_re = coef_re[..., None] * br - coef_im[..., None] * bi
    bbar_im = coef_re[..., None] * bi + coef_im[..., None] * br
    bu_re = jnp.einsum('blgh,gph->lbgp', uf, bbar_re)
    bu_im = jnp.einsum('blgh,gph->lbgp', uf, bbar_im)
    a_re = jnp.broadcast_to(abar_re[None, None], (seq, 1, SSM_GROUPS, SSM_STATE))
    a_im = jnp.broadcast_to(abar_im[None, None], (seq, 1, SSM_GROUPS, SSM_STATE))
    _, _, xr, xi = lax.associative_scan(_complex_affine_combine, (a_re, a_im, bu_re, bu_im), axis=0)
    y = (jnp.einsum('lbgp,ghp->blgh', xr, c_re.astype(f32))
         - jnp.einsum('lbgp,ghp->blgh', xi, c_im.astype(f32))
         + d_skip.astype(f32) * uf)
    yg = jax.nn.gelu(y.reshape(bsz, seq, SSM_WIDTH), approximate=False)
    out = yg * jax.nn.sigmoid(yg @ w_glu.astype(f32) + b_glu.astype(f32))
    return rms_norm(out, out_norm).astype(u.dtype)


def rwkv7_mixer(cols, mu, decay_up, decay_w0, aaa_up, aaa_a0, gate_up, k_k, k_a, r_k, ln_w, ln_b):
    bsz, seq, _ = cols.shape
    f32 = jnp.float32
    c = cols.astype(f32)
    prev = jnp.pad(c, ((0, 0), (1, 0), (0, 0)))[:, :-1]
    c = c + (prev - c) * mu.astype(f32)
    o1, o2, o3 = RW_WIDTH, 2 * RW_WIDTH, 3 * RW_WIDTH
    o4, o5 = o3 + RW_DECAY_RANK, o3 + RW_DECAY_RANK + RW_AAA_RANK
    r, k, v = c[..., :o1], c[..., o1:o2], c[..., o2:o3]
    wd, ad, gd = c[..., o3:o4], c[..., o4:o5], c[..., o5:]
    w_log = -jax.nn.softplus(-(decay_w0.astype(f32) + jnp.tanh(wd) @ decay_up.astype(f32))) - 0.5
    decay = jnp.exp(-jnp.exp(w_log))
    a = jax.nn.sigmoid(aaa_a0.astype(f32) + ad @ aaa_up.astype(f32))
    g = jax.nn.sigmoid(gd) @ gate_up.astype(f32)
    heads = lambda t: t.reshape(bsz, seq, RW_HEADS, RW_HEAD_DIM)
    kk = heads(k * k_k.astype(f32))
    kk = kk / jnp.maximum(jnp.sqrt(jnp.sum(kk * kk, axis=-1, keepdims=True)), 1e-12)
    k = k * (1.0 + (a - 1.0) * k_a.astype(f32))
    r, k, v, decay, a = heads(r), heads(k), heads(v), heads(decay), heads(a)
    bvec = kk * a

    def step(S, inp):
        r_t, w_t, k_t, v_t, kk_t, b_t = inp
        sa = jnp.einsum('bhij,bhj->bhi', S, -kk_t)
        S = S * w_t[:, :, None, :] + sa[..., None] * b_t[:, :, None, :] + v_t[..., None] * k_t[:, :, None, :]
        return S, jnp.einsum('bhij,bhj->bhi', S, r_t)

    xs = tuple(jnp.moveaxis(t, 1, 0) for t in (r, decay, k, v, kk, bvec))
    S0 = jnp.zeros((bsz, RW_HEADS, RW_HEAD_DIM, RW_HEAD_DIM), f32)
    _, y = lax.scan(step, S0, xs)
    y = jnp.moveaxis(y, 0, 1)
    mean = jnp.mean(y, axis=-1, keepdims=True)
    var = jnp.mean(jnp.square(y - mean), axis=-1, keepdims=True)
    y = ((y - mean) * lax.rsqrt(var + RW_LN_EPS)).reshape(bsz, seq, RW_WIDTH)
    y = y * ln_w.astype(f32) + ln_b.astype(f32)
    bonus = jnp.sum(r * k * r_k.astype(f32), axis=-1, keepdims=True) * v
    y = y + bonus.reshape(bsz, seq, RW_WIDTH)
    return (y * g).astype(cols.dtype)


def peer_ffn(h, w_q, sub_keys, u_tab, v_tab):
    bsz, seq, dm = h.shape
    blocks = h.reshape(bsz * seq // PEER_TOKEN_BLOCK, PEER_TOKEN_BLOCK, dm)

    def block_fn(hb):
        q = (hb @ w_q).reshape(PEER_TOKEN_BLOCK, PEER_HEADS, 2, PEER_KEY_DIM)
        s = jnp.einsum('thmd,hmkd->thmk', q, sub_keys).astype(jnp.float32)
        top_s, top_i = lax.top_k(s, PEER_TOPK)
        cand_s = top_s[:, :, 0, :, None] + top_s[:, :, 1, None, :]
        cand_i = top_i[:, :, 0, :, None] * N_KEYS + top_i[:, :, 1, None, :]
        cand_s = cand_s.reshape(PEER_TOKEN_BLOCK, PEER_HEADS, PEER_TOPK * PEER_TOPK)
        cand_i = cand_i.reshape(PEER_TOKEN_BLOCK, PEER_HEADS, PEER_TOPK * PEER_TOPK)
        best_s, best_pos = lax.top_k(cand_s, PEER_TOPK)
        expert = jnp.take_along_axis(cand_i, best_pos, axis=-1)
        gate = jax.nn.softmax(best_s, axis=-1)
        u_sel = jnp.take(u_tab, expert, axis=0)
        act = jax.nn.gelu(jnp.einsum('thkd,td->thk', u_sel, hb).astype(jnp.float32), approximate=False)
        v_sel = jnp.take(v_tab, expert, axis=0)
        return jnp.einsum('thk,thkd->td', (gate * act).astype(hb.dtype), v_sel)

    return lax.map(block_fn, blocks).reshape(bsz, seq, dm)


def setup_inputs(seed: int = 0) -> dict:
    key = jax.random.key(seed)
    keys = list(jax.random.split(key, 48))
    f32 = jnp.float32

    def nxt():
        return keys.pop()

    def nrm(shape, scale):
        return jax.random.normal(nxt(), shape, f32) * scale

    def gain(shape):
        return 1.0 + nrm(shape, 0.02)

    x = nrm((BATCH, SEQ, D_MODEL), 1.0)
    offs = jax.random.randint(nxt(), (BATCH, 1), 0, 64, dtype=jnp.int32) * CHUNK
    positions = (offs + jnp.arange(SEQ, dtype=jnp.int32)[None, :]).astype(jnp.int32)
    n_idx = jnp.arange(SSM_STATE, dtype=f32)
    decay_base = jnp.tile(jnp.linspace(-6.0, -1.0, RW_HEAD_DIM, dtype=f32), RW_HEADS)
    return {
        'x': x,
        'positions': positions,
        'norm_mix': gain((DEPTH, D_MODEL)),
        'w_in': nrm((DEPTH, D_MODEL, IN_COLS), D_MODEL ** -0.5),
        'da_q_norm': gain((DEPTH, DA_HEADS, 2, DA_HEAD_DIM)),
        'da_k_norm': gain((DEPTH, DA_HEADS, 2, DA_HEAD_DIM)),
        'da_lambda': nrm((DEPTH, 4, DA_HEAD_DIM), 0.1),
        'da_subln': gain((DEPTH, DA_V_DIM)),
        'ssm_lambda_re': -0.5 + nrm((DEPTH, SSM_GROUPS, SSM_STATE), 0.01),
        'ssm_lambda_im': math.pi * n_idx + nrm((DEPTH, SSM_GROUPS, SSM_STATE), 0.01),
        'ssm_b_re': nrm((DEPTH, SSM_GROUPS, SSM_STATE, SSM_GROUP), (2 * SSM_GROUP) ** -0.5),
        'ssm_b_im': nrm((DEPTH, SSM_GROUPS, SSM_STATE, SSM_GROUP), (2 * SSM_GROUP) ** -0.5),
        'ssm_c_re': nrm((DEPTH, SSM_GROUPS, SSM_GROUP, SSM_STATE), (2 * SSM_STATE) ** -0.5),
        'ssm_c_im': nrm((DEPTH, SSM_GROUPS, SSM_GROUP, SSM_STATE), (2 * SSM_STATE) ** -0.5),
        'ssm_d': nrm((DEPTH, SSM_GROUPS, SSM_GROUP), 1.0),
        'ssm_log_dt': jax.random.uniform(nxt(), (DEPTH, SSM_GROUPS), f32, math.log(1e-3), math.log(1e-1)),
        'ssm_w_glu': nrm((DEPTH, SSM_WIDTH, SSM_WIDTH), SSM_WIDTH ** -0.5),
        'ssm_b_glu': nrm((DEPTH, SSM_WIDTH), 0.02),
        'ssm_out_norm': gain((DEPTH, SSM_WIDTH)),
        'rw_mu': jax.random.uniform(nxt(), (DEPTH, RW_COLS), f32, 0.0, 1.0),
        'rw_decay_up': nrm((DEPTH, RW_DECAY_RANK, RW_WIDTH), 0.1),
        'rw_decay_w0': decay_base + nrm((DEPTH, RW_WIDTH), 0.1),
        'rw_aaa_up': nrm((DEPTH, RW_AAA_RANK, RW_WIDTH), 0.1),
        'rw_aaa_a0': nrm((DEPTH, RW_WIDTH), 0.1),
        'rw_gate_up': nrm((DEPTH, RW_GATE_RANK, RW_WIDTH), RW_GATE_RANK ** -0.5),
        'rw_k_k': 0.85 + nrm((DEPTH, RW_WIDTH), 0.02),
        'rw_k_a': gain((DEPTH, RW_WIDTH)),
        'rw_r_k': nrm((DEPTH, RW_HEADS, RW_HEAD_DIM), 0.1),
        'rw_ln_w': gain((DEPTH, RW_WIDTH)),
        'rw_ln_b': nrm((DEPTH, RW_WIDTH), 0.02),
        'w_out': nrm((DEPTH, MIX_WIDTH, D_MODEL), MIX_WIDTH ** -0.5),
        'norm_ffn': gain((DEPTH, D_MODEL)),
        'peer_w_q': nrm((DEPTH, D_MODEL, PEER_HEADS * 2 * PEER_KEY_DIM), D_MODEL ** -0.5),
        'peer_sub_keys': nrm((DEPTH, PEER_HEADS, 2, N_KEYS, PEER_KEY_DIM), PEER_KEY_DIM ** -0.5),
        'peer_u': nrm((DEPTH, N_EXPERTS, D_MODEL), D_MODEL ** -0.5),
        'peer_v': nrm((DEPTH, N_EXPERTS, D_MODEL), PEER_TOPK ** -0.5),
    }


def reference(x, positions, norm_mix, w_in, da_q_norm, da_k_norm, da_lambda, da_subln,
              ssm_lambda_re, ssm_lambda_im, ssm_b_re, ssm_b_im, ssm_c_re, ssm_c_im, ssm_d,
              ssm_log_dt, ssm_w_glu, ssm_b_glu, ssm_out_norm, rw_mu, rw_decay_up, rw_decay_w0,
              rw_aaa_up, rw_aaa_a0, rw_gate_up, rw_k_k, rw_k_a, rw_r_k, rw_ln_w, rw_ln_b,
              w_out, norm_ffn, peer_w_q, peer_sub_keys, peer_u, peer_v):
    inv_freq = ROPE_THETA ** (-jnp.arange(0, ROT_DIM, 2, dtype=jnp.float32) / ROT_DIM)
    ang = positions.astype(jnp.float32)[..., None] * inv_freq
    cos, sin = jnp.cos(ang), jnp.sin(ang)
    for l in range(DEPTH):
        h = rms_norm(x, norm_mix[l])
        cols = h @ w_in[l]
        cols_a = cols[..., :DA_COLS]
        cols_b = cols[..., DA_COLS:DA_COLS + SSM_WIDTH]
        cols_c = cols[..., DA_COLS + SSM_WIDTH:]
        y_a = diff_attention(cols_a, cos, sin, da_q_norm[l], da_k_norm[l], da_lambda[l], da_subln[l], l)
        y_b = s5_mixer(cols_b, ssm_lambda_re[l], ssm_lambda_im[l], ssm_b_re[l], ssm_b_im[l],
                       ssm_c_re[l], ssm_c_im[l], ssm_d[l], ssm_log_dt[l], ssm_w_glu[l],
                       ssm_b_glu[l], ssm_out_norm[l])
        y_c = rwkv7_mixer(cols_c, rw_mu[l], rw_decay_up[l], rw_decay_w0[l], rw_aaa_up[l],
                          rw_aaa_a0[l], rw_gate_up[l], rw_k_k[l], rw_k_a[l], rw_r_k[l],
                          rw_ln_w[l], rw_ln_b[l])
        mixed = jnp.concatenate([y_a.astype(x.dtype), y_b.astype(x.dtype), y_c.astype(x.dtype)], axis=-1)
        x = x + mixed @ w_out[l]
        x = x + peer_ffn(rms_norm(x, norm_ffn[l]), peer_w_q[l], peer_sub_keys[l], peer_u[l], peer_v[l])
    return x
```

```cpp
#include <hip/hip_runtime.h>
#include <cstdio>
#include <cstdint>

#ifndef MK_ONE_LAUNCH
#define MK_ONE_LAUNCH 0
#endif
#ifndef MK_DEBUG
#define MK_DEBUG 0
#endif
#ifndef MK_DBG_LAYER
#define MK_DBG_LAYER 0
#endif
#ifndef MK_DBG_SET
#define MK_DBG_SET 5,6,7,13,14,4
#endif
namespace pg8 {
#define PG8_LAS __attribute__((address_space(3)))
typedef unsigned short bf16_t;
typedef short bf16x8 __attribute__((ext_vector_type(8)));
typedef float f32x4 __attribute__((ext_vector_type(4)));
typedef unsigned u32x4 __attribute__((ext_vector_type(4)));
constexpr int BM = 256, BK = 64, HALF = 128, HTB = HALF * BK * 2  , STAGE_BYTES = 8 * HTB, NXCD = 8, WGM = 8;

__host__ __device__ __forceinline__ int lds_byte(int r, int c) { const int st = (r >> 4) * 2 + (c >> 5), rr = r & 15, cc = c & 31, ob = rr * 64 + cc * 2; return st * 1024 + (ob ^ (((ob >> 9) & 1) << 5)); }
__host__ __device__ __forceinline__ void stage_rc(int b, int& R, int& C) { const int st = b / 1024, sb = b % 1024, swz = sb ^ (((sb >> 9) & 1) << 5); R = (st >> 1) * 16 + swz / 64; C = (st & 1) * 32 + (swz % 64) / 2; }
__host__ __device__ __forceinline__ int perm32(int rho) { const int n = rho >> 4, i = rho & 15; return 8 * (i >> 2) + 4 * n + (i & 3); }

struct Unit { int pm, pn; };
struct Gemm { const bf16_t* A; const bf16_t* Bt; int M, N, K; };

struct StaticOrder {
    int nM, nN, nwg, G, c;
    __host__ __device__ void init(int M, int N, int G_, int c_) { nM = M / BM; nN = N / BM; nwg = nM * nN; G = G_; c = c_; }
    __host__ __device__ bool next(int i, Unit& u) const {
        const long L = (long)i * G + c; if (L >= nwg) return false;
        int wgid = (int)L; { const int q = nwg / NXCD, r = nwg % NXCD, xcd = wgid % NXCD, off = wgid / NXCD; wgid = (xcd < r ? xcd * (q + 1) : r * (q + 1) + (xcd - r) * q) + off; }
        const int nig = WGM * nN, gid = wgid / nig, fm = gid * WGM, gsz = (nM - fm) < WGM ? (nM - fm) : WGM;
        u.pm = fm + ((wgid % nig) % gsz); u.pn = (wgid % nig) / gsz; return true;
    }
    __device__ __forceinline__ void a_ready(const Unit&) const {}
    __device__ __forceinline__ void done(const Unit&) const {}
};

__device__ __forceinline__ unsigned cvt_pk_bf16(float lo, float hi) { unsigned r; asm volatile("v_cvt_pk_bf16_f32 %0, %1, %2" : "=v"(r) : "v"(lo), "v"(hi)); return r; }
typedef float f32x2 __attribute__((ext_vector_type(2)));
__device__ __forceinline__ f32x2 gelu_pk(f32x2 v) {
    const f32x2 av = __builtin_elementwise_abs(v), d = av * 0.2316418882f + 1.0f;
    f32x2 t; t.x = __builtin_amdgcn_rcpf(d.x); t.y = __builtin_amdgcn_rcpf(d.y);
    f32x2 q = t * 0.5307027145f + (-0.7265760135f); q = q * t + 0.7107068705f; q = q * t + (-0.142248368f); q = q * t + 0.127414796f; q = q * t;
    const f32x2 s = (v * v) * (-0.72134752044f);
    f32x2 e; e.x = __builtin_amdgcn_exp2f(s.x); e.y = __builtin_amdgcn_exp2f(s.y);
    const f32x2 m = v * (q * e), r = v - m;
    f32x2 o; o.x = v.x < 0.f ? m.x : r.x; o.y = v.y < 0.f ? m.y : r.y; return o;
}

struct EpiF32 {
    static constexpr bool PERM = false, AFTER_DRAIN = false;
    float* C; int ldc; const float* bias;
    __device__ __forceinline__ void operator()(const f32x4 (&acc)[2][2][4][2], const Unit& u, int wr, int wc, int fr, int fq) const {
        const int row0 = u.pm * BM + wr * 64 + fr, col0 = u.pn * BM + wc * 32 + 4 * fq;
        f32x4 bv[2][2];
#pragma unroll
        for (int bj = 0; bj < 2; ++bj)
#pragma unroll
            for (int n = 0; n < 2; ++n) bv[bj][n] = bias ? *(const f32x4*)(bias + col0 + bj * HALF + n * 16) : (f32x4){0.f, 0.f, 0.f, 0.f};
#pragma unroll
        for (int ai = 0; ai < 2; ++ai)
#pragma unroll
            for (int m = 0; m < 4; ++m) { float* rowp = C + (size_t)(row0 + ai * HALF + m * 16) * ldc + col0;
#pragma unroll
                for (int bj = 0; bj < 2; ++bj)
#pragma unroll
                    for (int n = 0; n < 2; ++n) *(f32x4*)(rowp + bj * HALF + n * 16) = acc[ai][bj][m][n] + bv[bj][n]; }
    }
};
template <int ACT  > struct EpiBf16 {
    static constexpr bool PERM = true, AFTER_DRAIN = false;
    bf16_t* O; int ldc; const float* bias; int split_cols; size_t split_stride;
    __device__ __forceinline__ void operator()(const f32x4 (&acc)[2][2][4][2], const Unit& u, int wr, int wc, int fr, int fq) const {
        const int row0 = u.pm * BM + wr * 64 + fr; int colt = u.pn * BM; bf16_t* base = O;
        if (split_cols) { const int t = colt / split_cols; base += (size_t)t * split_stride; colt -= t * split_cols; }
        const int col0 = colt + wc * 32 + 8 * fq, bcol0 = u.pn * BM + wc * 32 + 8 * fq;
        f32x4 bv[2][2];
#pragma unroll
        for (int bj = 0; bj < 2; ++bj)
#pragma unroll
            for (int n = 0; n < 2; ++n) bv[bj][n] = bias ? *(const f32x4*)(bias + bcol0 + bj * HALF + 4 * n) : (f32x4){0.f, 0.f, 0.f, 0.f};
#pragma unroll
        for (int ai = 0; ai < 2; ++ai)
#pragma unroll
            for (int m = 0; m < 4; ++m) { bf16_t* rowp = base + (size_t)(row0 + ai * HALF + m * 16) * ldc + col0;
#pragma unroll
                for (int bj = 0; bj < 2; ++bj) { f32x4 v0 = acc[ai][bj][m][0] + bv[bj][0], v1 = acc[ai][bj][m][1] + bv[bj][1];
                    if (ACT == 1) { f32x2 a = gelu_pk((f32x2){v0[0], v0[1]}), b = gelu_pk((f32x2){v0[2], v0[3]}), c = gelu_pk((f32x2){v1[0], v1[1]}), d = gelu_pk((f32x2){v1[2], v1[3]});
                        v0 = (f32x4){a.x, a.y, b.x, b.y}; v1 = (f32x4){c.x, c.y, d.x, d.y}; }
                    if (ACT == 2) {
#pragma unroll
                        for (int j = 0; j < 4; ++j) { v0[j] = 0.5f * v0[j] * (1.0f + erff(v0[j] * 0.70710678f)); v1[j] = 0.5f * v1[j] * (1.0f + erff(v1[j] * 0.70710678f)); } }
                    u32x4 w; w.x = cvt_pk_bf16(v0[0], v0[1]); w.y = cvt_pk_bf16(v0[2], v0[3]); w.z = cvt_pk_bf16(v1[0], v1[1]); w.w = cvt_pk_bf16(v1[2], v1[3]);
                    *(u32x4*)(rowp + bj * HALF) = w; } }
    }
};

template <class Epi, class Sched, bool STAMP = false>
__device__ __forceinline__ void gemm_phase(PG8_LAS unsigned char* lds, const Gemm g, const Sched& S, const Epi& E, unsigned long long* stamps, int wave_in) {
    int lane_; asm volatile("v_mbcnt_lo_u32_b32 %0, -1, 0\n\tv_mbcnt_hi_u32_b32 %0, -1, %0" : "=v"(lane_)); const int tid = wave_in * 64 + lane_; const int wid = wave_in, lane = tid & 63, wr = wid >> 2, wc = wid & 3, fr = lane & 15, fq = lane >> 4;
    const int K = g.K, nt = K / BK;
    int ts_lo = 0, ts_hi = 0, nts = 0; const unsigned long long rt_entry = STAMP ? (unsigned long long)wall_clock64() : 0ull;
#define PG8_STAMP() do { if (STAMP && wid == 0 && nts < 64) { const unsigned long long _c = (unsigned long long)clock64(); \
        ts_lo = (lane == nts) ? (int)(unsigned)_c : ts_lo; ts_hi = (lane == nts) ? (int)(unsigned)(_c >> 32) : ts_hi; ++nts; } } while (0)
    PG8_STAMP();
    unsigned voffA[2], voffB[2];
#pragma unroll
    for (int i = 0; i < 2; ++i) { int R, C; stage_rc(tid * 16 + i * 8192, R, C); const int Rb = Epi::PERM ? ((R & ~31) + perm32(R & 31)) : R;
        voffA[i] = (unsigned)(R * K + C) * 2u; voffB[i] = (unsigned)(Rb * K + C) * 2u; }
    const size_t kstep = (size_t)(BK * 2);
    const size_t hstep = (size_t)HALF * K * 2;
    const size_t tstep = 2 * hstep;
    const unsigned ldsw = (unsigned)wid * 1024u;
    const int aoff = lds_byte(wr * 64 + fr, fq * 8), boff = lds_byte(wc * 32 + fr, fq * 8);
#define PG8_SA(b, h) (((b) * 2 + (h)) * HTB)
#define PG8_SB(b, h) ((4 + (b) * 2 + (h)) * HTB)
#define PG8_STAGE(bufoff, gbase, voff) do { _Pragma("unroll") for (int _i = 0; _i < 2; ++_i) \
        __builtin_amdgcn_global_load_lds((const unsigned*)((const char*)(gbase) + (voff)[_i]), (PG8_LAS unsigned*)(lds + (bufoff) + ldsw + _i * 8192), 16, 0, 0); } while (0)
#define PG8_LDA(dst, b, h) do { _Pragma("unroll") for (int m = 0; m < 4; ++m) _Pragma("unroll") for (int k = 0; k < 2; ++k) dst[m][k] = *(const PG8_LAS bf16x8*)(lds + PG8_SA(b, h) + aoff + m * 2048 + k * 1024); } while (0)
#define PG8_LDB(dst, b, h) do { _Pragma("unroll") for (int n = 0; n < 2; ++n) _Pragma("unroll") for (int k = 0; k < 2; ++k) dst[n][k] = *(const PG8_LAS bf16x8*)(lds + PG8_SB(b, h) + boff + n * 2048 + k * 1024); } while (0)
#define PG8_MMA(ai, bj, At, Bt) do { __builtin_amdgcn_s_setprio(1); _Pragma("unroll") for (int m = 0; m < 4; ++m) _Pragma("unroll") for (int n = 0; n < 2; ++n) _Pragma("unroll") for (int k = 0; k < 2; ++k) \
        acc[ai][bj][m][n] = __builtin_amdgcn_mfma_f32_16x16x32_bf16(Bt[n][k], At[m][k], acc[ai][bj][m][n], 0, 0, 0); __builtin_amdgcn_s_setprio(0); } while (0)
#define PG8_WAIT_V(n) asm volatile("s_waitcnt vmcnt(" #n ")" ::: "memory")
#define PG8_WAIT_L(n) asm volatile("s_waitcnt lgkmcnt(" #n ")" ::: "memory")
#define PG8_BAR __builtin_amdgcn_s_barrier()
#define PG8_SCHED __builtin_amdgcn_sched_barrier(0)
    Unit cur, nxt; int ui = 0;
    if (!S.next(0, cur)) return;
    f32x4 acc[2][2][4][2];
#pragma unroll
    for (int a = 0; a < 2; ++a)
#pragma unroll
        for (int b = 0; b < 2; ++b)
#pragma unroll
            for (int m = 0; m < 4; ++m)
#pragma unroll
                for (int n = 0; n < 2; ++n) acc[a][b][m][n] = (f32x4){0.f, 0.f, 0.f, 0.f};
    bf16x8 At[4][2], B0[2][2], B1[2][2];
    const char* cA = (const char*)g.A + (size_t)cur.pm * tstep; const char* cB = (const char*)g.Bt + (size_t)cur.pn * tstep;
    S.a_ready(cur);
    PG8_STAGE(PG8_SB(0, 0), cB, voffB); PG8_STAGE(PG8_SA(0, 0), cA, voffA); PG8_STAGE(PG8_SB(0, 1), cB + hstep, voffB); PG8_STAGE(PG8_SA(0, 1), cA + hstep, voffA);
    if (wr == 1) PG8_BAR;
    PG8_WAIT_V(4); PG8_BAR;
    PG8_STAGE(PG8_SB(1, 0), cB + kstep, voffB); PG8_STAGE(PG8_SA(1, 0), cA + kstep, voffA); PG8_STAGE(PG8_SB(1, 1), cB + hstep + kstep, voffB);
    PG8_WAIT_V(6); PG8_BAR;
    PG8_STAMP();
    for (;;) {
        const bool has_next = S.next(ui + 1, nxt);
        const char* nA = has_next ? (const char*)g.A + (size_t)nxt.pm * tstep : cA; const char* nB = has_next ? (const char*)g.Bt + (size_t)nxt.pn * tstep : cB;
        for (int t = 0; t < nt; t += 2) {
            const bool last = (t == nt - 2);
            const char* a1 = cA + (size_t)(t + 1) * kstep;
            const char* a2 = last ? nA : cA + (size_t)(t + 2) * kstep; const char* b2 = last ? nB : cB + (size_t)(t + 2) * kstep;
            const char* a3 = a2 + kstep; const char* b3 = b2 + kstep;
            if (last && has_next) S.a_ready(nxt);
            PG8_LDB(B0, 0, 0); PG8_SCHED; PG8_LDA(At, 0, 0); PG8_STAGE(PG8_SA(1, 1), a1 + hstep, voffA);
            PG8_WAIT_L(8); PG8_BAR; PG8_WAIT_L(0); PG8_MMA(0, 0, At, B0); PG8_BAR; PG8_SCHED;
            PG8_LDB(B1, 0, 1); PG8_STAGE(PG8_SB(0, 0), b2, voffB);
            PG8_BAR; PG8_WAIT_L(0); PG8_MMA(0, 1, At, B1); PG8_BAR;
            PG8_LDA(At, 0, 1); PG8_STAGE(PG8_SA(0, 0), a2, voffA);
            PG8_BAR; PG8_WAIT_L(0); PG8_MMA(1, 0, At, B0); PG8_BAR; PG8_SCHED;
            PG8_STAGE(PG8_SB(0, 1), b2 + hstep, voffB);
            PG8_WAIT_V(6); PG8_BAR; PG8_MMA(1, 1, At, B1); PG8_BAR;
            PG8_LDB(B0, 1, 0); PG8_SCHED; PG8_LDA(At, 1, 0); PG8_STAGE(PG8_SA(0, 1), a2 + hstep, voffA);
            PG8_WAIT_L(8); PG8_BAR; PG8_WAIT_L(0); PG8_MMA(0, 0, At, B0); PG8_BAR; PG8_SCHED;
            PG8_LDB(B1, 1, 1); PG8_STAGE(PG8_SB(1, 0), b3, voffB);
            PG8_BAR; PG8_WAIT_L(0); PG8_MMA(0, 1, At, B1); PG8_BAR;
            PG8_LDA(At, 1, 1); PG8_STAGE(PG8_SA(1, 0), a3, voffA);
            PG8_BAR; PG8_WAIT_L(0); PG8_MMA(1, 0, At, B0); PG8_BAR; PG8_SCHED;
            PG8_STAGE(PG8_SB(1, 1), b3 + hstep, voffB);
            PG8_WAIT_V(6); PG8_BAR; PG8_MMA(1, 1, At, B1); PG8_BAR;
        }
        PG8_STAMP();
        if constexpr (!Epi::AFTER_DRAIN) { E(acc, cur, wr, wc, fr, fq); S.done(cur); }
        PG8_STAMP();
        if (!has_next) break;
#pragma unroll
        for (int a = 0; a < 2; ++a)
#pragma unroll
            for (int b = 0; b < 2; ++b)
#pragma unroll
                for (int m = 0; m < 4; ++m)
#pragma unroll
                    for (int n = 0; n < 2; ++n) acc[a][b][m][n] = (f32x4){0.f, 0.f, 0.f, 0.f};
        cur = nxt; cA = nA; cB = nB; ++ui;
    }
    PG8_WAIT_V(0);
    if (wr == 0) PG8_BAR;
    PG8_BAR;
    if constexpr (Epi::AFTER_DRAIN) { E.fused(acc, cur, wr, wc, fr, fq, lds, wid, lane); S.done(cur); }
    PG8_STAMP();
    if (STAMP && wid == 0) { stamps[lane] = lane < nts ? (((unsigned long long)(unsigned)ts_hi << 32) | (unsigned)ts_lo) : 0ull;
        if (lane == 62) stamps[62] = rt_entry; if (lane == 63) stamps[63] = (unsigned long long)wall_clock64(); }
#undef PG8_STAMP
#undef PG8_SA
#undef PG8_SB
#undef PG8_STAGE
#undef PG8_LDA
#undef PG8_LDB
#undef PG8_MMA
#undef PG8_WAIT_V
#undef PG8_WAIT_L
#undef PG8_BAR
#undef PG8_SCHED
}
}

namespace mk {
#define DI __device__ __forceinline__
#define LAS __attribute__((address_space(3)))
typedef unsigned short bf16_t;
typedef float f32x4 __attribute__((ext_vector_type(4)));
typedef float f32x2 __attribute__((ext_vector_type(2)));
typedef float f32x16 __attribute__((ext_vector_type(16)));
typedef short bf16x8 __attribute__((ext_vector_type(8)));
typedef short s16x4 __attribute__((ext_vector_type(4)));
typedef unsigned u32x4 __attribute__((ext_vector_type(4)));
typedef unsigned u32x2 __attribute__((ext_vector_type(2)));

constexpr int NB = 8, SEQ = 4096, T = NB * SEQ, DM = 1024, DEPTH = 4;
constexpr int INC = 2688, INCP = 2816;
constexpr int NEXP = 16384;
constexpr float NORM_EPS = 1e-6f;
constexpr int NWAVES = 8, NTHR = 512;

enum { I_X = 0, I_POS, I_NORM_MIX, I_W_IN, I_QN, I_KN, I_LAM, I_SUBLN, I_SLRE, I_SLIM, I_SBRE, I_SBIM, I_SCRE, I_SCIM, I_SD, I_SLOGDT,
       I_WGLU, I_BGLU, I_SONORM, I_MU, I_DECUP, I_DECW0, I_AAAUP, I_AAAA0, I_GATEUP, I_KK, I_KA, I_RK, I_LNW, I_LNB, I_WOUT, I_NORM_FFN,
       I_WQ, I_SUBK, I_PU, I_PV, N_IN };

constexpr size_t MiB = 1u << 20;
constexpr size_t WS_CTL = 0, CTL_BYTES = 1 * MiB;
constexpr size_t WS_WTIN = 1 * MiB;
constexpr size_t WS_WTOUT = WS_WTIN + 22 * MiB;
constexpr size_t WS_WTQ = WS_WTOUT + 8 * MiB;
constexpr size_t WS_WTGLU = WS_WTQ + 16 * MiB;
constexpr size_t WS_SUBK = WS_WTGLU + 1 * MiB;
constexpr size_t WS_ROPE = WS_SUBK + 2 * MiB;
constexpr size_t WS_SSMP = WS_ROPE + 2 * MiB;
constexpr size_t WS_U16 = WS_SSMP + 1 * MiB;
constexpr size_t WS_V16 = WS_U16 + 128 * MiB;
constexpr size_t WS_H = WS_V16 + 128 * MiB;
constexpr size_t WS_COLS = WS_H + 64 * MiB;
constexpr size_t WS_MIXED = WS_COLS + 176 * MiB;
constexpr size_t WS_X = WS_MIXED + 64 * MiB;
constexpr size_t WS_RW = WS_X;
constexpr size_t WS_QP = WS_X, WS_IDX = WS_X + 128 * MiB, WS_GATE = WS_IDX + 16 * MiB;
constexpr size_t WS_YG = WS_X + 224 * MiB;
constexpr size_t WS_GLU = WS_YG + 16 * MiB;
constexpr size_t WS_RWY = WS_GLU + 32 * MiB;
constexpr size_t WS_END = WS_RWY + 32 * MiB;
static_assert(WS_END <= 1000 * MiB, "workspace map");
constexpr int SSMP_STRIDE = 2048 + 2 * 16 * 16 * 64;

constexpr int LDS_BYTES = 155648;
constexpr int MISC_OFF = LDS_BYTES - 256;

DI unsigned f2bf(float f) { unsigned u = __builtin_bit_cast(unsigned, f); return (u + 0x7fffu + ((u >> 16) & 1u)) >> 16; }
DI unsigned pk2(float lo, float hi) { return f2bf(lo) | (f2bf(hi) << 16); }
DI float bflo(unsigned w) { return __builtin_bit_cast(float, w << 16); }
DI float bfhi(unsigned w) { return __builtin_bit_cast(float, w & 0xffff0000u); }
DI float bf2f(bf16_t b) { return __builtin_bit_cast(float, ((unsigned)b) << 16); }
template <int CTRL> DI float dpp_f(float x) { return __builtin_bit_cast(float, __builtin_amdgcn_update_dpp(0, __builtin_bit_cast(int, x), CTRL, 0xF, 0xF, true)); }
DI float sum4(float x) { x += dpp_f<0xB1>(x); x += dpp_f<0x4E>(x); return x; }
DI float sum8(float x) { x = sum4(x); x += dpp_f<0x141>(x); return x; }
DI float sum16(float x) { x = sum8(x); x += dpp_f<0x140>(x); return x; }
DI float sum32(float x) { x = sum16(x); x += __builtin_bit_cast(float, __builtin_amdgcn_ds_swizzle(__builtin_bit_cast(int, x), 0x401F)); return x; }
DI float other_half(float x, int hi) { unsigned a = __builtin_bit_cast(unsigned, x), c = a; asm volatile("" : "+v"(c));
    auto r = __builtin_amdgcn_permlane32_swap(a, c, false, false);
    return __builtin_bit_cast(float, hi ? r[0] : r[1]); }
DI float sum_halves(float x, int hi) { return x + other_half(x, hi); }
DI float wave_sum(float v) { const float s = sum32(v);
    return __builtin_bit_cast(float, __builtin_amdgcn_readlane(__builtin_bit_cast(int, s), 0)) + __builtin_bit_cast(float, __builtin_amdgcn_readlane(__builtin_bit_cast(int, s), 32)); }
DI float sigmoidf_(float x) { return 1.f / (1.f + __expf(-x)); }
DI float gelu_erf(float x) { return 0.5f * x * (1.f + erff(x * 0.70710678118654752f)); }


DI void sincos_red(double r, double& s, double& c) {
    const double k = rint(r * 0.63661977236758134308); const double y = r - k * 1.57079632679489661923; const double y2 = y * y;
    double sp = -7.6471637318198164759e-13; sp = sp * y2 + 1.6059043836821614599e-10; sp = sp * y2 - 2.5052108385441718775e-8; sp = sp * y2 + 2.7557319223985890653e-6;
    sp = sp * y2 - 1.9841269841269841270e-4; sp = sp * y2 + 8.3333333333333333333e-3; sp = sp * y2 - 1.6666666666666666667e-1; const double sy = y + y * y2 * sp;
    double cp = 4.7794773323873852974e-14; cp = cp * y2 - 1.1470745597729724714e-11; cp = cp * y2 + 2.0876756987868098979e-9; cp = cp * y2 - 2.7557319223985890653e-7;
    cp = cp * y2 + 2.4801587301587301587e-5; cp = cp * y2 - 1.3888888888888888889e-3; cp = cp * y2 + 4.1666666666666666667e-2; cp = cp * y2 - 0.5; const double cy = 1.0 + y2 * cp;
    const int q = ((int)k) & 3;
    s = (q == 0) ? sy : (q == 1) ? cy : (q == 2) ? -sy : -cy;
    c = (q == 0) ? cy : (q == 1) ? -sy : (q == 2) ? -cy : sy;
}
#define XB_TMO      128
#define XB_XCNT(j)  (256  + 64 * (j))
#define XB_XSUB(j)  (1280 + 64 * (j))
#define XB_XGEN(j)  (2304 + 64 * (j))
#define XB_TOP      3328
#define XB_TOPGEN   3392
#define XCD_BAR_WORDS 3456
#define XB_SPIN_CAP (1u << 22)
DI unsigned xb_ld(unsigned* p)              { return __hip_atomic_load(p, __ATOMIC_RELAXED, __HIP_MEMORY_SCOPE_AGENT); }
DI unsigned xb_add(unsigned* p, unsigned v) { return __hip_atomic_fetch_add(p, v, __ATOMIC_RELAXED, __HIP_MEMORY_SCOPE_AGENT); }
DI unsigned xb_xcc_id() { return (unsigned)__builtin_amdgcn_s_getreg((3 << 11) | 20) & 0xFu; }
#define XB_SPIN(cond, bar) do { unsigned _sp = 0; while (cond) { __builtin_amdgcn_s_sleep(1); \
    if ((++_sp & 255u) == 0u) { if (xb_ld(&(bar)[XB_TMO])) break; if (_sp > XB_SPIN_CAP) { atomicAdd(&(bar)[XB_TMO], 1u); break; } } } } while (0)
struct XcdBarrier { unsigned* bar; unsigned x; volatile LAS unsigned* st; };
DI XcdBarrier xcd_barrier_post(unsigned* bar, volatile LAS unsigned* st) {
    XcdBarrier b; b.bar = bar; b.x = xb_xcc_id(); b.st = st;
    if (threadIdx.x == 0) (void)xb_add(&bar[XB_XCNT(b.x)], 1u);
    return b;
}
DI void xcd_barrier_complete(unsigned* bar, unsigned x, unsigned& nloc, unsigned& nx) {
    const unsigned G = gridDim.x * gridDim.y * gridDim.z;
    unsigned sum, cnt, mine, sp = 0u;
    for (;;) {
        sum = 0u; cnt = 0u; mine = 0u;
#pragma unroll
        for (unsigned j = 0; j < 16; ++j) { const unsigned c = xb_ld(&bar[XB_XCNT(j)]); sum += c; cnt += (c > 0u) ? 1u : 0u; mine = (j == x) ? c : mine; }
        if (sum == G) break;
        __builtin_amdgcn_s_sleep(1);
        if ((++sp & 255u) == 0u) { if (xb_ld(&bar[XB_TMO])) break; if (sp > XB_SPIN_CAP) { atomicAdd(&bar[XB_TMO], 1u); break; } }
    }
    nloc = mine > 0u ? mine : 1u; nx = cnt > 0u ? cnt : 1u;
}
DI void xcd_barrier(const XcdBarrier& b, int wave) {
    asm volatile("s_waitcnt vmcnt(0)" ::: "memory");
    __syncthreads();
    int ln_; asm volatile("v_mbcnt_lo_u32_b32 %0, -1, 0\n\tv_mbcnt_hi_u32_b32 %0, -1, %0" : "=v"(ln_));
    if (wave == 0 && ln_ == 0) {
        unsigned* bar = b.bar;
        __builtin_amdgcn_s_waitcnt(0);
        unsigned nloc = b.st[0], nx = b.st[1];
        if (nloc == 0u) { xcd_barrier_complete(bar, b.x, nloc, nx); b.st[0] = nloc; b.st[1] = nx; }
        const unsigned old = xb_add(&bar[XB_XSUB(b.x)], 1u);
        const unsigned gen = old / nloc;
        if (old + 1u == (gen + 1u) * nloc) {
            __builtin_amdgcn_fence(__ATOMIC_RELEASE, "agent");
            asm volatile("s_waitcnt vmcnt(0)" ::: "memory");
            const unsigned og = xb_add(&bar[XB_TOP], 1u);
            const unsigned tg = og / nx;
            if (og + 1u == (tg + 1u) * nx) xb_add(&bar[XB_TOPGEN], 1u);
            else XB_SPIN(xb_ld(&bar[XB_TOPGEN]) == tg, bar);
            __builtin_amdgcn_fence(__ATOMIC_ACQUIRE, "agent");
            xb_add(&bar[XB_XGEN(b.x)], 1u);
            asm volatile("s_waitcnt vmcnt(0)" ::: "memory");
        } else {
            XB_SPIN(xb_ld(&bar[XB_XGEN(b.x)]) == gen, bar);
            __builtin_amdgcn_fence(__ATOMIC_ACQUIRE, "agent");
            asm volatile("s_waitcnt vmcnt(0)" ::: "memory");
        }
    }
    __syncthreads();
}

struct Args { const void* in[N_IN]; float* out; unsigned char* ws; int ph_lo, ph_hi; };
struct Ctx {
    const void* const* in; float* out; unsigned char* ws; char* lds;
    int G, vcu, NGW, wave;
};
#define INF(i) ((const float*)C.in[i])
#define PHASE_IDS int lane_; asm volatile("v_mbcnt_lo_u32_b32 %0, -1, 0\n\tv_mbcnt_hi_u32_b32 %0, -1, %0" : "=v"(lane_)); const int P_lane = lane_, P_wave = C.wave, P_tid = C.wave * 64 + lane_, P_gw = C.vcu * NWAVES + C.wave; (void)P_tid; (void)P_lane; (void)P_gw; (void)P_wave;

DI void p0_transpose_item(const float* W, int K, int N, bf16_t* WT, float* scr, int item, int lane) {
    const int nblk = N / 32, kb = item / nblk, nb = item % nblk, k0 = 64 * kb, n0 = 32 * nb;
#pragma unroll 8
    for (int i = 0; i < 32; ++i) { const int kk = 2 * i + (lane >> 5); scr[kk * 33 + (lane & 31)] = W[(size_t)(k0 + kk) * N + n0 + (lane & 31)]; }
    asm volatile("s_waitcnt lgkmcnt(0)" ::: "memory");
    const int c = lane & 7;
#pragma unroll
    for (int j = 0; j < 4; ++j) { const int n = (lane >> 3) + 8 * j; const float* s = scr + (8 * c) * 33 + n;
        u32x4 o; o.x = pk2(s[0 * 33], s[1 * 33]); o.y = pk2(s[2 * 33], s[3 * 33]); o.z = pk2(s[4 * 33], s[5 * 33]); o.w = pk2(s[6 * 33], s[7 * 33]);
        *(u32x4*)(WT + (size_t)(n0 + n) * K + k0 + 8 * c) = o; }
    asm volatile("s_waitcnt lgkmcnt(0)" ::: "memory");
}
DI void phase_prologue(const Ctx& C) {
    PHASE_IDS
    float* scr = (float*)(C.lds + P_wave * 16384);
    constexpr int I_IN = 16 * (INC / 32), I_OUT = 16 * 32, I_Q = 16 * 64, I_G = 4 * 8, I_L = I_IN + I_OUT + I_Q + I_G;
    for (int it = P_gw; it < DEPTH * I_L; it += C.NGW) {
        const int l = it / I_L; int r = it % I_L;
        if (r < I_IN) { p0_transpose_item(INF(I_W_IN) + (size_t)l * DM * INC, DM, INC, (bf16_t*)(C.ws + WS_WTIN) + (size_t)l * INCP * DM, scr, r, P_lane); continue; } r -= I_IN;
        if (r < I_OUT) { p0_transpose_item(INF(I_WOUT) + (size_t)l * DM * DM, DM, DM, (bf16_t*)(C.ws + WS_WTOUT) + (size_t)l * DM * DM, scr, r, P_lane); continue; } r -= I_OUT;
        if (r < I_Q) { p0_transpose_item(INF(I_WQ) + (size_t)l * DM * 2048, DM, 2048, (bf16_t*)(C.ws + WS_WTQ) + (size_t)l * 2048 * DM, scr, r, P_lane); continue; } r -= I_Q;
        p0_transpose_item(INF(I_WGLU) + (size_t)l * 256 * 256, 256, 256, (bf16_t*)(C.ws + WS_WTGLU) + (size_t)l * 256 * 256, scr, r, P_lane);
    }
    const size_t gt = (size_t)blockIdx.x * NTHR + P_tid, NGT = (size_t)C.G * NTHR;
    for (size_t i = gt; i < (size_t)DEPTH * 16384; i += NGT) { const size_t l = i / 16384, o = i % 16384;
        *(u32x4*)(C.ws + WS_WTIN + (l * INCP * DM + (size_t)INC * DM) * 2 + o * 16) = (u32x4){0u, 0u, 0u, 0u}; }
    for (size_t i = gt; i < (size_t)DEPTH * 16 * 128 * 128 / 8; i += NGT) { const f32x4 a = ((const f32x4*)INF(I_SUBK))[2 * i], b = ((const f32x4*)INF(I_SUBK))[2 * i + 1];
        ((u32x4*)(C.ws + WS_SUBK))[i] = (u32x4){pk2(a.x, a.y), pk2(a.z, a.w), pk2(b.x, b.y), pk2(b.z, b.w)}; }
    for (size_t i = gt; i < (size_t)DEPTH * NEXP * DM / 8; i += NGT) {
        const f32x4 a = __builtin_nontemporal_load((const f32x4*)INF(I_PU) + 2 * i), b = __builtin_nontemporal_load((const f32x4*)INF(I_PU) + 2 * i + 1);
        ((u32x4*)(C.ws + WS_U16))[i] = (u32x4){pk2(a.x, a.y), pk2(a.z, a.w), pk2(b.x, b.y), pk2(b.z, b.w)};
        const f32x4 c = __builtin_nontemporal_load((const f32x4*)INF(I_PV) + 2 * i), d = __builtin_nontemporal_load((const f32x4*)INF(I_PV) + 2 * i + 1);
        ((u32x4*)(C.ws + WS_V16))[i] = (u32x4){pk2(c.x, c.y), pk2(c.z, c.w), pk2(d.x, d.y), pk2(d.z, d.w)}; }
    for (size_t i = gt; i < (size_t)T * 8; i += NGT) { const int t = (int)(i >> 3), j = (int)(i & 7);
        const double invf = exp(-(double)j * 0.125 * log(500000.0));
        const double ang = (double)((const int*)C.in[I_POS])[t] * invf;
        const double red = ang - 6.283185307179586476925 * rint(ang * 0.15915494309189533577);
        float* o = (float*)(C.ws + WS_ROPE) + (size_t)t * 16;
        double sn, cn; sincos_red(red, sn, cn); o[j] = (float)cn; o[8 + j] = (float)sn; }
    for (size_t i = gt; i < (size_t)DEPTH * 1024; i += NGT) { const int l = (int)(i >> 10), gp = (int)(i & 1023), g = gp >> 6, p = gp & 63;
        const double lr = fmin((double)INF(I_SLRE)[l * 1024 + gp], -1e-4), li = (double)INF(I_SLIM)[l * 1024 + gp];
        const double step = exp((double)INF(I_SLOGDT)[l * 16 + g]);
        const double mag = exp(lr * step); double ph = li * step; ph -= 6.283185307179586476925 * rint(ph * 0.15915494309189533577);
        double sn, cn; sincos_red(ph, sn, cn); const double are = mag * cn, aim = mag * sn;
        const double den = lr * lr + li * li;
        const double cre = ((are - 1.0) * lr + aim * li) / den, cim = (aim * lr - (are - 1.0) * li) / den;
        float* P = (float*)(C.ws + WS_SSMP) + (size_t)l * SSMP_STRIDE;
        P[gp] = (float)are; P[1024 + gp] = (float)aim;
        for (int h = 0; h < 16; ++h) { const double br = (double)INF(I_SBRE)[((size_t)l * 1024 + gp) * 16 + h], bi = (double)INF(I_SBIM)[((size_t)l * 1024 + gp) * 16 + h];
            P[2048 + (g * 16 + h) * 64 + p] = (float)(cre * br - cim * bi);
            P[2048 + 16384 + (g * 16 + h) * 64 + p] = (float)(cre * bi + cim * br); } }
}

DI void phase_rmsnorm(const Ctx& C, const float* src, const float* gain, bf16_t* dst) {
    PHASE_IDS
    f32x4 g[4];
#pragma unroll
    for (int j = 0; j < 4; ++j) g[j] = ((const f32x4*)gain)[P_lane + 64 * j];
    for (int m = P_gw; m < T; m += C.NGW) {
        const f32x4* xr = (const f32x4*)(src + (size_t)m * DM) + P_lane;
        f32x4 v[4]; float s = 0.f;
#pragma unroll
        for (int j = 0; j < 4; ++j) { v[j] = xr[64 * j]; s += (v[j].x * v[j].x + v[j].y * v[j].y) + (v[j].z * v[j].z + v[j].w * v[j].w); }
        const float rs = 1.f / sqrtf(wave_sum(s) * (1.f / DM) + NORM_EPS);
        u32x2* o8 = (u32x2*)(dst + (size_t)m * DM) + P_lane;
#pragma unroll
        for (int j = 0; j < 4; ++j) o8[64 * j] = (u32x2){pk2(v[j].x * rs * g[j].x, v[j].y * rs * g[j].y), pk2(v[j].z * rs * g[j].z, v[j].w * rs * g[j].w)};
    }
}

DI void phase_prep(const Ctx& C, int l) {
    PHASE_IDS
    bf16_t* cols = (bf16_t*)(C.ws + WS_COLS);
    {
        float* Wd = (float*)C.lds; float* Wa = Wd + 32 * 256; float* Wg = Wa + 32 * 256; float* lr = Wg + 64 * 256;
        const float* gd = INF(I_DECUP) + (size_t)l * 32 * 256; const float* ga = INF(I_AAAUP) + (size_t)l * 32 * 256; const float* gg = INF(I_GATEUP) + (size_t)l * 64 * 256;
        for (int i = P_tid; i < 32 * 256 / 4; i += NTHR) { ((f32x4*)Wd)[i] = ((const f32x4*)gd)[i]; ((f32x4*)Wa)[i] = ((const f32x4*)ga)[i]; }
        for (int i = P_tid; i < 64 * 256 / 4; i += NTHR) ((f32x4*)Wg)[i] = ((const f32x4*)gg)[i];
        const float* mu = INF(I_MU) + (size_t)l * 896;
        const int hh = P_tid >> 8, j = P_tid & 255;
        const float w0 = INF(I_DECW0)[l * 256 + j], a0 = INF(I_AAAA0)[l * 256 + j], kkw = INF(I_KK)[l * 256 + j], kaw = INF(I_KA)[l * 256 + j];
        const float mur = mu[j], muk = mu[256 + j], muv = mu[512 + j];
        float* RW = (float*)(C.ws + WS_RW);
        for (int tile = C.vcu; tile < T / 16; tile += C.G) {
            const int t0 = tile * 16;
            __syncthreads();
#pragma unroll
            for (int i = 0; i < 4; ++i) { const int v = P_tid + NTHR * i, tt = v >> 7, c = v & 127, t = t0 + tt;
                const float cur = bf2f(cols[(size_t)t * INCP + 1792 + 768 + c]);
                const float prev = (t % SEQ) ? bf2f(cols[(size_t)(t - 1) * INCP + 1792 + 768 + c]) : 0.f;
                const float x = cur + (prev - cur) * mu[768 + c];
                lr[tt * 128 + c] = c < 32 ? tanhf(x) : (c < 64 ? x : sigmoidf_(x)); }
            __syncthreads();
#pragma unroll 1
            for (int pass = 0; pass < 2; ++pass) {
                const int tb = hh * 8 + pass * 4;
                float aw[4] = {0.f, 0.f, 0.f, 0.f}, aa[4] = {0.f, 0.f, 0.f, 0.f}, ag[4] = {0.f, 0.f, 0.f, 0.f};
#pragma unroll 4
                for (int i = 0; i < 32; ++i) { const float wd = Wd[i * 256 + j], wa = Wa[i * 256 + j];
#pragma unroll
                    for (int q = 0; q < 4; ++q) { aw[q] += lr[(tb + q) * 128 + i] * wd; aa[q] += lr[(tb + q) * 128 + 32 + i] * wa; } }
#pragma unroll 4
                for (int i = 0; i < 64; ++i) { const float wg = Wg[i * 256 + j];
#pragma unroll
                    for (int q = 0; q < 4; ++q) ag[q] += lr[(tb + q) * 128 + 64 + i] * wg; }
#pragma unroll
                for (int q = 0; q < 4; ++q) { const int t = t0 + tb + q; const bool first = (t % SEQ) == 0;
                    const bf16_t* cr = cols + (size_t)t * INCP + 1792; const bf16_t* pr = cr - INCP;
                    float r = bf2f(cr[j]), k = bf2f(cr[256 + j]), v = bf2f(cr[512 + j]);
                    const float rp = first ? 0.f : bf2f(pr[j]), kp = first ? 0.f : bf2f(pr[256 + j]), vp = first ? 0.f : bf2f(pr[512 + j]);
                    r += (rp - r) * mur; k += (kp - k) * muk; v += (vp - v) * muv;
                    const float sg = sigmoidf_(w0 + aw[q]); const float decay = __expf(-0.60653065971263342f * sg);
                    const float a = sigmoidf_(a0 + aa[q]);
                    float kk = k * kkw; const float ss = wave_sum(kk * kk); kk = kk / fmaxf(sqrtf(ss), 1e-12f);
                    const float k2 = k * (1.f + (a - 1.f) * kaw);
                    float* o = RW + (size_t)t * 1792 + j;
                    o[0] = r; o[256] = decay; o[512] = k2; o[768] = v; o[1024] = kk; o[1280] = kk * a; o[1536] = ag[q]; __builtin_amdgcn_sched_barrier(0); }
            }
        }
        __syncthreads();
    }
    {
        const int v16 = P_lane >> 2, qt = P_lane & 3, part = v16 >> 3, vec = v16 & 7;
        float gn[16];
#pragma unroll
        for (int i = 0; i < 16; ++i) gn[i] = (part == 0 ? INF(I_QN) : INF(I_KN))[l * 512 + vec * 64 + qt * 16 + i];
        const float qscale = part == 0 ? 0.18033688011112042f : 1.f;
        const float* rope = (const float*)(C.ws + WS_ROPE);
        for (int t = P_gw; t < T; t += C.NGW) {
            float cs[16];
#pragma unroll
            for (int i = 0; i < 4; ++i) { const f32x4 v = ((const f32x4*)(rope + (size_t)t * 16))[i]; cs[4 * i] = v.x; cs[4 * i + 1] = v.y; cs[4 * i + 2] = v.z; cs[4 * i + 3] = v.w; }
            bf16_t* p = cols + (size_t)t * INCP + v16 * 64 + qt * 16;
            const u32x4 w0 = ((const u32x4*)p)[0], w1 = ((const u32x4*)p)[1];
            float x[16];
            x[0] = bflo(w0.x); x[1] = bfhi(w0.x); x[2] = bflo(w0.y); x[3] = bfhi(w0.y); x[4] = bflo(w0.z); x[5] = bfhi(w0.z); x[6] = bflo(w0.w); x[7] = bfhi(w0.w);
            x[8] = bflo(w1.x); x[9] = bfhi(w1.x); x[10] = bflo(w1.y); x[11] = bfhi(w1.y); x[12] = bflo(w1.z); x[13] = bfhi(w1.z); x[14] = bflo(w1.w); x[15] = bfhi(w1.w);
            float ss = 0.f;
#pragma unroll
            for (int i = 0; i < 16; ++i) ss += x[i] * x[i];
            ss = sum4(ss);
            const float rs = qscale / sqrtf(ss * (1.f / 64.f) + NORM_EPS);
#pragma unroll
            for (int i = 0; i < 16; ++i) x[i] = x[i] * rs * gn[i];
            if (qt == 0) {
#pragma unroll
                for (int i = 0; i < 8; ++i) { const float r1 = x[i], r2 = x[8 + i]; x[i] = r1 * cs[i] - r2 * cs[8 + i]; x[8 + i] = r2 * cs[i] + r1 * cs[8 + i]; }
            }
            ((u32x4*)p)[0] = (u32x4){pk2(x[0], x[1]), pk2(x[2], x[3]), pk2(x[4], x[5]), pk2(x[6], x[7])};
            ((u32x4*)p)[1] = (u32x4){pk2(x[8], x[9]), pk2(x[10], x[11]), pk2(x[12], x[13]), pk2(x[14], x[15])};
        }
    }
}

typedef short v4i16_t __attribute__((ext_vector_type(4)));
DI s16x4 tr_read(const char* p) { return __builtin_bit_cast(s16x4, __builtin_amdgcn_ds_read_tr16_b64_v4i16((LAS v4i16_t*)p)); }
typedef __bf16 bf16x2_t __attribute__((ext_vector_type(2)));
DI unsigned cvtpk(float lo, float hi) { f32x2 v = {lo, hi}; bf16x2_t b = __builtin_convertvector(v, bf16x2_t); return __builtin_bit_cast(unsigned, b); }
DI int crow(int r, int hi) { return (r & 3) + 8 * (r >> 2) + 4 * hi; }
DI bf16x8 pack8(const f32x16& p, int b) { u32x4 w = {cvtpk(p[b], p[b + 1]), cvtpk(p[b + 2], p[b + 3]), cvtpk(p[b + 4], p[b + 5]), cvtpk(p[b + 6], p[b + 7])}; return __builtin_bit_cast(bf16x8, w); }
constexpr int AT_K = 0, AT_V = 16384, AT_X = 32768, AT_W = 98304;

DI void attn_unit(const Ctx& C, int l, int b, int h, int qb, float lam_full, float lam_init) {
    PHASE_IDS
    const bf16_t* cols = (const bf16_t*)(C.ws + WS_COLS);
    char* lds = C.lds;
    const int tid = P_tid, lane = P_lane, wid = P_wave, r32 = lane & 31, hi = lane >> 5, m = wid >> 2, sub = wid & 3;
    const size_t tb = (size_t)b * SEQ;
    const size_t qrow = tb + qb * 128 + sub * 32 + r32;
    bf16x8 qr[4];
#pragma unroll
    for (int d0 = 0; d0 < 4; ++d0) qr[d0] = *(const bf16x8*)(cols + qrow * INCP + h * 128 + m * 64 + d0 * 16 + hi * 8);
    f32x16 o[4];
#pragma unroll
    for (int i = 0; i < 4; ++i)
#pragma unroll
        for (int r = 0; r < 16; ++r) o[i][r] = 0.f;
    float lsum = 0.f;
    const int nt = 2 * qb + 2, my_nt = 2 * qb + 1 + (sub >> 1);
    const int q4 = (lane & 15) >> 2, p4 = lane & 3, blk16 = (lane >> 4) & 1;
    unsigned goK[2], goV[2], loK[2], loV[2];
#pragma unroll
    for (int i = 0; i < 2; ++i) { const int c = tid + NTHR * i, mm = c >> 9, row = (c >> 3) & 63, ch = c & 7;
        goK[i] = (unsigned)((row * INCP + 512 + mm * 64 + ch * 8) * 2); loK[i] = (unsigned)(AT_K + mm * 8192 + row * 128 + 16 * (ch ^ ((row >> 1) & 7))); }
#pragma unroll
    for (int i = 0; i < 2; ++i) { const int c = tid + NTHR * i, row = c >> 4, ch = c & 15;
        goV[i] = (unsigned)((row * INCP + 1024 + ch * 8) * 2); loV[i] = (unsigned)(AT_V + row * 256 + 16 * (ch ^ (((row & 3) << 2) | ((row >> 2) & 3)))); }
    for (int kt = 0; kt < nt; ++kt) {
        __syncthreads();
        const char* tbase = (const char*)(cols + (tb + kt * 64) * INCP + h * 128);
#pragma unroll
        for (int i = 0; i < 2; ++i) *(u32x4*)(lds + loK[i]) = *(const u32x4*)(tbase + goK[i]);
#pragma unroll
        for (int i = 0; i < 2; ++i) *(u32x4*)(lds + loV[i]) = *(const u32x4*)(tbase + goV[i]);
        __syncthreads();
        if (kt < my_nt) {
            f32x16 p0, p1;
#pragma unroll
            for (int r = 0; r < 16; ++r) { p0[r] = 0.f; p1[r] = 0.f; }
#pragma unroll
            for (int d0 = 0; d0 < 4; ++d0) {
                const char* kp = lds + AT_K + m * 8192 + r32 * 128 + 16 * ((2 * d0 + hi) ^ ((r32 >> 1) & 7));
                const bf16x8 ka0 = *(const bf16x8*)kp, ka1 = *(const bf16x8*)(kp + 4096);
                p0 = __builtin_amdgcn_mfma_f32_32x32x16_bf16(ka0, qr[d0], p0, 0, 0, 0);
                p1 = __builtin_amdgcn_mfma_f32_32x32x16_bf16(ka1, qr[d0], p1, 0, 0, 0);
            }
            float s = 0.f;
#pragma unroll
            for (int r = 0; r < 16; ++r) { p0[r] = __builtin_amdgcn_exp2f(p0[r]); p1[r] = __builtin_amdgcn_exp2f(p1[r]); s += p0[r] + p1[r]; }
            lsum += s;
            bf16x8 pa[4]; pa[0] = pack8(p0, 0); pa[1] = pack8(p0, 8); pa[2] = pack8(p1, 0); pa[3] = pack8(p1, 8);
#pragma unroll
            for (int db = 0; db < 4; ++db) {
#pragma unroll
                for (int s4 = 0; s4 < 4; ++s4) {
                    const int rlo = 32 * (s4 >> 1) + 16 * (s4 & 1) + 4 * hi + q4, rhi = rlo + 8;
                    const int ch = 4 * db + 2 * blk16 + (p4 >> 1);
                    const s16x4 lo = tr_read(lds + AT_V + rlo * 256 + 16 * (ch ^ (((rlo & 3) << 2) | ((rlo >> 2) & 3))) + 8 * (p4 & 1));
                    const s16x4 hh = tr_read(lds + AT_V + rhi * 256 + 16 * (ch ^ (((rhi & 3) << 2) | ((rhi >> 2) & 3))) + 8 * (p4 & 1));
                    const bf16x8 vf = __builtin_shufflevector(lo, hh, 0, 1, 2, 3, 4, 5, 6, 7);
                    o[db] = __builtin_amdgcn_mfma_f32_32x32x16_bf16(pa[s4], vf, o[db], 0, 0, 0);
                }
            }
        }
    }
    float* wsf = (float*)(lds + AT_W) + wid * 64;
    const float lt = sum_halves(lsum, hi);
    if (hi == 0) wsf[r32] = 1.f / lt;
    __syncthreads();
#pragma unroll
    for (int r = 0; r < 16; ++r) { const float rl = wsf[crow(r, hi)];
#pragma unroll
        for (int db = 0; db < 4; ++db) o[db][r] *= rl; }
    float* xch = (float*)(lds + AT_X) + sub * 4096;
    if (m == 1) {
#pragma unroll
        for (int r = 0; r < 16; ++r)
#pragma unroll
            for (int db = 0; db < 4; ++db) xch[crow(r, hi) * 128 + db * 32 + r32] = o[db][r];
    }
    __syncthreads();
    if (m == 0) {
        const float* subln = INF(I_SUBLN) + l * 128;
        float g[4];
#pragma unroll
        for (int db = 0; db < 4; ++db) g[db] = subln[db * 32 + r32] * (1.f - lam_init);
        bf16_t* mixed = (bf16_t*)(C.ws + WS_MIXED);
#pragma unroll
        for (int r = 0; r < 16; ++r) {
            float ss = 0.f;
#pragma unroll
            for (int db = 0; db < 4; ++db) { o[db][r] -= lam_full * xch[crow(r, hi) * 128 + db * 32 + r32]; ss += o[db][r] * o[db][r]; }
            ss = sum32(ss);
            const float rs = 1.f / sqrtf(ss * (1.f / 128.f) + NORM_EPS);
            bf16_t* orow = mixed + (tb + qb * 128 + sub * 32 + crow(r, hi)) * DM + h * 128;
#pragma unroll
            for (int db = 0; db < 4; ++db) orow[db * 32 + r32] = (bf16_t)f2bf(o[db][r] * rs * g[db]);
        }
    }
}
DI void phase_attn(const Ctx& C, int l) {
    PHASE_IDS
    const float* lf = INF(I_LAM) + l * 256;
    const float la = wave_sum(lf[P_lane] * lf[64 + P_lane]), lb = wave_sum(lf[128 + P_lane] * lf[192 + P_lane]);
    const float lam_init = 0.8f - 0.6f * expf(-0.3f * (float)l);
    const float lam_full = expf(la) - expf(lb) + lam_init;
    for (int u = C.vcu; u < 1024; u += C.G) {
        const int bh = (u & 255) >> 3, s = u & 7, i = u >> 8;
        const int qb = (i == 0) ? s : (i == 1) ? 15 - s : (i == 2) ? 16 + s : 31 - s;
        attn_unit(C, l, bh >> 2, bh & 3, qb, lam_full, lam_init);
    }
    __syncthreads();
}

DI void phase_ssm(const Ctx& C, int l) {
    PHASE_IDS
    float* L = (float*)C.lds;
    float* Bre = L;
    float* Bim = L + 1024;
    float* Cre = L + 2048;
    float* Cim = Cre + 16 * 65;
    float* Uu = Cim + 16 * 65;
    float* Xre = Uu + 1024;
    float* Xim = Xre + 64 * 65;
    const bf16_t* cols = (const bf16_t*)(C.ws + WS_COLS);
    bf16_t* yg = (bf16_t*)(C.ws + WS_YG);
    const float* P = (const float*)(C.ws + WS_SSMP) + (size_t)l * SSMP_STRIDE;
    const int tid = P_tid;
    for (int u = C.vcu; u < 128; u += C.G) {
        const int b = u >> 4, g = u & 15;
        __syncthreads();
        for (int i = tid; i < 1024; i += NTHR) { Bre[i] = P[2048 + g * 1024 + i]; Bim[i] = P[2048 + 16384 + g * 1024 + i];
            const int h = i >> 6, p = i & 63; Cre[h * 65 + p] = INF(I_SCRE)[((size_t)l * 256 + g * 16 + h) * 64 + p]; Cim[h * 65 + p] = INF(I_SCIM)[((size_t)l * 256 + g * 16 + h) * 64 + p]; }
        const float are = P[g * 64 + (tid & 63)], aim = P[1024 + g * 64 + (tid & 63)];
        float xr = 0.f, xi = 0.f;
        const int yt = tid >> 3, yh = (tid & 7) * 2;
        const float d0 = INF(I_SD)[l * 256 + g * 16 + yh], d1 = INF(I_SD)[l * 256 + g * 16 + yh + 1];
        for (int ck = 0; ck < 64; ++ck) {
            const size_t t0 = (size_t)b * SEQ + ck * 64;
            __syncthreads();
            for (int i = tid; i < 1024; i += NTHR) Uu[i] = bf2f(cols[(t0 + (i >> 4)) * INCP + 1536 + g * 16 + (i & 15)]);
            __syncthreads();
            { const int p = tid & 63, tg = tid >> 6;
#pragma unroll
              for (int q = 0; q < 8; ++q) { const int t = tg * 8 + q; float sr = 0.f, si = 0.f;
#pragma unroll
                  for (int h = 0; h < 16; ++h) { const float uv = Uu[t * 16 + h]; sr += uv * Bre[h * 64 + p]; si += uv * Bim[h * 64 + p]; }
                  Xre[t * 65 + p] = sr; Xim[t * 65 + p] = si; } }
            __syncthreads();
            if (tid < 64) {
#pragma unroll 8
                for (int t = 0; t < 64; ++t) { const float br = Xre[t * 65 + tid], bi = Xim[t * 65 + tid];
                    const float nr = are * xr - aim * xi + br, ni = are * xi + aim * xr + bi; xr = nr; xi = ni;
                    Xre[t * 65 + tid] = xr; Xim[t * 65 + tid] = xi; }
            }
            __syncthreads();
            { float y0 = d0 * Uu[yt * 16 + yh], y1 = d1 * Uu[yt * 16 + yh + 1];
#pragma unroll 8
              for (int p = 0; p < 64; ++p) { const float vr = Xre[yt * 65 + p], vi = Xim[yt * 65 + p];
                  y0 += vr * Cre[yh * 65 + p] - vi * Cim[yh * 65 + p]; y1 += vr * Cre[(yh + 1) * 65 + p] - vi * Cim[(yh + 1) * 65 + p]; }
              *(unsigned*)(yg + (t0 + yt) * 256 + g * 16 + yh) = pk2(gelu_erf(y0), gelu_erf(y1)); }
        }
    }
    __syncthreads();
}

DI void phase_rwkv(const Ctx& C, int l) {
    PHASE_IDS
    constexpr int CH = 32;
    float* buf = (float*)C.lds;
    float* ybuf = buf + CH * 384;
    const float* RW = (const float*)(C.ws + WS_RW);
    float* RWY = (float*)(C.ws + WS_RWY);
    const int tid = P_tid, i = tid >> 3, jq = tid & 7;
    for (int u = C.vcu; u < 32; u += C.G) {
        const int b = u >> 2, h = u & 3;
        float S[8];
#pragma unroll
        for (int c = 0; c < 8; ++c) S[c] = 0.f;
        for (int ck = 0; ck < SEQ / CH; ++ck) {
            const size_t t0 = (size_t)b * SEQ + ck * CH;
            __syncthreads();
            for (int it = tid; it < CH * 96; it += NTHR) { const int tt = it / 96, r = it % 96, vt = r >> 4, q = r & 15;
                ((f32x4*)buf)[it] = *(const f32x4*)(RW + (t0 + tt) * 1792 + vt * 256 + h * 64 + q * 4); }
            __syncthreads();
#pragma unroll 2
            for (int tt = 0; tt < CH; ++tt) {
                const float* bb = buf + tt * 384;
                const f32x4 r0 = *(const f32x4*)(bb + 8 * jq), r1 = *(const f32x4*)(bb + 8 * jq + 4);
                const f32x4 w0 = *(const f32x4*)(bb + 64 + 8 * jq), w1 = *(const f32x4*)(bb + 64 + 8 * jq + 4);
                const f32x4 k0 = *(const f32x4*)(bb + 128 + 8 * jq), k1 = *(const f32x4*)(bb + 128 + 8 * jq + 4);
                const float vi = bb[192 + i];
                const f32x4 q0 = *(const f32x4*)(bb + 256 + 8 * jq), q1 = *(const f32x4*)(bb + 256 + 8 * jq + 4);
                const f32x4 b0 = *(const f32x4*)(bb + 320 + 8 * jq), b1 = *(const f32x4*)(bb + 320 + 8 * jq + 4);
                float sa = S[0] * q0.x + S[1] * q0.y + S[2] * q0.z + S[3] * q0.w + S[4] * q1.x + S[5] * q1.y + S[6] * q1.z + S[7] * q1.w;
                sa = -sum8(sa);
                S[0] = S[0] * w0.x + sa * b0.x + vi * k0.x; S[1] = S[1] * w0.y + sa * b0.y + vi * k0.y; S[2] = S[2] * w0.z + sa * b0.z + vi * k0.z; S[3] = S[3] * w0.w + sa * b0.w + vi * k0.w;
                S[4] = S[4] * w1.x + sa * b1.x + vi * k1.x; S[5] = S[5] * w1.y + sa * b1.y + vi * k1.y; S[6] = S[6] * w1.z + sa * b1.z + vi * k1.z; S[7] = S[7] * w1.w + sa * b1.w + vi * k1.w;
                float y = S[0] * r0.x + S[1] * r0.y + S[2] * r0.z + S[3] * r0.w + S[4] * r1.x + S[5] * r1.y + S[6] * r1.z + S[7] * r1.w;
                y = sum8(y);
                if (jq == 0) ybuf[tt * 64 + i] = y;
            }
            __syncthreads();
            for (int it = tid; it < CH * 16; it += NTHR) { const int tt = it >> 4, q = it & 15;
                *(f32x4*)(RWY + (t0 + tt) * 256 + h * 64 + q * 4) = ((const f32x4*)ybuf)[it]; }
        }
    }
    __syncthreads();
}

DI void phase_post(const Ctx& C, int l) {
    PHASE_IDS
    const float* glu = (const float*)(C.ws + WS_GLU); const float* RW = (const float*)(C.ws + WS_RW); const float* RWY = (const float*)(C.ws + WS_RWY);
    bf16_t* mixed = (bf16_t*)(C.ws + WS_MIXED);
    const f32x4 on = ((const f32x4*)(INF(I_SONORM) + l * 256))[P_lane];
    for (int t = P_gw; t < T; t += C.NGW) {
        const f32x4 v = ((const f32x4*)(glu + (size_t)t * 256))[P_lane];
        const float ss = wave_sum(v.x * v.x + v.y * v.y + v.z * v.z + v.w * v.w);
        const float rs = 1.f / sqrtf(ss * (1.f / 256.f) + NORM_EPS);
        *(u32x2*)(mixed + (size_t)t * DM + 512 + 4 * P_lane) = (u32x2){pk2(v.x * rs * on.x, v.y * rs * on.y), pk2(v.z * rs * on.z, v.w * rs * on.w)};
#pragma unroll
        for (int h = 0; h < 4; ++h) { const int j = h * 64 + P_lane;
            const float y = RWY[(size_t)t * 256 + j];
            const float mean = wave_sum(y) * (1.f / 64.f); const float dv = y - mean; const float var = wave_sum(dv * dv) * (1.f / 64.f);
            float yn = dv * (1.f / sqrtf(var + 64e-5f)) * INF(I_LNW)[l * 256 + j] + INF(I_LNB)[l * 256 + j];
            const float* rw = RW + (size_t)t * 1792 + j;
            const float dot = wave_sum(rw[0] * rw[512] * INF(I_RK)[l * 256 + j]);
            yn = (yn + dot * rw[768]) * rw[1536];
            mixed[(size_t)t * DM + 768 + j] = (bf16_t)f2bf(yn); }
    }
}

DI void phase_topk(const Ctx& C, int l) {
    PHASE_IDS
    const bf16_t* qp = (const bf16_t*)(C.ws + WS_QP); const bf16_t* subk = (const bf16_t*)(C.ws + WS_SUBK);
    int* IDX = (int*)(C.ws + WS_IDX); float* GATE = (float*)(C.ws + WS_GATE);
    unsigned* scr = (unsigned*)C.lds + P_wave * 2048;
    const float NEG = -3.0e38f;
    for (int task = P_gw; task < (T / 32) * 8; task += C.NGW) {
        const int tile = task >> 3, h = task & 7;
        float LA[16], LB[16];
        {
        int lane0; asm volatile("v_mbcnt_lo_u32_b32 %0, -1, 0\n\tv_mbcnt_hi_u32_b32 %0, -1, %0" : "=v"(lane0)); const int r32 = lane0 & 31, hi = lane0 >> 5;
#pragma unroll
        for (int m = 0; m < 2; ++m) {
            bf16x8 bq[8];
#pragma unroll
            for (int d0 = 0; d0 < 8; ++d0) bq[d0] = *(const bf16x8*)(qp + (size_t)(tile * 32 + r32) * 2048 + h * 256 + m * 128 + d0 * 16 + hi * 8);
            float Lm[16];
#pragma unroll
            for (int i = 0; i < 16; ++i) Lm[i] = NEG;
#pragma unroll
            for (int k = 0; k < 4; ++k) {
                f32x16 acc;
#pragma unroll
                for (int r = 0; r < 16; ++r) acc[r] = 0.f;
                const bf16_t* kp = subk + ((size_t)((l * 8 + h) * 2 + m) * 128 + k * 32 + r32) * 128 + hi * 8;
#pragma unroll
                for (int d0 = 0; d0 < 8; ++d0) { const bf16x8 ak = *(const bf16x8*)(kp + d0 * 16); acc = __builtin_amdgcn_mfma_f32_32x32x16_bf16(ak, bq[d0], acc, 0, 0, 0); }
#pragma unroll
                for (int r = 0; r < 16; ++r) { const unsigned key = 32 * k + (r & 3) + 8 * (r >> 2) + 4 * hi;
                    const float av = acc[r];
                    float x = __builtin_bit_cast(float, (__builtin_bit_cast(unsigned, av) & ~127u) | key);
#pragma unroll
                    for (int i = 0; i < 16; ++i) { const float mx = fmaxf(Lm[i], x); x = fminf(Lm[i], x); Lm[i] = mx; } }
                __builtin_amdgcn_sched_barrier(0);
            }
            float ot[16];
#pragma unroll
            for (int i = 0; i < 16; ++i) ot[i] = other_half(Lm[i], hi);
#pragma unroll
            for (int j = 0; j < 16; ++j) { float x = ot[j];
#pragma unroll
                for (int i = 0; i < 16; ++i) { const float mx = fmaxf(Lm[i], x); x = fminf(Lm[i], x); Lm[i] = mx; } }
#pragma unroll
            for (int i = 0; i < 16; ++i) { if (m == 0) LA[i] = Lm[i]; else LB[i] = Lm[i]; }
        }
        }
        int lane; asm volatile("v_mbcnt_lo_u32_b32 %0, -1, 0\n\tv_mbcnt_hi_u32_b32 %0, -1, %0" : "=v"(lane)); const int r32 = lane & 31, hi = lane >> 5;
#pragma unroll
        for (int i = 0; i < 16; ++i) { scr[i * 64 + lane] = __builtin_bit_cast(unsigned, LA[i]) & 127u; scr[(16 + i) * 64 + lane] = __builtin_bit_cast(unsigned, LB[i]) & 127u; }
        float L2[16];
#pragma unroll
        for (int i = 0; i < 16; ++i) L2[i] = NEG;
#pragma unroll
        for (int i = 0; i < 16; ++i) {
            const float sa = __builtin_bit_cast(float, __builtin_bit_cast(unsigned, LA[i]) & ~127u);
#pragma unroll
            for (int j = 0; j < 16; ++j) {
                if ((i + 1) * (j + 1) <= 16) {
                    const float sb = __builtin_bit_cast(float, __builtin_bit_cast(unsigned, LB[j]) & ~127u);
                    float x = __builtin_bit_cast(float, (__builtin_bit_cast(unsigned, sa + sb) & ~255u) | (unsigned)(i * 16 + j));
#pragma unroll
                    for (int q = 0; q < 16; ++q) { const float mx = fmaxf(L2[q], x); x = fminf(L2[q], x); L2[q] = mx; }
                }
            }
            __builtin_amdgcn_sched_barrier(0);
        }
        float sc[16], den = 0.f;
#pragma unroll
        for (int q = 0; q < 16; ++q) { sc[q] = __builtin_bit_cast(float, __builtin_bit_cast(unsigned, L2[q]) & ~255u); }
        { const float m0 = sc[0];
#pragma unroll
        for (int q = 0; q < 16; ++q) { sc[q] = __expf(sc[q] - m0); den += sc[q]; } }
        const float rden = 1.f / den;
        if (hi == 0) {
            const size_t ob = (size_t)(tile * 32 + r32) * 128 + h * 16;
#pragma unroll
            for (int q = 0; q < 16; ++q) { const unsigned bits = __builtin_bit_cast(unsigned, L2[q]); const unsigned i = (bits >> 4) & 15u, j = bits & 15u;
                const unsigned e = scr[i * 64 + lane] * 128u + scr[(16 + j) * 64 + lane];
                IDX[ob + q] = (int)e; GATE[ob + q] = sc[q] * rden; }
        }
    }
}

DI float dot8(const u32x4 w, const float* hf) {
    return bflo(w.x) * hf[0] + bfhi(w.x) * hf[1] + bflo(w.y) * hf[2] + bfhi(w.y) * hf[3] + bflo(w.z) * hf[4] + bfhi(w.z) * hf[5] + bflo(w.w) * hf[6] + bfhi(w.w) * hf[7];
}
DI void phase_gather(const Ctx& C, int l) {
    PHASE_IDS
    const bf16_t* H2 = (const bf16_t*)(C.ws + WS_H);
    const bf16_t* U = (const bf16_t*)(C.ws + WS_U16) + (size_t)l * NEXP * DM; const bf16_t* V = (const bf16_t*)(C.ws + WS_V16) + (size_t)l * NEXP * DM;
    const int* IDX = (const int*)(C.ws + WS_IDX); const float* GATE = (const float*)(C.ws + WS_GATE);
    const int lane = P_lane;
    for (int t = P_gw; t < T; t += C.NGW) {
        float hf[16];
        { const u32x4 a = *(const u32x4*)(H2 + (size_t)t * DM + 8 * lane), b = *(const u32x4*)(H2 + (size_t)t * DM + 512 + 8 * lane);
          hf[0] = bflo(a.x); hf[1] = bfhi(a.x); hf[2] = bflo(a.y); hf[3] = bfhi(a.y); hf[4] = bflo(a.z); hf[5] = bfhi(a.z); hf[6] = bflo(a.w); hf[7] = bfhi(a.w);
          hf[8] = bflo(b.x); hf[9] = bfhi(b.x); hf[10] = bflo(b.y); hf[11] = bfhi(b.y); hf[12] = bflo(b.z); hf[13] = bfhi(b.z); hf[14] = bflo(b.w); hf[15] = bfhi(b.w); }
        const int e0 = IDX[(size_t)t * 128 + lane], e1 = IDX[(size_t)t * 128 + 64 + lane];
        const float g0 = GATE[(size_t)t * 128 + lane], g1 = GATE[(size_t)t * 128 + 64 + lane];
        float c0 = 0.f, c1 = 0.f;
#pragma unroll 1
        for (int eb = 0; eb < 128; eb += 8) {
            u32x4 ua[8], ub[8];
#pragma unroll
            for (int q = 0; q < 8; ++q) { const int e = __builtin_amdgcn_readlane(eb < 64 ? e0 : e1, (eb & 63) + q);
                const bf16_t* row = U + (size_t)e * DM; ua[q] = *(const u32x4*)(row + 8 * lane); ub[q] = *(const u32x4*)(row + 512 + 8 * lane); }
#pragma unroll
            for (int q = 0; q < 8; ++q) { const float d = wave_sum(dot8(ua[q], hf) + dot8(ub[q], hf + 8));
                const float act = gelu_erf(d);
                if (eb < 64) { if (lane == (eb & 63) + q) c0 = act * g0; } else { if (lane == (eb & 63) + q) c1 = act * g1; } }
        }
        float acc[16];
#pragma unroll
        for (int i = 0; i < 16; ++i) acc[i] = 0.f;
#pragma unroll 1
        for (int eb = 0; eb < 128; eb += 8) {
            u32x4 va[8], vb[8]; float cf[8];
#pragma unroll
            for (int q = 0; q < 8; ++q) { const int e = __builtin_amdgcn_readlane(eb < 64 ? e0 : e1, (eb & 63) + q);
                cf[q] = __builtin_bit_cast(float, __builtin_amdgcn_readlane(__builtin_bit_cast(int, eb < 64 ? c0 : c1), (eb & 63) + q));
                const bf16_t* row = V + (size_t)e * DM; va[q] = *(const u32x4*)(row + 8 * lane); vb[q] = *(const u32x4*)(row + 512 + 8 * lane); }
#pragma unroll
            for (int q = 0; q < 8; ++q) { const float c = cf[q];
                acc[0] += c * bflo(va[q].x); acc[1] += c * bfhi(va[q].x); acc[2] += c * bflo(va[q].y); acc[3] += c * bfhi(va[q].y);
                acc[4] += c * bflo(va[q].z); acc[5] += c * bfhi(va[q].z); acc[6] += c * bflo(va[q].w); acc[7] += c * bfhi(va[q].w);
                acc[8] += c * bflo(vb[q].x); acc[9] += c * bfhi(vb[q].x); acc[10] += c * bflo(vb[q].y); acc[11] += c * bfhi(vb[q].y);
                acc[12] += c * bflo(vb[q].z); acc[13] += c * bfhi(vb[q].z); acc[14] += c * bflo(vb[q].w); acc[15] += c * bfhi(vb[q].w); }
        }
        float* orow = C.out + (size_t)t * DM;
        f32x4 x0 = *(f32x4*)(orow + 8 * lane), x1 = *(f32x4*)(orow + 8 * lane + 4), x2 = *(f32x4*)(orow + 512 + 8 * lane), x3 = *(f32x4*)(orow + 512 + 8 * lane + 4);
        x0 += (f32x4){acc[0], acc[1], acc[2], acc[3]}; x1 += (f32x4){acc[4], acc[5], acc[6], acc[7]}; x2 += (f32x4){acc[8], acc[9], acc[10], acc[11]}; x3 += (f32x4){acc[12], acc[13], acc[14], acc[15]};
        *(f32x4*)(orow + 8 * lane) = x0; *(f32x4*)(orow + 8 * lane + 4) = x1; *(f32x4*)(orow + 512 + 8 * lane) = x2; *(f32x4*)(orow + 512 + 8 * lane + 4) = x3;
    }
}

struct EpiResF32 {
    static constexpr bool PERM = false, AFTER_DRAIN = false;
    const float* R; float* Cc; int ldc;
    __device__ __forceinline__ void operator()(const pg8::f32x4 (&acc)[2][2][4][2], const pg8::Unit& u, int wr, int wc, int fr, int fq) const {
        int fr_ = fr, fq_ = fq; asm volatile("" : "+v"(fr_), "+v"(fq_));
        const int row0 = u.pm * 256 + wr * 64 + fr_, col0 = u.pn * 256 + wc * 32 + 4 * fq_;
#pragma unroll
        for (int ai = 0; ai < 2; ++ai)
#pragma unroll
            for (int m = 0; m < 4; ++m) { const size_t ro = (size_t)(row0 + ai * 128 + m * 16) * ldc + col0;
#pragma unroll
                for (int bj = 0; bj < 2; ++bj)
#pragma unroll
                    for (int n = 0; n < 2; ++n) { const pg8::f32x4 r = *(const pg8::f32x4*)(R + ro + bj * 128 + n * 16); *(pg8::f32x4*)(Cc + ro + bj * 128 + n * 16) = acc[ai][bj][m][n] + r; } __builtin_amdgcn_sched_barrier(0); }
    }
};
struct EpiGlu {
    static constexpr bool PERM = false, AFTER_DRAIN = false;
    const bf16_t* YG; const float* bias; float* Gg;
    __device__ __forceinline__ void operator()(const pg8::f32x4 (&acc)[2][2][4][2], const pg8::Unit& u, int wr, int wc, int fr, int fq) const {
        int fr_ = fr, fq_ = fq; asm volatile("" : "+v"(fr_), "+v"(fq_));
        const int row0 = u.pm * 256 + wr * 64 + fr_, col0 = wc * 32 + 4 * fq_;
#pragma unroll
        for (int ai = 0; ai < 2; ++ai)
#pragma unroll
            for (int m = 0; m < 4; ++m) { const size_t ro = (size_t)(row0 + ai * 128 + m * 16) * 256 + col0;
#pragma unroll
                for (int bj = 0; bj < 2; ++bj)
#pragma unroll
                    for (int n = 0; n < 2; ++n) { const size_t o = ro + bj * 128 + n * 16; const pg8::f32x4 bv = *(const pg8::f32x4*)(bias + col0 + bj * 128 + n * 16);
                        const u32x2 y = *(const u32x2*)(YG + o); const pg8::f32x4 a = acc[ai][bj][m][n] + bv;
                        pg8::f32x4 r; r.x = bflo(y.x) * sigmoidf_(a.x); r.y = bfhi(y.x) * sigmoidf_(a.y); r.z = bflo(y.y) * sigmoidf_(a.z); r.w = bfhi(y.y) * sigmoidf_(a.w);
                        *(pg8::f32x4*)(Gg + o) = r; } __builtin_amdgcn_sched_barrier(0); }
    }
};

#ifndef MK_ONLY
#define MK_ONLY -1
#endif
#define PH_EN(k) ((MK_ONLY) < 0 || (MK_ONLY) == (k))
constexpr int PH_PER_LAYER = 13, NPHASES = 1 + DEPTH * PH_PER_LAYER;
__global__ void __launch_bounds__(NTHR, 2) fwd(Args args) {
    extern __shared__ __attribute__((aligned(16))) unsigned char lds_raw[];
    Ctx C;
    C.in = args.in; C.out = args.out; C.ws = args.ws; C.lds = (char*)lds_raw;
    C.G = gridDim.x; { const int bx = blockIdx.x; C.vcu = (C.G % 8 == 0) ? (bx % 8) * (C.G / 8) + bx / 8 : bx; }
    C.NGW = C.G * NWAVES; C.wave = __builtin_amdgcn_readfirstlane((int)threadIdx.x >> 6);
    volatile LAS unsigned* MISC = (volatile LAS unsigned*)((LAS unsigned char*)lds_raw + MISC_OFF);
    if (threadIdx.x < 64) MISC[threadIdx.x] = 0u;
    __syncthreads();
    XcdBarrier bar; bar.bar = (unsigned*)(args.ws + WS_CTL) + 4096; bar.x = 0; bar.st = MISC + 8;
    const bool multi = (args.ph_hi - args.ph_lo) > 1;
    if (multi) bar = xcd_barrier_post((unsigned*)(args.ws + WS_CTL) + 4096, MISC + 8);
    LAS unsigned char* ldsp = (LAS unsigned char*)lds_raw;

    if (args.ph_lo == 0) { if (PH_EN(100)) phase_prologue(C); if (args.ph_hi > 1) xcd_barrier(bar, C.wave); }
    for (int ph = (args.ph_lo > 1 ? args.ph_lo : 1); ph < args.ph_hi; ++ph) {
        {
            const int l = (ph - 1) / PH_PER_LAYER, k = (ph - 1) % PH_PER_LAYER;
            const float* xres = (l == 0) ? (const float*)args.in[I_X] : (const float*)args.out;
            switch (k) {
            case 0: if (PH_EN(0)) phase_rmsnorm(C, xres, INF(I_NORM_MIX) + l * DM, (bf16_t*)(C.ws + WS_H)); break;
            case 1: if (PH_EN(1)) { pg8::Gemm g{(const bf16_t*)(C.ws + WS_H), (const bf16_t*)(C.ws + WS_WTIN) + (size_t)l * INCP * DM, T, INCP, DM}; pg8::StaticOrder S; S.init(T, INCP, C.G, (int)blockIdx.x);
                      pg8::EpiBf16<0> E{(bf16_t*)(C.ws + WS_COLS), INCP, nullptr, 0, 0};
                      pg8::gemm_phase<pg8::EpiBf16<0>, pg8::StaticOrder>(ldsp, g, S, E, nullptr, C.wave); } break;
            case 2: if (PH_EN(2)) phase_prep(C, l); break;
            case 3: if (PH_EN(3)) phase_attn(C, l); break;
            case 4: if (PH_EN(4)) phase_ssm(C, l); break;
            case 5: if (PH_EN(5)) phase_rwkv(C, l); break;
            case 6: if (PH_EN(6)) { pg8::Gemm g{(const bf16_t*)(C.ws + WS_YG), (const bf16_t*)(C.ws + WS_WTGLU) + (size_t)l * 256 * 256, T, 256, 256}; pg8::StaticOrder S; S.init(T, 256, C.G, (int)blockIdx.x);
                      EpiGlu E{(const bf16_t*)(C.ws + WS_YG), INF(I_BGLU) + l * 256, (float*)(C.ws + WS_GLU)};
                      pg8::gemm_phase<EpiGlu, pg8::StaticOrder>(ldsp, g, S, E, nullptr, C.wave); } break;
            case 7: if (PH_EN(7)) phase_post(C, l); break;
            case 8: if (PH_EN(8)) { pg8::Gemm g{(const bf16_t*)(C.ws + WS_MIXED), (const bf16_t*)(C.ws + WS_WTOUT) + (size_t)l * DM * DM, T, DM, DM}; pg8::StaticOrder S; S.init(T, DM, C.G, (int)blockIdx.x);
                      EpiResF32 E{xres, args.out, DM};
                      pg8::gemm_phase<EpiResF32, pg8::StaticOrder>(ldsp, g, S, E, nullptr, C.wave); } break;
            case 9: if (PH_EN(9)) phase_rmsnorm(C, args.out, INF(I_NORM_FFN) + l * DM, (bf16_t*)(C.ws + WS_H)); break;
            case 10: if (PH_EN(10)) { pg8::Gemm g{(const bf16_t*)(C.ws + WS_H), (const bf16_t*)(C.ws + WS_WTQ) + (size_t)l * 2048 * DM, T, 2048, DM}; pg8::StaticOrder S; S.init(T, 2048, C.G, (int)blockIdx.x);
                       pg8::EpiBf16<0> E{(bf16_t*)(C.ws + WS_QP), 2048, nullptr, 0, 0};
                       pg8::gemm_phase<pg8::EpiBf16<0>, pg8::StaticOrder>(ldsp, g, S, E, nullptr, C.wave); } break;
            case 11: if (PH_EN(11)) phase_topk(C, l); break;
            case 12: if (PH_EN(12)) phase_gather(C, l); break;
            }
        }
        if (ph + 1 < args.ph_hi) xcd_barrier(bar, C.wave);
    }
}
}

extern "C" void kernel_launch(void* const* d_in, const int* in_sizes, int n_in, void* d_out, int out_size, void* d_ws, size_t ws_size, hipStream_t stream) {
    using namespace mk;
    static int grid = 0;
    if (grid == 0) {
        if (n_in != N_IN || out_size != T * DM || ws_size < WS_END) { fprintf(stderr, "kernel_launch: unexpected shapes (n_in %d, out %d, ws %zu)\n", n_in, out_size, ws_size); grid = -1; return; }
        int dev = 0, cus = 0;
        if (hipGetDevice(&dev) != hipSuccess || hipDeviceGetAttribute(&cus, hipDeviceAttributeMultiprocessorCount, dev) != hipSuccess) { grid = -1; return; }
        if (hipFuncSetAttribute((const void*)fwd, hipFuncAttributeMaxDynamicSharedMemorySize, LDS_BYTES) != hipSuccess) { fprintf(stderr, "kernel_launch: hipFuncSetAttribute failed\n"); grid = -1; return; }
        int per_cu = 0;
        if (hipOccupancyMaxActiveBlocksPerMultiprocessor(&per_cu, (const void*)fwd, NTHR, LDS_BYTES) != hipSuccess || per_cu < 1) fprintf(stderr, "kernel_launch: occupancy query says %d\n", per_cu);
        (void)hipGetLastError();
        grid = cus;
    }
    if (grid < 0) return;
    (void)hipMemsetAsync((char*)d_ws + WS_CTL, 0, CTL_BYTES, stream);
    Args a{};
    for (int i = 0; i < N_IN; ++i) a.in[i] = d_in[i];
    a.out = (float*)d_out; a.ws = (unsigned char*)d_ws;
#if MK_DEBUG
    {
        auto run = [&](int p) { a.ph_lo = p; a.ph_hi = p + 1; hipLaunchKernelGGL(fwd, dim3(grid), dim3(NTHR), LDS_BYTES, stream, a); };
        auto chk = [&](int stage, int blocks, int thr, int ldsb) { hipLaunchKernelGGL(dbg_check, dim3(blocks), dim3(thr), ldsb, stream, a, stage, (int)MK_DBG_LAYER); };
        static bool attr = false; if (!attr) { (void)hipFuncSetAttribute((const void*)dbg_check, hipFuncAttributeMaxDynamicSharedMemorySize, 65536); attr = true; }
        run(0); chk(20, 1, 256, 0);
        for (int l = 0; l < MK_DBG_LAYER; ++l) for (int k = 0; k < PH_PER_LAYER; ++k) run(1 + l * PH_PER_LAYER + k);
        const int base = 1 + MK_DBG_LAYER * PH_PER_LAYER;
        run(base + 0); chk(1, 8, 256, 0);
        run(base + 1); chk(2, 16, 256, 0); chk(34, 16, 256, 0); chk(35, 64, 256, 0); chk(37, 64, 256, 0);
        run(base + 2); chk(46, 256, 256, 0); chk(38, 16, 256, 0); chk(3, 2, 256, 65536); chk(4, 2, 256, 0);
        run(base + 3); chk(5, 16, 256, 0);
        run(base + 4); chk(6, 1, 256, 0);
        run(base + 5); chk(7, 1, 256, 0);
        run(base + 6); run(base + 7); chk(8, 4, 64, 65536); chk(9, 4, 256, 0);
        run(base + 8); chk(10, 16, 256, 0);
        run(base + 9); chk(11, 8, 256, 0);
        run(base + 10); chk(12, 16, 256, 0);
        run(base + 11); chk(61, 4, 256, 65536); chk(13, 8, 64, 65536); chk(140, 4, 256, 0);
        run(base + 12); chk(14, 4, 256, 0);
#ifdef MK_DBG_VAL
        hipLaunchKernelGGL(dbg_encode_val, dim3(1024), dim3(256), 0, stream, a, MK_DBG_VAL);
#elif defined(MK_DBG_LVL)
        hipLaunchKernelGGL(dbg_encode_lvl, dim3(1024), dim3(256), 0, stream, a, MK_DBG_LVL);
#else
        hipLaunchKernelGGL(dbg_encode, dim3(1024), dim3(256), 0, stream, a, MK_DBG_SET);
#endif
    }
#elif MK_ONE_LAUNCH
    a.ph_lo = 0; a.ph_hi = NPHASES;
    hipLaunchKernelGGL(fwd, dim3(grid), dim3(NTHR), LDS_BYTES, stream, a);
#else
    for (int p = 0; p < NPHASES; ++p) { a.ph_lo = p; a.ph_hi = p + 1; hipLaunchKernelGGL(fwd, dim3(grid), dim3(NTHR), LDS_BYTES, stream, a); }
#endif
}
```

```cpp
#include <hip/hip_runtime.h>
#include <cstdio>
#include <cstdint>
#define MK_ONE_LAUNCH 1
#ifndef MK_ONE_LAUNCH
#define MK_ONE_LAUNCH 0
#endif
#ifndef MK_DEBUG
#define MK_DEBUG 0
#endif
#ifndef MK_DBG_LAYER
#define MK_DBG_LAYER 0
#endif
#ifndef MK_DBG_SET
#define MK_DBG_SET 5,6,7,13,14,4
#endif
namespace pg8 {
#define PG8_LAS __attribute__((address_space(3)))
typedef unsigned short bf16_t;
typedef short bf16x8 __attribute__((ext_vector_type(8)));
typedef float f32x4 __attribute__((ext_vector_type(4)));
typedef unsigned u32x4 __attribute__((ext_vector_type(4)));
constexpr int BM = 256, BK = 64, HALF = 128, HTB = HALF * BK * 2  , STAGE_BYTES = 8 * HTB, NXCD = 8, WGM = 8;

__host__ __device__ __forceinline__ int lds_byte(int r, int c) { const int st = (r >> 4) * 2 + (c >> 5), rr = r & 15, cc = c & 31, ob = rr * 64 + cc * 2; return st * 1024 + (ob ^ (((ob >> 9) & 1) << 5)); }
__host__ __device__ __forceinline__ void stage_rc(int b, int& R, int& C) { const int st = b / 1024, sb = b % 1024, swz = sb ^ (((sb >> 9) & 1) << 5); R = (st >> 1) * 16 + swz / 64; C = (st & 1) * 32 + (swz % 64) / 2; }
__host__ __device__ __forceinline__ int perm32(int rho) { const int n = rho >> 4, i = rho & 15; return 8 * (i >> 2) + 4 * n + (i & 3); }

struct Unit { int pm, pn; };
struct Gemm { const bf16_t* A; const bf16_t* Bt; int M, N, K; };

struct StaticOrder {
    int nM, nN, nwg, G, c;
    __host__ __device__ void init(int M, int N, int G_, int c_) { nM = M / BM; nN = N / BM; nwg = nM * nN; G = G_; c = c_; }
    __host__ __device__ bool next(int i, Unit& u) const {
        const long L = (long)i * G + c; if (L >= nwg) return false;
        int wgid = (int)L; { const int q = nwg / NXCD, r = nwg % NXCD, xcd = wgid % NXCD, off = wgid / NXCD; wgid = (xcd < r ? xcd * (q + 1) : r * (q + 1) + (xcd - r) * q) + off; }
        const int nig = WGM * nN, gid = wgid / nig, fm = gid * WGM, gsz = (nM - fm) < WGM ? (nM - fm) : WGM;
        u.pm = fm + ((wgid % nig) % gsz); u.pn = (wgid % nig) / gsz; return true;
    }
    __device__ __forceinline__ void a_ready(const Unit&) const {}
    __device__ __forceinline__ void done(const Unit&) const {}
};

__device__ __forceinline__ unsigned cvt_pk_bf16(float lo, float hi) { unsigned r; asm volatile("v_cvt_pk_bf16_f32 %0, %1, %2" : "=v"(r) : "v"(lo), "v"(hi)); return r; }
typedef float f32x2 __attribute__((ext_vector_type(2)));
__device__ __forceinline__ f32x2 gelu_pk(f32x2 v) {
    const f32x2 av = __builtin_elementwise_abs(v), d = av * 0.2316418882f + 1.0f;
    f32x2 t; t.x = __builtin_amdgcn_rcpf(d.x); t.y = __builtin_amdgcn_rcpf(d.y);
    f32x2 q = t * 0.5307027145f + (-0.7265760135f); q = q * t + 0.7107068705f; q = q * t + (-0.142248368f); q = q * t + 0.127414796f; q = q * t;
    const f32x2 s = (v * v) * (-0.72134752044f);
    f32x2 e; e.x = __builtin_amdgcn_exp2f(s.x); e.y = __builtin_amdgcn_exp2f(s.y);
    const f32x2 m = v * (q * e), r = v - m;
    f32x2 o; o.x = v.x < 0.f ? m.x : r.x; o.y = v.y < 0.f ? m.y : r.y; return o;
}

struct EpiF32 {
    static constexpr bool PERM = false, AFTER_DRAIN = false;
    float* C; int ldc; const float* bias;
    __device__ __forceinline__ void operator()(const f32x4 (&acc)[2][2][4][2], const Unit& u, int wr, int wc, int fr, int fq) const {
        const int row0 = u.pm * BM + wr * 64 + fr, col0 = u.pn * BM + wc * 32 + 4 * fq;
        f32x4 bv[2][2];
#pragma unroll
        for (int bj = 0; bj < 2; ++bj)
#pragma unroll
            for (int n = 0; n < 2; ++n) bv[bj][n] = bias ? *(const f32x4*)(bias + col0 + bj * HALF + n * 16) : (f32x4){0.f, 0.f, 0.f, 0.f};
#pragma unroll
        for (int ai = 0; ai < 2; ++ai)
#pragma unroll
            for (int m = 0; m < 4; ++m) { float* rowp = C + (size_t)(row0 + ai * HALF + m * 16) * ldc + col0;
#pragma unroll
                for (int bj = 0; bj < 2; ++bj)
#pragma unroll
                    for (int n = 0; n < 2; ++n) *(f32x4*)(rowp + bj * HALF + n * 16) = acc[ai][bj][m][n] + bv[bj][n]; }
    }
};
template <int ACT  > struct EpiBf16 {
    static constexpr bool PERM = true, AFTER_DRAIN = false;
    bf16_t* O; int ldc; const float* bias; int split_cols; size_t split_stride;
    __device__ __forceinline__ void operator()(const f32x4 (&acc)[2][2][4][2], const Unit& u, int wr, int wc, int fr_in, int fq_in) const {
        int ln_; asm volatile("v_mbcnt_lo_u32_b32 %0, -1, 0\n\tv_mbcnt_hi_u32_b32 %0, -1, %0" : "=v"(ln_)); const int fr = ln_ & 15, fq = ln_ >> 4; (void)fr_in; (void)fq_in;
        const int row0 = u.pm * BM + wr * 64 + fr; int colt = u.pn * BM; bf16_t* base = O;
        if (split_cols) { const int t = colt / split_cols; base += (size_t)t * split_stride; colt -= t * split_cols; }
        const int col0 = colt + wc * 32 + 8 * fq, bcol0 = u.pn * BM + wc * 32 + 8 * fq;
        f32x4 bv[2][2];
#pragma unroll
        for (int bj = 0; bj < 2; ++bj)
#pragma unroll
            for (int n = 0; n < 2; ++n) bv[bj][n] = bias ? *(const f32x4*)(bias + bcol0 + bj * HALF + 4 * n) : (f32x4){0.f, 0.f, 0.f, 0.f};
#pragma unroll
        for (int ai = 0; ai < 2; ++ai)
#pragma unroll
            for (int m = 0; m < 4; ++m) { bf16_t* rowp = base + (size_t)(row0 + ai * HALF + m * 16) * ldc + col0;
#pragma unroll
                for (int bj = 0; bj < 2; ++bj) { f32x4 v0 = acc[ai][bj][m][0] + bv[bj][0], v1 = acc[ai][bj][m][1] + bv[bj][1];
                    if (ACT == 1) { f32x2 a = gelu_pk((f32x2){v0[0], v0[1]}), b = gelu_pk((f32x2){v0[2], v0[3]}), c = gelu_pk((f32x2){v1[0], v1[1]}), d = gelu_pk((f32x2){v1[2], v1[3]});
                        v0 = (f32x4){a.x, a.y, b.x, b.y}; v1 = (f32x4){c.x, c.y, d.x, d.y}; }
                    if (ACT == 2) {
#pragma unroll
                        for (int j = 0; j < 4; ++j) { v0[j] = 0.5f * v0[j] * (1.0f + erff(v0[j] * 0.70710678f)); v1[j] = 0.5f * v1[j] * (1.0f + erff(v1[j] * 0.70710678f)); } }
                    u32x4 w; w.x = cvt_pk_bf16(v0[0], v0[1]); w.y = cvt_pk_bf16(v0[2], v0[3]); w.z = cvt_pk_bf16(v1[0], v1[1]); w.w = cvt_pk_bf16(v1[2], v1[3]);
                    *(u32x4*)(rowp + bj * HALF) = w; } }
    }
};

template <class Epi, class Sched, bool STAMP = false>
__device__ __forceinline__ void gemm_phase(PG8_LAS unsigned char* lds, const Gemm g, const Sched& S, const Epi& E, unsigned long long* stamps, int wave_in) {
    int lane_; asm volatile("v_mbcnt_lo_u32_b32 %0, -1, 0\n\tv_mbcnt_hi_u32_b32 %0, -1, %0" : "=v"(lane_)); const int tid = wave_in * 64 + lane_; const int wid = wave_in, lane = tid & 63, wr = wid >> 2, wc = wid & 3, fr = lane & 15, fq = lane >> 4;
    const int K = g.K, nt = K / BK;
    int ts_lo = 0, ts_hi = 0, nts = 0; const unsigned long long rt_entry = STAMP ? (unsigned long long)wall_clock64() : 0ull;
#define PG8_STAMP() do { if (STAMP && wid == 0 && nts < 64) { const unsigned long long _c = (unsigned long long)clock64(); \
        ts_lo = (lane == nts) ? (int)(unsigned)_c : ts_lo; ts_hi = (lane == nts) ? (int)(unsigned)(_c >> 32) : ts_hi; ++nts; } } while (0)
    PG8_STAMP();
    unsigned voffA[2], voffB[2];
#pragma unroll
    for (int i = 0; i < 2; ++i) { int R, C; stage_rc(tid * 16 + i * 8192, R, C); const int Rb = Epi::PERM ? ((R & ~31) + perm32(R & 31)) : R;
        voffA[i] = (unsigned)(R * K + C) * 2u; voffB[i] = (unsigned)(Rb * K + C) * 2u; }
    const size_t kstep = (size_t)(BK * 2);
    const size_t hstep = (size_t)HALF * K * 2;
    const size_t tstep = 2 * hstep;
    const unsigned ldsw = (unsigned)wid * 1024u;
    const int aoff = lds_byte(wr * 64 + fr, fq * 8), boff = lds_byte(wc * 32 + fr, fq * 8);
#define PG8_SA(b, h) (((b) * 2 + (h)) * HTB)
#define PG8_SB(b, h) ((4 + (b) * 2 + (h)) * HTB)
#define PG8_STAGE(bufoff, gbase, voff) do { _Pragma("unroll") for (int _i = 0; _i < 2; ++_i) \
        __builtin_amdgcn_global_load_lds((const unsigned*)((const char*)(gbase) + (voff)[_i]), (PG8_LAS unsigned*)(lds + (bufoff) + ldsw + _i * 8192), 16, 0, 0); } while (0)
#define PG8_LDA(dst, b, h) do { _Pragma("unroll") for (int m = 0; m < 4; ++m) _Pragma("unroll") for (int k = 0; k < 2; ++k) dst[m][k] = *(const PG8_LAS bf16x8*)(lds + PG8_SA(b, h) + aoff + m * 2048 + k * 1024); } while (0)
#define PG8_LDB(dst, b, h) do { _Pragma("unroll") for (int n = 0; n < 2; ++n) _Pragma("unroll") for (int k = 0; k < 2; ++k) dst[n][k] = *(const PG8_LAS bf16x8*)(lds + PG8_SB(b, h) + boff + n * 2048 + k * 1024); } while (0)
#define PG8_MMA(ai, bj, At, Bt) do { __builtin_amdgcn_s_setprio(1); _Pragma("unroll") for (int m = 0; m < 4; ++m) _Pragma("unroll") for (int n = 0; n < 2; ++n) _Pragma("unroll") for (int k = 0; k < 2; ++k) \
        acc[ai][bj][m][n] = __builtin_amdgcn_mfma_f32_16x16x32_bf16(Bt[n][k], At[m][k], acc[ai][bj][m][n], 0, 0, 0); __builtin_amdgcn_s_setprio(0); } while (0)
#define PG8_WAIT_V(n) asm volatile("s_waitcnt vmcnt(" #n ")" ::: "memory")
#define PG8_WAIT_L(n) asm volatile("s_waitcnt lgkmcnt(" #n ")" ::: "memory")
#define PG8_BAR __builtin_amdgcn_s_barrier()
#define PG8_SCHED __builtin_amdgcn_sched_barrier(0)
    Unit cur, nxt; int ui = 0;
    if (!S.next(0, cur)) return;
    f32x4 acc[2][2][4][2];
#pragma unroll
    for (int a = 0; a < 2; ++a)
#pragma unroll
        for (int b = 0; b < 2; ++b)
#pragma unroll
            for (int m = 0; m < 4; ++m)
#pragma unroll
                for (int n = 0; n < 2; ++n) acc[a][b][m][n] = (f32x4){0.f, 0.f, 0.f, 0.f};
    bf16x8 At[4][2], B0[2][2], B1[2][2];
    const char* cA = (const char*)g.A + (size_t)cur.pm * tstep; const char* cB = (const char*)g.Bt + (size_t)cur.pn * tstep;
    S.a_ready(cur);
    PG8_STAGE(PG8_SB(0, 0), cB, voffB); PG8_STAGE(PG8_SA(0, 0), cA, voffA); PG8_STAGE(PG8_SB(0, 1), cB + hstep, voffB); PG8_STAGE(PG8_SA(0, 1), cA + hstep, voffA);
    if (wr == 1) PG8_BAR;
    PG8_WAIT_V(4); PG8_BAR;
    PG8_STAGE(PG8_SB(1, 0), cB + kstep, voffB); PG8_STAGE(PG8_SA(1, 0), cA + kstep, voffA); PG8_STAGE(PG8_SB(1, 1), cB + hstep + kstep, voffB);
    PG8_WAIT_V(6); PG8_BAR;
    PG8_STAMP();
    for (;;) {
        const bool has_next = S.next(ui + 1, nxt);
        const char* nA = has_next ? (const char*)g.A + (size_t)nxt.pm * tstep : cA; const char* nB = has_next ? (const char*)g.Bt + (size_t)nxt.pn * tstep : cB;
        for (int t = 0; t < nt; t += 2) {
            const bool last = (t == nt - 2);
            const char* a1 = cA + (size_t)(t + 1) * kstep;
            const char* a2 = last ? nA : cA + (size_t)(t + 2) * kstep; const char* b2 = last ? nB : cB + (size_t)(t + 2) * kstep;
            const char* a3 = a2 + kstep; const char* b3 = b2 + kstep;
            if (last && has_next) S.a_ready(nxt);
            PG8_LDB(B0, 0, 0); PG8_SCHED; PG8_LDA(At, 0, 0); PG8_STAGE(PG8_SA(1, 1), a1 + hstep, voffA);
            PG8_WAIT_L(8); PG8_BAR; PG8_WAIT_L(0); PG8_MMA(0, 0, At, B0); PG8_BAR; PG8_SCHED;
            PG8_LDB(B1, 0, 1); PG8_STAGE(PG8_SB(0, 0), b2, voffB);
            PG8_BAR; PG8_WAIT_L(0); PG8_MMA(0, 1, At, B1); PG8_BAR;
            PG8_LDA(At, 0, 1); PG8_STAGE(PG8_SA(0, 0), a2, voffA);
            PG8_BAR; PG8_WAIT_L(0); PG8_MMA(1, 0, At, B0); PG8_BAR; PG8_SCHED;
            PG8_STAGE(PG8_SB(0, 1), b2 + hstep, voffB);
            PG8_WAIT_V(6); PG8_BAR; PG8_MMA(1, 1, At, B1); PG8_BAR;
            PG8_LDB(B0, 1, 0); PG8_SCHED; PG8_LDA(At, 1, 0); PG8_STAGE(PG8_SA(0, 1), a2 + hstep, voffA);
            PG8_WAIT_L(8); PG8_BAR; PG8_WAIT_L(0); PG8_MMA(0, 0, At, B0); PG8_BAR; PG8_SCHED;
            PG8_LDB(B1, 1, 1); PG8_STAGE(PG8_SB(1, 0), b3, voffB);
            PG8_BAR; PG8_WAIT_L(0); PG8_MMA(0, 1, At, B1); PG8_BAR;
            PG8_LDA(At, 1, 1); PG8_STAGE(PG8_SA(1, 0), a3, voffA);
            PG8_BAR; PG8_WAIT_L(0); PG8_MMA(1, 0, At, B0); PG8_BAR; PG8_SCHED;
            PG8_STAGE(PG8_SB(1, 1), b3 + hstep, voffB);
            PG8_WAIT_V(6); PG8_BAR; PG8_MMA(1, 1, At, B1); PG8_BAR;
        }
        PG8_STAMP();
        if constexpr (!Epi::AFTER_DRAIN) { E(acc, cur, wr, wc, fr, fq); S.done(cur); }
        PG8_STAMP();
        if (!has_next) break;
#pragma unroll
        for (int a = 0; a < 2; ++a)
#pragma unroll
            for (int b = 0; b < 2; ++b)
#pragma unroll
                for (int m = 0; m < 4; ++m)
#pragma unroll
                    for (int n = 0; n < 2; ++n) acc[a][b][m][n] = (f32x4){0.f, 0.f, 0.f, 0.f};
        cur = nxt; cA = nA; cB = nB; ++ui;
    }
    PG8_WAIT_V(0);
    if (wr == 0) PG8_BAR;
    PG8_BAR;
    if constexpr (Epi::AFTER_DRAIN) { E.fused(acc, cur, wr, wc, fr, fq, lds, wid, lane); S.done(cur); }
    PG8_STAMP();
    if (STAMP && wid == 0) { stamps[lane] = lane < nts ? (((unsigned long long)(unsigned)ts_hi << 32) | (unsigned)ts_lo) : 0ull;
        if (lane == 62) stamps[62] = rt_entry; if (lane == 63) stamps[63] = (unsigned long long)wall_clock64(); }
#undef PG8_STAMP
#undef PG8_SA
#undef PG8_SB
#undef PG8_STAGE
#undef PG8_LDA
#undef PG8_LDB
#undef PG8_MMA
#undef PG8_WAIT_V
#undef PG8_WAIT_L
#undef PG8_BAR
#undef PG8_SCHED
}
}

namespace mk {
#define DI __device__ __forceinline__
#define LAS __attribute__((address_space(3)))
typedef unsigned short bf16_t;
typedef float f32x4 __attribute__((ext_vector_type(4)));
typedef float f32x2 __attribute__((ext_vector_type(2)));
typedef float f32x16 __attribute__((ext_vector_type(16)));
typedef short bf16x8 __attribute__((ext_vector_type(8)));
typedef short s16x4 __attribute__((ext_vector_type(4)));
typedef unsigned u32x4 __attribute__((ext_vector_type(4)));
typedef unsigned u32x2 __attribute__((ext_vector_type(2)));

constexpr int NB = 8, SEQ = 4096, T = NB * SEQ, DM = 1024, DEPTH = 4;
constexpr int INC = 2688, INCP = 2816;
constexpr int NEXP = 16384;
constexpr float NORM_EPS = 1e-6f;
constexpr int NWAVES = 8, NTHR = 512;

enum { I_X = 0, I_POS, I_NORM_MIX, I_W_IN, I_QN, I_KN, I_LAM, I_SUBLN, I_SLRE, I_SLIM, I_SBRE, I_SBIM, I_SCRE, I_SCIM, I_SD, I_SLOGDT,
       I_WGLU, I_BGLU, I_SONORM, I_MU, I_DECUP, I_DECW0, I_AAAUP, I_AAAA0, I_GATEUP, I_KK, I_KA, I_RK, I_LNW, I_LNB, I_WOUT, I_NORM_FFN,
       I_WQ, I_SUBK, I_PU, I_PV, N_IN };

constexpr size_t MiB = 1u << 20;
constexpr size_t WS_CTL = 0, CTL_BYTES = 1 * MiB;
constexpr size_t WS_WTIN = 1 * MiB;
constexpr size_t WS_WTOUT = WS_WTIN + 22 * MiB;
constexpr size_t WS_WTQ = WS_WTOUT + 8 * MiB;
constexpr size_t WS_WTGLU = WS_WTQ + 16 * MiB;
constexpr size_t WS_SUBK = WS_WTGLU + 1 * MiB;
constexpr size_t WS_ROPE = WS_SUBK + 2 * MiB;
constexpr size_t WS_SSMP = WS_ROPE + 2 * MiB;
constexpr size_t WS_U8 = WS_SSMP + 1 * MiB;
constexpr size_t WS_V8 = WS_U8 + 64 * MiB;
constexpr size_t WS_SU = WS_V8 + 64 * MiB;
constexpr size_t WS_SV = WS_SU + 1 * MiB;
constexpr size_t WS_H = WS_SV + 1 * MiB;
constexpr size_t WS_COLS = WS_H + 64 * MiB;
constexpr size_t WS_MIXED = WS_COLS + 176 * MiB;
constexpr size_t WS_X = WS_MIXED + 64 * MiB;
constexpr size_t WS_RW = WS_X;
constexpr size_t WS_RWW = WS_X + 96 * MiB;
constexpr size_t WS_PART = WS_X;
constexpr size_t WS_QP = WS_X, WS_IDX = WS_X + 128 * MiB, WS_GATE = WS_IDX + 16 * MiB, WS_COEF = WS_GATE + 16 * MiB;
constexpr size_t WS_YG = WS_X + 224 * MiB;
constexpr size_t WS_GLU = WS_YG + 16 * MiB;
constexpr size_t WS_RWY = WS_GLU + 32 * MiB;
constexpr size_t WS_RWC = WS_RWY + 32 * MiB;
constexpr size_t WS_RWS = WS_H;
constexpr size_t WS_H8 = WS_COLS;
constexpr size_t WS_END = WS_RWC + 192 * MiB;
static_assert(WS_END <= 1024 * MiB, "workspace map");
constexpr int SSMP_STRIDE = 2048 + 2 * 16 * 16 * 64;

constexpr int LDS_BYTES = 155648;
constexpr int MISC_OFF = LDS_BYTES - 256;

DI unsigned f2bf(float f) { unsigned u = __builtin_bit_cast(unsigned, f); return (u + 0x7fffu + ((u >> 16) & 1u)) >> 16; }
DI unsigned pk2(float lo, float hi) { return f2bf(lo) | (f2bf(hi) << 16); }
DI float bflo(unsigned w) { return __builtin_bit_cast(float, w << 16); }
DI float bfhi(unsigned w) { return __builtin_bit_cast(float, w & 0xffff0000u); }
DI float bf2f(bf16_t b) { return __builtin_bit_cast(float, ((unsigned)b) << 16); }
template <int CTRL> DI float dpp_f(float x) { return __builtin_bit_cast(float, __builtin_amdgcn_update_dpp(0, __builtin_bit_cast(int, x), CTRL, 0xF, 0xF, true)); }
DI float sum4(float x) { x += dpp_f<0xB1>(x); x += dpp_f<0x4E>(x); return x; }
DI float sum8(float x) { x = sum4(x); x += dpp_f<0x141>(x); return x; }
DI float sum16(float x) { x = sum8(x); x += dpp_f<0x140>(x); return x; }
DI float sum32(float x) { x = sum16(x); x += __builtin_bit_cast(float, __builtin_amdgcn_ds_swizzle(__builtin_bit_cast(int, x), 0x401F)); return x; }
DI float other_half(float x, int hi) { unsigned a = __builtin_bit_cast(unsigned, x), c = a; asm volatile("" : "+v"(c));
    auto r = __builtin_amdgcn_permlane32_swap(a, c, false, false);
    return __builtin_bit_cast(float, hi ? r[0] : r[1]); }
DI float sum_halves(float x, int hi) { return x + other_half(x, hi); }
DI float wave_sum(float v) { const float s = sum32(v);
    return __builtin_bit_cast(float, __builtin_amdgcn_readlane(__builtin_bit_cast(int, s), 0)) + __builtin_bit_cast(float, __builtin_amdgcn_readlane(__builtin_bit_cast(int, s), 32)); }
DI float wave_max(float v) {
    v = fmaxf(v, dpp_f<0xB1>(v)); v = fmaxf(v, dpp_f<0x4E>(v)); v = fmaxf(v, dpp_f<0x141>(v)); v = fmaxf(v, dpp_f<0x140>(v));
    v = fmaxf(v, __builtin_bit_cast(float, __builtin_amdgcn_ds_swizzle(__builtin_bit_cast(int, v), 0x401F)));
    return fmaxf(__builtin_bit_cast(float, __builtin_amdgcn_readlane(__builtin_bit_cast(int, v), 0)), __builtin_bit_cast(float, __builtin_amdgcn_readlane(__builtin_bit_cast(int, v), 32)));
}
DI float xor16(float v) { return __builtin_bit_cast(float, __builtin_amdgcn_ds_swizzle(__builtin_bit_cast(int, v), 0x401F)); }
DI float xor8(float v) { return dpp_f<0x128>(v); }
DI float sigmoidf_(float x) { return 1.f / (1.f + __expf(-x)); }
DI float gelu_erf(float x) { return 0.5f * x * (1.f + erff(x * 0.70710678118654752f)); }


DI void sincos_red(double r, double& s, double& c) {
    const double k = rint(r * 0.63661977236758134308); const double y = r - k * 1.57079632679489661923; const double y2 = y * y;
    double sp = -7.6471637318198164759e-13; sp = sp * y2 + 1.6059043836821614599e-10; sp = sp * y2 - 2.5052108385441718775e-8; sp = sp * y2 + 2.7557319223985890653e-6;
    sp = sp * y2 - 1.9841269841269841270e-4; sp = sp * y2 + 8.3333333333333333333e-3; sp = sp * y2 - 1.6666666666666666667e-1; const double sy = y + y * y2 * sp;
    double cp = 4.7794773323873852974e-14; cp = cp * y2 - 1.1470745597729724714e-11; cp = cp * y2 + 2.0876756987868098979e-9; cp = cp * y2 - 2.7557319223985890653e-7;
    cp = cp * y2 + 2.4801587301587301587e-5; cp = cp * y2 - 1.3888888888888888889e-3; cp = cp * y2 + 4.1666666666666666667e-2; cp = cp * y2 - 0.5; const double cy = 1.0 + y2 * cp;
    const int q = ((int)k) & 3;
    s = (q == 0) ? sy : (q == 1) ? cy : (q == 2) ? -sy : -cy;
    c = (q == 0) ? cy : (q == 1) ? -sy : (q == 2) ? -cy : sy;
}
#define XB_TMO      128
#define XB_XCNT(j)  (256  + 64 * (j))
#define XB_XSUB(j)  (1280 + 64 * (j))
#define XB_XGEN(j)  (2304 + 64 * (j))
#define XB_TOP      3328
#define XB_TOPGEN   3392
#define XCD_BAR_WORDS 3456
#define XB_SPIN_CAP (1u << 22)
DI unsigned xb_ld(unsigned* p)              { return __hip_atomic_load(p, __ATOMIC_RELAXED, __HIP_MEMORY_SCOPE_AGENT); }
DI unsigned xb_add(unsigned* p, unsigned v) { return __hip_atomic_fetch_add(p, v, __ATOMIC_RELAXED, __HIP_MEMORY_SCOPE_AGENT); }
DI unsigned xb_xcc_id() { return (unsigned)__builtin_amdgcn_s_getreg((3 << 11) | 20) & 0xFu; }
#define XB_SPIN(cond, bar) do { unsigned _sp = 0; while (cond) { __builtin_amdgcn_s_sleep(1); \
    if ((++_sp & 255u) == 0u) { if (xb_ld(&(bar)[XB_TMO])) break; if (_sp > XB_SPIN_CAP) { atomicAdd(&(bar)[XB_TMO], 1u); break; } } } } while (0)
struct XcdBarrier { unsigned* bar; unsigned x; volatile LAS unsigned* st; };
DI XcdBarrier xcd_barrier_post(unsigned* bar, volatile LAS unsigned* st) {
    XcdBarrier b; b.bar = bar; b.x = xb_xcc_id(); b.st = st;
    if (threadIdx.x == 0) (void)xb_add(&bar[XB_XCNT(b.x)], 1u);
    return b;
}
DI void xcd_barrier_complete(unsigned* bar, unsigned x, unsigned& nloc, unsigned& nx) {
    const unsigned G = gridDim.x * gridDim.y * gridDim.z;
    unsigned sum, cnt, mine, sp = 0u;
    for (;;) {
        sum = 0u; cnt = 0u; mine = 0u;
#pragma unroll
        for (unsigned j = 0; j < 16; ++j) { const unsigned c = xb_ld(&bar[XB_XCNT(j)]); sum += c; cnt += (c > 0u) ? 1u : 0u; mine = (j == x) ? c : mine; }
        if (sum == G) break;
        __builtin_amdgcn_s_sleep(1);
        if ((++sp & 255u) == 0u) { if (xb_ld(&bar[XB_TMO])) break; if (sp > XB_SPIN_CAP) { atomicAdd(&bar[XB_TMO], 1u); break; } }
    }
    nloc = mine > 0u ? mine : 1u; nx = cnt > 0u ? cnt : 1u;
}
DI void xcd_barrier(const XcdBarrier& b, int wave) {
    asm volatile("s_waitcnt vmcnt(0)" ::: "memory");
    __syncthreads();
    int ln_; asm volatile("v_mbcnt_lo_u32_b32 %0, -1, 0\n\tv_mbcnt_hi_u32_b32 %0, -1, %0" : "=v"(ln_));
    if (wave == 0 && ln_ == 0) {
        unsigned* bar = b.bar;
        __builtin_amdgcn_s_waitcnt(0);
        unsigned nloc = b.st[0], nx = b.st[1];
        if (nloc == 0u) { xcd_barrier_complete(bar, b.x, nloc, nx); b.st[0] = nloc; b.st[1] = nx; }
        const unsigned old = xb_add(&bar[XB_XSUB(b.x)], 1u);
        const unsigned gen = old / nloc;
        if (old + 1u == (gen + 1u) * nloc) {
            __builtin_amdgcn_fence(__ATOMIC_RELEASE, "agent");
            asm volatile("s_waitcnt vmcnt(0)" ::: "memory");
            const unsigned og = xb_add(&bar[XB_TOP], 1u);
            const unsigned tg = og / nx;
            if (og + 1u == (tg + 1u) * nx) xb_add(&bar[XB_TOPGEN], 1u);
            else XB_SPIN(xb_ld(&bar[XB_TOPGEN]) == tg, bar);
            __builtin_amdgcn_fence(__ATOMIC_ACQUIRE, "agent");
            xb_add(&bar[XB_XGEN(b.x)], 1u);
            asm volatile("s_waitcnt vmcnt(0)" ::: "memory");
        } else {
            XB_SPIN(xb_ld(&bar[XB_XGEN(b.x)]) == gen, bar);
            __builtin_amdgcn_fence(__ATOMIC_ACQUIRE, "agent");
            asm volatile("s_waitcnt vmcnt(0)" ::: "memory");
        }
    }
    __syncthreads();
}

struct Args { const void* in[N_IN]; float* out; unsigned char* ws; int ph_lo, ph_hi, bli, pad; };
struct Ctx {
    const void* const* in; float* out; unsigned char* ws; char* lds;
    int G, vcu, NGW, wave;
};
#define INF(i) ((const float*)C.in[i])
#define PHASE_IDS int lane_; asm volatile("v_mbcnt_lo_u32_b32 %0, -1, 0\n\tv_mbcnt_hi_u32_b32 %0, -1, %0" : "=v"(lane_)); const int P_lane = lane_, P_wave = C.wave, P_tid = C.wave * 64 + lane_, P_gw = C.vcu * NWAVES + C.wave; (void)P_tid; (void)P_lane; (void)P_gw; (void)P_wave;

DI void p0_transpose_item(const float* W, int K, int N, bf16_t* WT, float* scr, int item, int lane) {
    const int nblk = N / 32, kb = item / nblk, nb = item % nblk, k0 = 64 * kb, n0 = 32 * nb;
#pragma unroll 8
    for (int i = 0; i < 32; ++i) { const int kk = 2 * i + (lane >> 5); scr[kk * 33 + (lane & 31)] = W[(size_t)(k0 + kk) * N + n0 + (lane & 31)]; }
    asm volatile("s_waitcnt lgkmcnt(0)" ::: "memory");
    const int c = lane & 7;
#pragma unroll
    for (int j = 0; j < 4; ++j) { const int n = (lane >> 3) + 8 * j; const float* s = scr + (8 * c) * 33 + n;
        u32x4 o; o.x = pk2(s[0 * 33], s[1 * 33]); o.y = pk2(s[2 * 33], s[3 * 33]); o.z = pk2(s[4 * 33], s[5 * 33]); o.w = pk2(s[6 * 33], s[7 * 33]);
        *(u32x4*)(WT + (size_t)(n0 + n) * K + k0 + 8 * c) = o; }
    asm volatile("s_waitcnt lgkmcnt(0)" ::: "memory");
}
DI void phase_prologue(const Ctx& C) {
    PHASE_IDS
    float* scr = (float*)(C.lds + P_wave * 16384);
    constexpr int I_IN = 16 * (INC / 32), I_OUT = 16 * 32, I_Q = 16 * 64, I_G = 4 * 8, I_L = I_IN + I_OUT + I_Q + I_G;
    for (int it = P_gw; it < DEPTH * I_L; it += C.NGW) {
        const int l = it / I_L; int r = it % I_L;
        if (r < I_IN) { p0_transpose_item(INF(I_W_IN) + (size_t)l * DM * INC, DM, INC, (bf16_t*)(C.ws + WS_WTIN) + (size_t)l * INCP * DM, scr, r, P_lane); continue; } r -= I_IN;
        if (r < I_OUT) { p0_transpose_item(INF(I_WOUT) + (size_t)l * DM * DM, DM, DM, (bf16_t*)(C.ws + WS_WTOUT) + (size_t)l * DM * DM, scr, r, P_lane); continue; } r -= I_OUT;
        if (r < I_Q) { p0_transpose_item(INF(I_WQ) + (size_t)l * DM * 2048, DM, 2048, (bf16_t*)(C.ws + WS_WTQ) + (size_t)l * 2048 * DM, scr, r, P_lane); continue; } r -= I_Q;
        p0_transpose_item(INF(I_WGLU) + (size_t)l * 256 * 256, 256, 256, (bf16_t*)(C.ws + WS_WTGLU) + (size_t)l * 256 * 256, scr, r, P_lane);
    }
    const size_t gt = (size_t)blockIdx.x * NTHR + P_tid, NGT = (size_t)C.G * NTHR;
    for (size_t i = gt; i < (size_t)DEPTH * 16384; i += NGT) { const size_t l = i / 16384, o = i % 16384;
        *(u32x4*)(C.ws + WS_WTIN + (l * INCP * DM + (size_t)INC * DM) * 2 + o * 16) = (u32x4){0u, 0u, 0u, 0u}; }
    for (size_t i = gt; i < (size_t)DEPTH * 16 * 128 * 128 / 8; i += NGT) { const f32x4 a = ((const f32x4*)INF(I_SUBK))[2 * i], b = ((const f32x4*)INF(I_SUBK))[2 * i + 1];
        ((u32x4*)(C.ws + WS_SUBK))[i] = (u32x4){pk2(a.x, a.y), pk2(a.z, a.w), pk2(b.x, b.y), pk2(b.z, b.w)}; }
    for (int row = P_gw; row < 2 * DEPTH * NEXP; row += 2 * C.NGW) {
        const int row2 = row + C.NGW; const bool has2 = row2 < 2 * DEPTH * NEXP;
        const int tab = row >= DEPTH * NEXP, r = tab ? row - DEPTH * NEXP : row;
        const int tab2 = row2 >= DEPTH * NEXP, r2 = has2 ? (tab2 ? row2 - DEPTH * NEXP : row2) : r;
        const f32x4* src = (const f32x4*)((tab ? INF(I_PV) : INF(I_PU)) + (size_t)r * DM);
        const f32x4* src2 = (const f32x4*)(((has2 ? tab2 : tab) ? INF(I_PV) : INF(I_PU)) + (size_t)r2 * DM);
        f32x4 v[4], v2[4]; float am = 0.f, am2 = 0.f;
#pragma unroll
        for (int j = 0; j < 4; ++j) v[j] = __builtin_nontemporal_load(src + P_lane + 64 * j);
#pragma unroll
        for (int j = 0; j < 4; ++j) v2[j] = __builtin_nontemporal_load(src2 + P_lane + 64 * j);
#pragma unroll
        for (int j = 0; j < 4; ++j) { am = fmaxf(fmaxf(am, fmaxf(fabsf(v[j].x), fabsf(v[j].y))), fmaxf(fabsf(v[j].z), fabsf(v[j].w))); am2 = fmaxf(fmaxf(am2, fmaxf(fabsf(v2[j].x), fabsf(v2[j].y))), fmaxf(fabsf(v2[j].z), fabsf(v2[j].w))); }
        am = wave_max(am); am2 = wave_max(am2);
        { const float sc = am > 0.f ? 440.f / am : 1.f;
          unsigned* dst = (unsigned*)(C.ws + (tab ? WS_V8 : WS_U8)) + (size_t)r * 256;
#pragma unroll
          for (int j = 0; j < 4; ++j) { int w = __builtin_amdgcn_cvt_pk_fp8_f32(v[j].x * sc, v[j].y * sc, 0, false); w = __builtin_amdgcn_cvt_pk_fp8_f32(v[j].z * sc, v[j].w * sc, w, true); dst[P_lane + 64 * j] = (unsigned)w; }
          if (P_lane == 0) ((float*)(C.ws + (tab ? WS_SV : WS_SU)))[r] = am > 0.f ? am / 440.f : 1.f; }
        if (has2) { const float sc = am2 > 0.f ? 440.f / am2 : 1.f;
          unsigned* dst = (unsigned*)(C.ws + (tab2 ? WS_V8 : WS_U8)) + (size_t)r2 * 256;
#pragma unroll
          for (int j = 0; j < 4; ++j) { int w = __builtin_amdgcn_cvt_pk_fp8_f32(v2[j].x * sc, v2[j].y * sc, 0, false); w = __builtin_amdgcn_cvt_pk_fp8_f32(v2[j].z * sc, v2[j].w * sc, w, true); dst[P_lane + 64 * j] = (unsigned)w; }
          if (P_lane == 0) ((float*)(C.ws + (tab2 ? WS_SV : WS_SU)))[r2] = am2 > 0.f ? am2 / 440.f : 1.f; }
    }
    for (size_t i = gt; i < (size_t)T * 8; i += NGT) { const int t = (int)(i >> 3), j = (int)(i & 7);
        const double invf = exp(-(double)j * 0.125 * log(500000.0));
        const double ang = (double)((const int*)C.in[I_POS])[t] * invf;
        const double red = ang - 6.283185307179586476925 * rint(ang * 0.15915494309189533577);
        float* o = (float*)(C.ws + WS_ROPE) + (size_t)t * 16;
        double sn, cn; sincos_red(red, sn, cn); o[j] = (float)cn; o[8 + j] = (float)sn; }
    for (size_t i = gt; i < (size_t)DEPTH * 1024; i += NGT) { const int l = (int)(i >> 10), gp = (int)(i & 1023), g = gp >> 6, p = gp & 63;
        const double lr = fmin((double)INF(I_SLRE)[l * 1024 + gp], -1e-4), li = (double)INF(I_SLIM)[l * 1024 + gp];
        const double step = exp((double)INF(I_SLOGDT)[l * 16 + g]);
        const double mag = exp(lr * step); double ph = li * step; ph -= 6.283185307179586476925 * rint(ph * 0.15915494309189533577);
        double sn, cn; sincos_red(ph, sn, cn); const double are = mag * cn, aim = mag * sn;
        const double den = lr * lr + li * li;
        const double cre = ((are - 1.0) * lr + aim * li) / den, cim = (aim * lr - (are - 1.0) * li) / den;
        float* P = (float*)(C.ws + WS_SSMP) + (size_t)l * SSMP_STRIDE;
        P[gp] = (float)are; P[1024 + gp] = (float)aim;
        for (int h = 0; h < 16; ++h) { const double br = (double)INF(I_SBRE)[((size_t)l * 1024 + gp) * 16 + h], bi = (double)INF(I_SBIM)[((size_t)l * 1024 + gp) * 16 + h];
            P[2048 + (g * 16 + h) * 64 + p] = (float)(cre * br - cim * bi);
            P[2048 + 16384 + (g * 16 + h) * 64 + p] = (float)(cre * bi + cim * br); } }
}

template <bool FP8IMG> DI void phase_rmsnorm(const Ctx& C, const float* src, const float* gain, bf16_t* dst) {
    PHASE_IDS
    f32x4 g[4];
#pragma unroll
    for (int j = 0; j < 4; ++j) g[j] = ((const f32x4*)gain)[P_lane + 64 * j];
    f32x4 vn[4];
    if (P_gw < T) { const f32x4* xr = (const f32x4*)(src + (size_t)P_gw * DM) + P_lane;
#pragma unroll
        for (int j = 0; j < 4; ++j) vn[j] = xr[64 * j]; }
    for (int m = P_gw; m < T; m += C.NGW) {
        f32x4 v[4]; float s = 0.f;
#pragma unroll
        for (int j = 0; j < 4; ++j) { v[j] = vn[j]; s += (v[j].x * v[j].x + v[j].y * v[j].y) + (v[j].z * v[j].z + v[j].w * v[j].w); }
        { const int mn = m + C.NGW < T ? m + C.NGW : m; const f32x4* xr = (const f32x4*)(src + (size_t)mn * DM) + P_lane;
#pragma unroll
          for (int j = 0; j < 4; ++j) vn[j] = xr[64 * j]; }
        const float rs = 1.f / sqrtf(wave_sum(s) * (1.f / DM) + NORM_EPS);
        u32x2* o8 = (u32x2*)(dst + (size_t)m * DM) + P_lane;
#pragma unroll
        for (int j = 0; j < 4; ++j) { const f32x4 y = {v[j].x * rs * g[j].x, v[j].y * rs * g[j].y, v[j].z * rs * g[j].z, v[j].w * rs * g[j].w};
            o8[64 * j] = (u32x2){pk2(y.x, y.y), pk2(y.z, y.w)};
            if (FP8IMG) {
                f32x4 ys = y * 16.f; ys.x = fminf(fmaxf(ys.x, -440.f), 440.f); ys.y = fminf(fmaxf(ys.y, -440.f), 440.f); ys.z = fminf(fmaxf(ys.z, -440.f), 440.f); ys.w = fminf(fmaxf(ys.w, -440.f), 440.f);
                int wh = __builtin_amdgcn_cvt_pk_fp8_f32(ys.x, ys.y, 0, false); wh = __builtin_amdgcn_cvt_pk_fp8_f32(ys.z, ys.w, wh, true);
                const f32x2 h01 = __builtin_amdgcn_cvt_pk_f32_fp8(wh, false), h23 = __builtin_amdgcn_cvt_pk_f32_fp8(wh, true);
                int wl_ = __builtin_amdgcn_cvt_pk_fp8_f32((ys.x - h01.x) * 16.f, (ys.y - h01.y) * 16.f, 0, false); wl_ = __builtin_amdgcn_cvt_pk_fp8_f32((ys.z - h23.x) * 16.f, (ys.w - h23.y) * 16.f, wl_, true);
                unsigned* h8 = (unsigned*)(C.ws + WS_H8 + (size_t)m * 2048) + P_lane + 64 * j; h8[0] = (unsigned)wh; h8[256] = (unsigned)wl_; } }
    }
}

DI void phase_prep(const Ctx& C, int l) {
    PHASE_IDS
    bf16_t* cols = (bf16_t*)(C.ws + WS_COLS);
    {
        float* Wd = (float*)C.lds; float* Wa = Wd + 32 * 256; float* Wg = Wa + 32 * 256; float* lr = Wg + 64 * 256;
        const float* gd = INF(I_DECUP) + (size_t)l * 32 * 256; const float* ga = INF(I_AAAUP) + (size_t)l * 32 * 256; const float* gg = INF(I_GATEUP) + (size_t)l * 64 * 256;
        for (int i = P_tid; i < 32 * 256 / 4; i += NTHR) { ((f32x4*)Wd)[i] = ((const f32x4*)gd)[i]; ((f32x4*)Wa)[i] = ((const f32x4*)ga)[i]; }
        for (int i = P_tid; i < 64 * 256 / 4; i += NTHR) ((f32x4*)Wg)[i] = ((const f32x4*)gg)[i];
        const float* mu = INF(I_MU) + (size_t)l * 896;
        const int hh = P_tid >> 8, j = P_tid & 255;
        const float w0 = INF(I_DECW0)[l * 256 + j], a0 = INF(I_AAAA0)[l * 256 + j], kkw = INF(I_KK)[l * 256 + j], kaw = INF(I_KA)[l * 256 + j];
        const float mur = mu[j], muk = mu[256 + j], muv = mu[512 + j];
        bf16_t* RWB = (bf16_t*)(C.ws + WS_RW); float* RWW = (float*)(C.ws + WS_RWW);
        for (int tile = C.vcu; tile < T / 16; tile += C.G) {
            const int t0 = tile * 16;
            __syncthreads();
#pragma unroll
            for (int i = 0; i < 4; ++i) { const int v = P_tid + NTHR * i, tt = v >> 7, c = v & 127, t = t0 + tt;
                const float cur = bf2f(cols[(size_t)t * INCP + 1792 + 768 + c]);
                const float prev = (t % SEQ) ? bf2f(cols[(size_t)(t - 1) * INCP + 1792 + 768 + c]) : 0.f;
                const float x = cur + (prev - cur) * mu[768 + c];
                lr[tt * 128 + (c < 32 ? 2 * c : (c < 64 ? 2 * (c - 32) + 1 : c))] = c < 32 ? tanhf(x) : (c < 64 ? x : sigmoidf_(x)); }
            __syncthreads();
#pragma unroll 1
            for (int pass = 0; pass < 2; ++pass) {
                const int tb = hh * 8 + pass * 4;
                float aw[4], aa[4], ag[4];
                float rc[4], kc[4], vc[4], rpv[4], kpv[4], vpv[4];
#pragma unroll
                for (int q = 0; q < 4; ++q) { const int t = t0 + tb + q; const bool first = (t % SEQ) == 0;
                    const bf16_t* cr = cols + (size_t)t * INCP + 1792; const bf16_t* pr = first ? cr : cr - INCP;
                    rc[q] = bf2f(cr[j]); kc[q] = bf2f(cr[256 + j]); vc[q] = bf2f(cr[512 + j]);
                    rpv[q] = bf2f(pr[j]); kpv[q] = bf2f(pr[256 + j]); vpv[q] = bf2f(pr[512 + j]); }
                { f32x2 awa[4], ag2[4];
#pragma unroll
                  for (int q = 0; q < 4; ++q) { awa[q] = (f32x2){0.f, 0.f}; ag2[q] = (f32x2){0.f, 0.f}; }
#pragma unroll 4
                  for (int i = 0; i < 32; ++i) { const f32x2 w2 = {Wd[i * 256 + j], Wa[i * 256 + j]};
#pragma unroll
                      for (int q = 0; q < 4; ++q) awa[q] += *(const f32x2*)(lr + (tb + q) * 128 + 2 * i) * w2; }
#pragma unroll 2
                  for (int i = 0; i < 64; i += 2) { const f32x2 w2 = {Wg[i * 256 + j], Wg[(i + 1) * 256 + j]};
#pragma unroll
                      for (int q = 0; q < 4; ++q) ag2[q] += *(const f32x2*)(lr + (tb + q) * 128 + 64 + i) * w2; }
#pragma unroll
                  for (int q = 0; q < 4; ++q) { aw[q] = awa[q].x; aa[q] = awa[q].y; ag[q] = ag2[q].x + ag2[q].y; } }
#pragma unroll
                for (int q = 0; q < 4; ++q) { const int t = t0 + tb + q; const bool first = (t % SEQ) == 0;
                    float r = rc[q], k = kc[q], v = vc[q];
                    const float rp = first ? 0.f : rpv[q], kp = first ? 0.f : kpv[q], vp = first ? 0.f : vpv[q];
                    r += (rp - r) * mur; k += (kp - k) * muk; v += (vp - v) * muv;
                    const float sg = sigmoidf_(w0 + aw[q]); const float decay = __expf(-0.60653065971263342f * sg);
                    const float a = sigmoidf_(a0 + aa[q]);
                    float kk = k * kkw; const float ss = wave_sum(kk * kk); kk = kk / fmaxf(sqrtf(ss), 1e-12f);
                    const float k2 = k * (1.f + (a - 1.f) * kaw);
                    bf16_t* o = RWB + (size_t)t * 1536 + j;
                    o[0] = (bf16_t)f2bf(r); o[256] = (bf16_t)f2bf(k2); o[512] = (bf16_t)f2bf(v); o[768] = (bf16_t)f2bf(kk); o[1024] = (bf16_t)f2bf(kk * a); o[1280] = (bf16_t)f2bf(ag[q]); RWW[(size_t)t * 256 + j] = decay; __builtin_amdgcn_sched_barrier(0); }
            }
        }
        __syncthreads();
    }
    {
        const int v16 = P_lane >> 2, qt = P_lane & 3, part = v16 >> 3, vec = v16 & 7;
        float gn[16];
#pragma unroll
        for (int i = 0; i < 16; ++i) gn[i] = (part == 0 ? INF(I_QN) : INF(I_KN))[l * 512 + vec * 64 + qt * 16 + i];
        const float qscale = part == 0 ? 0.18033688011112042f : 1.f;
        const float* rope = (const float*)(C.ws + WS_ROPE);
        for (int t = P_gw; t < T; t += C.NGW) {
            float cs[16];
#pragma unroll
            for (int i = 0; i < 4; ++i) { const f32x4 v = ((const f32x4*)(rope + (size_t)t * 16))[i]; cs[4 * i] = v.x; cs[4 * i + 1] = v.y; cs[4 * i + 2] = v.z; cs[4 * i + 3] = v.w; }
            bf16_t* p = cols + (size_t)t * INCP + v16 * 64 + qt * 16;
            const u32x4 w0 = ((const u32x4*)p)[0], w1 = ((const u32x4*)p)[1];
            float x[16];
            x[0] = bflo(w0.x); x[1] = bfhi(w0.x); x[2] = bflo(w0.y); x[3] = bfhi(w0.y); x[4] = bflo(w0.z); x[5] = bfhi(w0.z); x[6] = bflo(w0.w); x[7] = bfhi(w0.w);
            x[8] = bflo(w1.x); x[9] = bfhi(w1.x); x[10] = bflo(w1.y); x[11] = bfhi(w1.y); x[12] = bflo(w1.z); x[13] = bfhi(w1.z); x[14] = bflo(w1.w); x[15] = bfhi(w1.w);
            float ss = 0.f;
#pragma unroll
            for (int i = 0; i < 16; ++i) ss += x[i] * x[i];
            ss = sum4(ss);
            const float rs = qscale / sqrtf(ss * (1.f / 64.f) + NORM_EPS);
#pragma unroll
            for (int i = 0; i < 16; ++i) x[i] = x[i] * rs * gn[i];
            if (qt == 0) {
#pragma unroll
                for (int i = 0; i < 8; ++i) { const float r1 = x[i], r2 = x[8 + i]; x[i] = r1 * cs[i] - r2 * cs[8 + i]; x[8 + i] = r2 * cs[i] + r1 * cs[8 + i]; }
            }
            ((u32x4*)p)[0] = (u32x4){pk2(x[0], x[1]), pk2(x[2], x[3]), pk2(x[4], x[5]), pk2(x[6], x[7])};
            ((u32x4*)p)[1] = (u32x4){pk2(x[8], x[9]), pk2(x[10], x[11]), pk2(x[12], x[13]), pk2(x[14], x[15])};
        }
    }
}

typedef short v4i16_t __attribute__((ext_vector_type(4)));
DI s16x4 tr_read(const char* p) { return __builtin_bit_cast(s16x4, __builtin_amdgcn_ds_read_tr16_b64_v4i16((LAS v4i16_t*)p)); }
typedef __bf16 bf16x2_t __attribute__((ext_vector_type(2)));
DI unsigned cvtpk(float lo, float hi) { f32x2 v = {lo, hi}; bf16x2_t b = __builtin_convertvector(v, bf16x2_t); return __builtin_bit_cast(unsigned, b); }
DI int crow(int r, int hi) { return (r & 3) + 8 * (r >> 2) + 4 * hi; }
DI bf16x8 pack8(const f32x16& p, int b) { u32x4 w = {cvtpk(p[b], p[b + 1]), cvtpk(p[b + 2], p[b + 3]), cvtpk(p[b + 4], p[b + 5]), cvtpk(p[b + 6], p[b + 7])}; return __builtin_bit_cast(bf16x8, w); }
constexpr int AT_K = 0, AT_V = 16384, AT_BUF = 32768, AT_X = 65536, AT_W = 131072;

DI void attn_unit(const Ctx& C, int l, int b, int h, int qb, float lam_full, float lam_init) {
    PHASE_IDS
    const bf16_t* cols = (const bf16_t*)(C.ws + WS_COLS);
    char* lds = C.lds;
    const int tid = P_tid, lane = P_lane, wid = P_wave, r32 = lane & 31, hi = lane >> 5, m = wid >> 2, sub = wid & 3;
    const size_t tb = (size_t)b * SEQ;
    const size_t qrow = tb + qb * 128 + sub * 32 + r32;
    bf16x8 qr[4];
#pragma unroll
    for (int d0 = 0; d0 < 4; ++d0) qr[d0] = *(const bf16x8*)(cols + qrow * INCP + h * 128 + m * 64 + d0 * 16 + hi * 8);
    f32x16 o[4];
#pragma unroll
    for (int i = 0; i < 4; ++i)
#pragma unroll
        for (int r = 0; r < 16; ++r) o[i][r] = 0.f;
    float lsum = 0.f;
    const int nt = 2 * qb + 2, my_nt = 2 * qb + 1 + (sub >> 1);
    const int q4 = (lane & 15) >> 2, p4 = lane & 3, blk16 = (lane >> 4) & 1;
    unsigned goK[2], goV[2], loK[2], loV[2];
#pragma unroll
    for (int i = 0; i < 2; ++i) { const int c = tid + NTHR * i, mm = c >> 9, row = (c >> 3) & 63, ch = c & 7;
        goK[i] = (unsigned)((row * INCP + 512 + mm * 64 + ch * 8) * 2); loK[i] = (unsigned)(AT_K + mm * 8192 + row * 128 + 16 * (ch ^ ((row >> 1) & 7))); }
#pragma unroll
    for (int i = 0; i < 2; ++i) { const int c = tid + NTHR * i, row = c >> 4, ch = c & 15;
        goV[i] = (unsigned)((row * INCP + 1024 + ch * 8) * 2); loV[i] = (unsigned)(AT_V + row * 256 + 16 * (ch ^ (((row & 3) << 2) | ((row >> 2) & 3)))); }
    unsigned vo[8];
#pragma unroll
    for (int k = 0; k < 8; ++k) { const int db_ = k >> 1, rr_ = 4 * hi + q4 + 8 * (k & 1), ch_ = 4 * db_ + 2 * blk16 + (p4 >> 1);
        vo[k] = (unsigned)(rr_ * 256 + 16 * (ch_ ^ (((rr_ & 3) << 2) | ((rr_ >> 2) & 3))) + 8 * (p4 & 1)); }
    const unsigned lds32 = (unsigned)(size_t)(LAS char*)lds;
    u32x4 kreg[2], vreg[2];
    { const char* tbase = (const char*)(cols + tb * INCP + h * 128);
#pragma unroll
      for (int i = 0; i < 2; ++i) { kreg[i] = *(const u32x4*)(tbase + goK[i]); vreg[i] = *(const u32x4*)(tbase + goV[i]); } }
    __syncthreads();
    for (int kt = 0; kt < nt; ++kt) {
        char* ldb = lds + (kt & 1) * AT_BUF;
#pragma unroll
        for (int i = 0; i < 2; ++i) { *(u32x4*)(ldb + loK[i]) = kreg[i]; *(u32x4*)(ldb + loV[i]) = vreg[i]; }
        if (kt + 1 < nt) { const char* tbase = (const char*)(cols + (tb + (kt + 1) * 64) * INCP + h * 128);
#pragma unroll
            for (int i = 0; i < 2; ++i) { kreg[i] = *(const u32x4*)(tbase + goK[i]); vreg[i] = *(const u32x4*)(tbase + goV[i]); } }
        __syncthreads();
        if (kt < my_nt) {
            bf16x8 kf[8];
#pragma unroll
            for (int d0 = 0; d0 < 4; ++d0) { const char* kp = ldb + AT_K + m * 8192 + r32 * 128 + 16 * ((2 * d0 + hi) ^ ((r32 >> 1) & 7)); kf[2 * d0] = *(const bf16x8*)kp; kf[2 * d0 + 1] = *(const bf16x8*)(kp + 4096); }
            __builtin_amdgcn_sched_barrier(0);
            f32x16 p0, p1;
#pragma unroll
            for (int r = 0; r < 16; ++r) { p0[r] = 0.f; p1[r] = 0.f; }
#pragma unroll
            for (int d0 = 0; d0 < 4; ++d0) { p0 = __builtin_amdgcn_mfma_f32_32x32x16_bf16(kf[2 * d0], qr[d0], p0, 0, 0, 0); p1 = __builtin_amdgcn_mfma_f32_32x32x16_bf16(kf[2 * d0 + 1], qr[d0], p1, 0, 0, 0); }
#define AT_TR(p_) __builtin_bit_cast(s16x4, __builtin_amdgcn_ds_read_tr16_b64_v4i16((LAS v4i16_t*)(p_)))
#define AT_VFRAG(db, s4) ({ const s16x4 lo_ = AT_TR(vp[2 * (db)] + 256 * (32 * ((s4) >> 1) + 16 * ((s4) & 1))); const s16x4 hh_ = AT_TR(vp[2 * (db) + 1] + 256 * (32 * ((s4) >> 1) + 16 * ((s4) & 1))); \
                (bf16x8)__builtin_shufflevector(lo_, hh_, 0, 1, 2, 3, 4, 5, 6, 7); })
            LAS char* vp[8];
#pragma unroll
            for (int k = 0; k < 8; ++k) { unsigned a_ = lds32 + (unsigned)((kt & 1) * AT_BUF + AT_V) + vo[k]; asm volatile("" : "+v"(a_)); vp[k] = (LAS char*)(size_t)a_; }
            bf16x8 va[8];
#pragma unroll
            for (int i = 0; i < 8; ++i) va[i] = AT_VFRAG(i >> 1, i & 1);
            __builtin_amdgcn_sched_barrier(0);
            float s = 0.f;
#pragma unroll
            for (int r = 0; r < 8; ++r) { p0[r] = __builtin_amdgcn_exp2f(p0[r]); s += p0[r]; }
            bf16x8 pa[4]; pa[0] = pack8(p0, 0);
            __builtin_amdgcn_sched_barrier(0);
            bf16x8 vb[8];
#pragma unroll
            for (int i = 0; i < 8; ++i) vb[i] = AT_VFRAG(i >> 1, 2 + (i & 1));
            __builtin_amdgcn_sched_barrier(0);
#pragma unroll
            for (int j = 0; j < 16; ++j) { const int q = j >> 2, db = j & 3;
                o[db] = __builtin_amdgcn_mfma_f32_32x32x16_bf16(pa[q], q < 2 ? va[2 * db + (q & 1)] : vb[2 * db + (q & 1)], o[db], 0, 0, 0);
                if (j < 12) { const int i0 = 8 * ((q + 1) & 1) + 2 * db;
                    float e0 = __builtin_amdgcn_exp2f(q == 0 ? p0[i0] : p1[i0]), e1 = __builtin_amdgcn_exp2f(q == 0 ? p0[i0 + 1] : p1[i0 + 1]);
                    s += e0 + e1;
                    asm volatile("" : "+v"(e0), "+v"(e1), "+v"(s));
                    if (q == 0) { p0[i0] = e0; p0[i0 + 1] = e1; } else { p1[i0] = e0; p1[i0 + 1] = e1; }
                    if (db == 3) pa[q + 1] = q == 0 ? pack8(p0, 8) : (q == 1 ? pack8(p1, 0) : pack8(p1, 8)); }
                __builtin_amdgcn_sched_barrier(0); }
            lsum += s;
#undef AT_VFRAG
#undef AT_TR
        }
    }
    float* wsf = (float*)(lds + AT_W) + wid * 64;
    const float lt = sum_halves(lsum, hi);
    if (hi == 0) wsf[r32] = 1.f / lt;
    __syncthreads();
#pragma unroll
    for (int r = 0; r < 16; ++r) { const float rl = wsf[crow(r, hi)];
#pragma unroll
        for (int db = 0; db < 4; ++db) o[db][r] *= rl; }
    float* xch = (float*)(lds + AT_X) + sub * 4096;
    if (m == 1) {
#pragma unroll
        for (int r = 0; r < 16; ++r)
#pragma unroll
            for (int db = 0; db < 4; ++db) xch[crow(r, hi) * 128 + db * 32 + r32] = o[db][r];
    }
    __syncthreads();
    if (m == 0) {
        const float* subln = INF(I_SUBLN) + l * 128;
        float g[4];
#pragma unroll
        for (int db = 0; db < 4; ++db) g[db] = subln[db * 32 + r32] * (1.f - lam_init);
        bf16_t* mixed = (bf16_t*)(C.ws + WS_MIXED);
#pragma unroll
        for (int r = 0; r < 16; ++r) {
            float ss = 0.f;
#pragma unroll
            for (int db = 0; db < 4; ++db) { o[db][r] -= lam_full * xch[crow(r, hi) * 128 + db * 32 + r32]; ss += o[db][r] * o[db][r]; }
            ss = sum32(ss);
            const float rs = 1.f / sqrtf(ss * (1.f / 128.f) + NORM_EPS);
            bf16_t* orow = mixed + (tb + qb * 128 + sub * 32 + crow(r, hi)) * DM + h * 128;
#pragma unroll
            for (int db = 0; db < 4; ++db) orow[db * 32 + r32] = (bf16_t)f2bf(o[db][r] * rs * g[db]);
        }
    }
}
DI void attn_lambda(const Ctx& C, int l, int lane, float& lam_full, float& lam_init) {
    const float* lf = INF(I_LAM) + l * 256;
    const float la = wave_sum(lf[lane] * lf[64 + lane]), lb = wave_sum(lf[128 + lane] * lf[192 + lane]);
    lam_init = 0.8f - 0.6f * expf(-0.3f * (float)l);
    lam_full = expf(la) - expf(lb) + lam_init;
}
DI void phase_attn(const Ctx& C, int l, int w0, int nw) {
    PHASE_IDS
    float lam_full, lam_init; attn_lambda(C, l, P_lane, lam_full, lam_init);
    if (nw == 256) {
        for (int u = C.vcu - w0; u < 1024; u += nw) {
            const int bh = (u & 255) >> 3, s = u & 7, i = u >> 8;
            const int qb = (i == 0) ? s : (i == 1) ? 15 - s : (i == 2) ? 16 + s : 31 - s;
            attn_unit(C, l, bh >> 2, bh & 3, qb, lam_full, lam_init);
        }
    } else {
        for (int u = C.vcu - w0; u < 1024; u += nw) { const int qb = 31 - (u >> 5), bh = u & 31; attn_unit(C, l, bh >> 2, bh & 3, qb, lam_full, lam_init); }
    }
    __syncthreads();
}
DI int attn_queue_qb(int which, int k) { return which == 0 ? (k < 7 ? 31 - k : 7 - 2 * (k - 7)) : (k < 17 ? 24 - k : 6 - 2 * (k - 17)); }
DI void phase_attn_queue(const Ctx& C, int l, int which) {
    PHASE_IDS
    float lam_full, lam_init; attn_lambda(C, l, P_lane, lam_full, lam_init);
    unsigned* ticket = (unsigned*)(C.ws + WS_CTL) + 1024 + (l * 2 + which) * 64;
    volatile int* slot = (volatile int*)(C.lds + MISC_OFF + 64);
    const int count = (which == 0 ? 11 : 21) * 32;
    int next = 0;
    if (P_tid == 0) next = (int)__hip_atomic_fetch_add(ticket, 1u, __ATOMIC_RELAXED, __HIP_MEMORY_SCOPE_AGENT);
    for (;;) {
        __syncthreads();
        if (P_tid == 0) *slot = next;
        __syncthreads();
        const int u = __builtin_amdgcn_readfirstlane(*slot);
        if (u >= count) break;
        if (P_tid == 0) next = (int)__hip_atomic_fetch_add(ticket, 1u, __ATOMIC_RELAXED, __HIP_MEMORY_SCOPE_AGENT);
        const int qb = attn_queue_qb(which, u >> 5), bh = u & 31;
        attn_unit(C, l, bh >> 2, bh & 3, qb, lam_full, lam_init);
    }
    __syncthreads();
}

DI void phase_ssm(const Ctx& C, int l, int w0, int nw) {
    PHASE_IDS
    float* L = (float*)C.lds;
    float* Uu = L;
    float* Tt = L + 2048;
    bf16_t* X2 = (bf16_t*)(L + 3072);
    bf16_t* C2 = X2 + 64 * 136;
    const bf16_t* cols = (const bf16_t*)(C.ws + WS_COLS);
    bf16_t* yg = (bf16_t*)(C.ws + WS_YG);
    const float* P = (const float*)(C.ws + WS_SSMP) + (size_t)l * SSMP_STRIDE;
    const int tid = P_tid, lane = P_lane, w = P_wave;
    for (int u = C.vcu - w0; u < 128; u += nw) {
        const int b = u >> 4, g = u & 15;
        const int p1 = tid & 63;
        f32x2 bb[16];
        { const float* pbr = P + 2048 + g * 1024 + p1; const float* pbi = pbr + 16384;
#pragma unroll
          for (int h = 0; h < 16; ++h) { bb[h].x = pbr[h * 64]; bb[h].y = pbi[h * 64]; } }
        const float a1r = P[g * 64 + p1], a1i = P[1024 + g * 64 + p1];
        float a8r, a8i;
        { double xr = (double)a1r, xi = (double)a1i;
#pragma unroll
          for (int k = 0; k < 3; ++k) { const double nr = xr * xr - xi * xi, ni = 2.0 * xr * xi; xr = nr; xi = ni; }
          a8r = (float)xr; a8i = (float)xi; }
        float xpr = 0.f, xpi = 0.f;
        __syncthreads();
        for (int i = tid; i < 16 * 128; i += NTHR) { const int h = i >> 7, k = i & 127;
            const float v = k < 64 ? INF(I_SCRE)[((size_t)l * 256 + g * 16 + h) * 64 + k] : -INF(I_SCIM)[((size_t)l * 256 + g * 16 + h) * 64 + k - 64]; C2[h * 136 + k] = (bf16_t)f2bf(v); }
        const float dsk = INF(I_SD)[l * 256 + g * 16 + (lane & 15)];
        const size_t tb = (size_t)b * SEQ;
        { const unsigned v = *(const unsigned*)(cols + (tb + (tid >> 3)) * INCP + 1536 + g * 16 + 2 * (tid & 7)); Uu[(tid >> 3) * 16 + 2 * (tid & 7)] = bflo(v); Uu[(tid >> 3) * 16 + 2 * (tid & 7) + 1] = bfhi(v); }
        __syncthreads();
        for (int ck = 0; ck < 64; ++ck) {
            const float* Uc = Uu + (ck & 1) * 1024; float* Un = Uu + ((ck + 1) & 1) * 1024;
            unsigned unext = 0u;
            if (ck + 1 < 64) unext = *(const unsigned*)(cols + (tb + (ck + 1) * 64 + (tid >> 3)) * INCP + 1536 + g * 16 + 2 * (tid & 7));
            float xlr[8], xli[8]; float cr = 0.f, ci = 0.f;
#pragma unroll
            for (int q = 0; q < 8; ++q) { const int t = 8 * w + q; const f32x4 u0 = *(const f32x4*)(Uc + t * 16), u1 = *(const f32x4*)(Uc + t * 16 + 4), u2 = *(const f32x4*)(Uc + t * 16 + 8), u3 = *(const f32x4*)(Uc + t * 16 + 12);
                f32x2 s = bb[0] * u0.x, s1 = bb[1] * u0.y, s2 = bb[2] * u0.z, s3 = bb[3] * u0.w;
                s += bb[4] * u1.x; s1 += bb[5] * u1.y; s2 += bb[6] * u1.z; s3 += bb[7] * u1.w;
                s += bb[8] * u2.x; s1 += bb[9] * u2.y; s2 += bb[10] * u2.z; s3 += bb[11] * u2.w; s += bb[12] * u3.x; s1 += bb[13] * u3.y; s2 += bb[14] * u3.z; s3 += bb[15] * u3.w;
                s = (s + s1) + (s2 + s3);
                const float nr = a1r * cr - a1i * ci + s.x, ni = a1r * ci + a1i * cr + s.y; cr = nr; ci = ni; xlr[q] = nr; xli[q] = ni; }
            { f32x2 tv; tv.x = cr; tv.y = ci; *(f32x2*)(Tt + (w * 64 + p1) * 2) = tv; }
            __syncthreads();
            Un[(tid >> 3) * 16 + 2 * (tid & 7)] = bflo(unext); Un[(tid >> 3) * 16 + 2 * (tid & 7) + 1] = bfhi(unext);
            { float kr = xpr, ki = xpi, inr = 0.f, ini = 0.f;
#pragma unroll
              for (int k = 0; k < 8; ++k) { if (k == w) { inr = kr; ini = ki; } const f32x2 tv = *(const f32x2*)(Tt + (k * 64 + p1) * 2);
                  const float nr = a8r * kr - a8i * ki + tv.x, ni = a8r * ki + a8i * kr + tv.y; kr = nr; ki = ni; }
              xpr = kr; xpi = ki;
#pragma unroll
              for (int q = 0; q < 8; ++q) { const float nr = a1r * inr - a1i * ini, ni = a1r * ini + a1i * inr; inr = nr; ini = ni;
                  X2[(8 * w + q) * 136 + p1] = (bf16_t)f2bf(xlr[q] + nr); X2[(8 * w + q) * 136 + 64 + p1] = (bf16_t)f2bf(xli[q] + ni); } }
            __syncthreads();
            if (w < 4) {
                f32x4 acc = {0.f, 0.f, 0.f, 0.f};
#pragma unroll
                for (int ks = 0; ks < 4; ++ks) { const bf16x8 af = *(const bf16x8*)(X2 + (16 * w + (lane & 15)) * 136 + 32 * ks + 8 * (lane >> 4));
                    const bf16x8 cfk = *(const bf16x8*)(C2 + (lane & 15) * 136 + 32 * ks + 8 * (lane >> 4));
                    acc = __builtin_amdgcn_mfma_f32_16x16x32_bf16(af, cfk, acc, 0, 0, 0); }
#pragma unroll
                for (int r = 0; r < 4; ++r) { const int t = 16 * w + 4 * (lane >> 4) + r; const float y = acc[r] + dsk * Uc[t * 16 + (lane & 15)];
                    yg[(tb + ck * 64 + t) * 256 + g * 16 + (lane & 15)] = (bf16_t)f2bf(gelu_erf(y)); }
            }
        }
    }
    __syncthreads();
}

constexpr int RC = 32, NCH = SEQ / RC;
constexpr int LD = 68, LA = 36, LX = 132;
DI f32x4 mf4(float a, float b, f32x4 c) { return __builtin_amdgcn_mfma_f32_16x16x4f32(a, b, c, 0, 0, 0); }
template <int K> DI void mm_cc(f32x4& acc, const float* A, int lda, const float* B, int ldb, int tr, int tc, int lane) {
    const float* ap = A + (16 * tr + (lane & 15)) * lda + 4 * (lane >> 4); const float* bp = B + (16 * tc + (lane & 15)) * ldb + 4 * (lane >> 4);
#pragma unroll
    for (int kq = 0; kq < K / 16; ++kq) { const f32x4 a = *(const f32x4*)(ap + 16 * kq), c = *(const f32x4*)(bp + 16 * kq);
        acc = mf4(a.x, c.x, acc); acc = mf4(a.y, c.y, acc); acc = mf4(a.z, c.z, acc); acc = mf4(a.w, c.w, acc); }
}
template <int K> DI void mm_cm(f32x4& acc, const float* A, int lda, const float* B, int ldb, int tr, int tc, int lane) {
    const float* ap = A + (16 * tr + (lane & 15)) * lda + 4 * (lane >> 4); const float* bp = B + (4 * (lane >> 4)) * ldb + 16 * tc + (lane & 15);
#pragma unroll
    for (int kq = 0; kq < K / 16; ++kq) { const f32x4 a = *(const f32x4*)(ap + 16 * kq); const float* b0 = bp + 16 * kq * ldb;
        acc = mf4(a.x, b0[0], acc); acc = mf4(a.y, b0[ldb], acc); acc = mf4(a.z, b0[2 * ldb], acc); acc = mf4(a.w, b0[3 * ldb], acc); }
}
template <int K> DI void mm_mm(f32x4& acc, const float* A, int lda, const float* B, int ldb, int tr, int tc, int lane) {
    const float* ap = A + (lane >> 4) * lda + 16 * tr + (lane & 15); const float* bp = B + (lane >> 4) * ldb + 16 * tc + (lane & 15);
#pragma unroll
    for (int kk = 0; kk < K / 4; ++kk) acc = mf4(ap[4 * kk * lda], bp[4 * kk * ldb], acc);
}
struct RwcPtr { float* G; float* HT; float* Pm; float* Y0; };
DI RwcPtr rwc_ptr(unsigned char* ws, int unit) { float* p = (float*)(ws + WS_RWC) + (size_t)unit * 12288; return RwcPtr{p, p + 4096, p + 8192, p + 10240}; }

DI void phase_rw1(const Ctx& C, int l, int w0, int nw) {
    PHASE_IDS
    (void)l;
    float* L0 = (float*)C.lds;
    float* AT = L0; float* RT = L0 + 2176; float* BT = L0 + 4352; float* KT = L0 + 6528; float* VV = L0 + 8704;
    float* Lm = L0 + 10880; float* AK = L0 + 12032; float* ARB = L0 + 13184; float* ARK = L0 + 14336; float* X = L0 + 15488;
    float* tot = L0 + 19712; float* gC = L0 + 20224;
    const int tid = P_tid, lane = P_lane, w = P_wave;
    const bf16_t* RWB = (const bf16_t*)(C.ws + WS_RW); const float* RWW = (const float*)(C.ws + WS_RWW);
    float iw[4], ir[4], ik[4], iv[4], ia[4], ib[4];
    { const int unit = C.vcu - w0; if (unit < 32 * NCH) { const int bh = unit / NCH, c = unit % NCH;
        const size_t tk = (size_t)(bh >> 2) * SEQ + c * RC + 4 * w; const bf16_t* base = RWB + tk * 1536 + (bh & 3) * 64 + lane; const float* bw = RWW + tk * 256 + (bh & 3) * 64 + lane;
#pragma unroll
        for (int q = 0; q < 4; ++q) { ir[q] = bf2f(base[q * 1536]); iw[q] = bw[q * 256]; ik[q] = bf2f(base[q * 1536 + 256]); iv[q] = bf2f(base[q * 1536 + 512]); ia[q] = bf2f(base[q * 1536 + 768]); ib[q] = bf2f(base[q * 1536 + 1024]); } } }
    for (int unit = C.vcu - w0; unit < 32 * NCH; unit += nw) {
        const int bh = unit / NCH, c = unit % NCH, bb = bh >> 2, h = bh & 3;
        __syncthreads();
        float g[4];
#pragma unroll
        for (int q = 0; q < 4; ++q) g[q] = q ? g[q - 1] * iw[q] : iw[q];
        tot[w * 64 + lane] = g[3];
        __syncthreads();
        float pre = 1.f, all = 1.f;
#pragma unroll
        for (int k = 0; k < 8; ++k) { const float tk = tot[k * 64 + lane]; all *= tk; if (k < w) pre *= tk; }
        if (w == 0) gC[lane] = all;
#pragma unroll
        for (int q = 0; q < 4; ++q) { const int t = 4 * w + q; const float gt = pre * g[q], gm = q ? pre * g[q - 1] : pre, ig = 1.f / gt;
            const float at = -ia[q] * gm;
            AT[t * LD + lane] = at; X[t * LX + lane] = at; RT[t * LD + lane] = ir[q] * gt; BT[t * LD + lane] = ib[q] * ig; KT[t * LD + lane] = ik[q] * ig; VV[t * LD + lane] = iv[q]; }
        { const int un = unit + nw; if (un < 32 * NCH) { const int bhn = un / NCH, cn = un % NCH;
            const size_t tk = (size_t)(bhn >> 2) * SEQ + cn * RC + 4 * w; const bf16_t* base = RWB + tk * 1536 + (bhn & 3) * 64 + lane; const float* bw = RWW + tk * 256 + (bhn & 3) * 64 + lane;
#pragma unroll
            for (int q = 0; q < 4; ++q) { ir[q] = bf2f(base[q * 1536]); iw[q] = bw[q * 256]; ik[q] = bf2f(base[q * 1536 + 256]); iv[q] = bf2f(base[q * 1536 + 512]); ia[q] = bf2f(base[q * 1536 + 768]); ib[q] = bf2f(base[q * 1536 + 1024]); } } }
        __syncthreads();
#pragma unroll
        for (int x = 0; x < 2; ++x) { const int job = 2 * w + x, mt = job >> 2, tr = (job >> 1) & 1, tc = job & 1;
            f32x4 a = {0.f, 0.f, 0.f, 0.f};
            if (tc <= tr) mm_cc<64>(a, mt < 2 ? AT : RT, LD, (mt & 1) ? KT : BT, LD, tr, tc, lane);
            const int ncol = 16 * tc + (lane & 15), mrow = 16 * tr + 4 * (lane >> 4);
#pragma unroll
            for (int r = 0; r < 4; ++r) { const bool keep = mt < 2 ? (ncol < mrow + r) : (ncol <= mrow + r); const float v = keep ? a[r] : 0.f;
                if (mt == 0) Lm[(mrow + r) * LA + (ncol & 3) * 8 + (ncol >> 2)] = v;
                else (mt == 1 ? AK : (mt == 2 ? ARB : ARK))[(mrow + r) * LA + ncol] = v; } }
        __syncthreads();
        { const int tr = w >> 2, tc = w & 3; f32x4 a = {0.f, 0.f, 0.f, 0.f}; mm_cm<32>(a, AK, LA, VV, LD, tr, tc, lane);
#pragma unroll
          for (int r = 0; r < 4; ++r) X[(16 * tr + 4 * (lane >> 4) + r) * LX + 64 + 16 * tc + (lane & 15)] = a[r]; }
        __syncthreads();
        { const int cc = tid >> 2, part = tid & 3; float u[8];
#pragma unroll
          for (int k = 0; k < 8; ++k) u[k] = 0.f;
#pragma unroll
          for (int blk = 0; blk < RC / 8; ++blk) {
              f32x4 la[8], lb[8]; float xv[8];
#pragma unroll
              for (int q = 0; q < 8; ++q) { const int t = 8 * blk + q; la[q] = *(const f32x4*)(Lm + t * LA + part * 8); lb[q] = *(const f32x4*)(Lm + t * LA + part * 8 + 4); xv[q] = X[t * LX + cc]; }
#pragma unroll
              for (int q = 0; q < 8; ++q) { const int t = 8 * blk + q;
                  float sm = la[q].x * u[0] + la[q].y * u[1] + la[q].z * u[2] + la[q].w * u[3] + lb[q].x * u[4] + lb[q].y * u[5] + lb[q].z * u[6] + lb[q].w * u[7];
                  sm = sum4(sm) + xv[q];
                  u[t >> 2] = (part == (t & 3)) ? sm : u[t >> 2]; } }
#pragma unroll
          for (int k = 0; k < 8; ++k) X[(part + 4 * k) * LX + cc] = u[k]; }
        __syncthreads();
        const RwcPtr O = rwc_ptr(C.ws, unit);
#pragma unroll
        for (int x = 0; x < 2; ++x) { const int tile = 2 * w + x, tr = tile >> 2, tc = tile & 3, ncol = 16 * tc + (lane & 15), mrow = 16 * tr + 4 * (lane >> 4);
            f32x4 gg = {0.f, 0.f, 0.f, 0.f}, hh = gg;
            mm_mm<32>(gg, BT, LD, X, LX, tr, tc, lane);
            mm_mm<32>(hh, X + 64, LX, BT, LD, tr, tc, lane); mm_mm<32>(hh, VV, LD, KT, LD, tr, tc, lane);
#pragma unroll
            for (int r = 0; r < 4; ++r) { const int row = mrow + r;
                O.G[row * 64 + ncol] = gC[row] * (gg[r] + (row == ncol ? 1.f : 0.f)); O.HT[row * 64 + ncol] = hh[r] * gC[ncol]; } }
        { const int tr = w >> 2, tc = w & 3, ncol = 16 * tc + (lane & 15), mrow = 16 * tr + 4 * (lane >> 4);
          f32x4 pp = {0.f, 0.f, 0.f, 0.f}, yy = pp;
          mm_cm<32>(pp, ARB, LA, X, LX, tr, tc, lane);
          mm_cm<32>(yy, ARB, LA, X + 64, LX, tr, tc, lane); mm_cm<32>(yy, ARK, LA, VV, LD, tr, tc, lane);
#pragma unroll
          for (int r = 0; r < 4; ++r) { const int row = mrow + r; O.Pm[row * 64 + ncol] = pp[r] + RT[row * LD + ncol]; O.Y0[row * 64 + ncol] = yy[r]; } }
    }
    __syncthreads();
}

DI void phase_rw2(const Ctx& C, int l, int w0, int nw) {
    PHASE_IDS
    (void)l;
    float* Ss = (float*)C.lds; float* Gs = Ss + 64 * LD;
    const int tid = P_tid, lane = P_lane, w = P_wave;
    const int tr = w >> 1, tc0 = 2 * (w & 1), mrow = 16 * tr + 4 * (lane >> 4);
    for (int bh = C.vcu - w0; bh < 32; bh += nw) {
        f32x4 sm[2] = {{0.f, 0.f, 0.f, 0.f}, {0.f, 0.f, 0.f, 0.f}};
        f32x4 gpre[2];
        { const RwcPtr O = rwc_ptr(C.ws, bh * NCH); gpre[0] = *(const f32x4*)(O.G + tid * 8); gpre[1] = *(const f32x4*)(O.G + tid * 8 + 4); }
        for (int c = 0; c < NCH; ++c) {
            const RwcPtr O = rwc_ptr(C.ws, bh * NCH + c);
            float* SC = (float*)(C.ws + WS_RWS) + (size_t)(bh * NCH + c) * 4096;
            float* Gc = Gs + (c & 1) * 64 * LD;
            __syncthreads();
#pragma unroll
            for (int x = 0; x < 2; ++x) { const int ncol = 16 * (tc0 + x) + (lane & 15);
#pragma unroll
                for (int r = 0; r < 4; ++r) { Ss[(mrow + r) * LD + ncol] = sm[x][r]; SC[(mrow + r) * 64 + ncol] = sm[x][r]; } }
            *(f32x4*)(Gc + (tid >> 3) * LD + 8 * (tid & 7)) = gpre[0]; *(f32x4*)(Gc + (tid >> 3) * LD + 8 * (tid & 7) + 4) = gpre[1];
            if (c + 1 < NCH) { const RwcPtr On = rwc_ptr(C.ws, bh * NCH + c + 1); gpre[0] = *(const f32x4*)(On.G + tid * 8); gpre[1] = *(const f32x4*)(On.G + tid * 8 + 4); }
            __syncthreads();
#pragma unroll
            for (int x = 0; x < 2; ++x) { const int tc = tc0 + x, ncol = 16 * tc + (lane & 15);
                f32x4 a = {O.HT[(mrow + 0) * 64 + ncol], O.HT[(mrow + 1) * 64 + ncol], O.HT[(mrow + 2) * 64 + ncol], O.HT[(mrow + 3) * 64 + ncol]};
                mm_cc<64>(a, Ss, LD, Gc, LD, tr, tc, lane); sm[x] = a; }
        }
    }
    __syncthreads();
}

DI void phase_rw3(const Ctx& C, int l, int w0, int nw) {
    PHASE_IDS
    (void)l;
    float* Ps = (float*)C.lds; float* Ss = Ps + RC * LD;
    const int tid = P_tid, lane = P_lane, w = P_wave;
    const int tr = w >> 2, tc = w & 3, mrow = 16 * tr + 4 * (lane >> 4), ncol = 16 * tc + (lane & 15);
    float* RWY = (float*)(C.ws + WS_RWY);
    f32x4 ns0, ns1, np0, np1, ny;
#define RW3_LOAD(unit_) { const RwcPtr On = rwc_ptr(C.ws, (unit_)); const float* SCn = (const float*)(C.ws + WS_RWS) + (size_t)(unit_) * 4096; \
        ns0 = *(const f32x4*)(SCn + tid * 8); ns1 = *(const f32x4*)(SCn + tid * 8 + 4); \
        if (tid < 256) { np0 = *(const f32x4*)(On.Pm + tid * 8); np1 = *(const f32x4*)(On.Pm + tid * 8 + 4); } \
        ny = (f32x4){On.Y0[(mrow + 0) * 64 + ncol], On.Y0[(mrow + 1) * 64 + ncol], On.Y0[(mrow + 2) * 64 + ncol], On.Y0[(mrow + 3) * 64 + ncol]}; }
    if (C.vcu - w0 < 32 * NCH) RW3_LOAD(C.vcu - w0)
    for (int unit = C.vcu - w0; unit < 32 * NCH; unit += nw) {
        const int bh = unit / NCH, c = unit % NCH, bb = bh >> 2, h = bh & 3;
        __syncthreads();
        { const int row = tid >> 3, ch = 8 * (tid & 7);
          *(f32x4*)(Ss + row * LD + ch) = ns0; *(f32x4*)(Ss + row * LD + ch + 4) = ns1;
          if (tid < 256) { *(f32x4*)(Ps + row * LD + ch) = np0; *(f32x4*)(Ps + row * LD + ch + 4) = np1; } }
        f32x4 a = ny;
        if (unit + nw < 32 * NCH) RW3_LOAD(unit + nw)
        __syncthreads();
        mm_cc<64>(a, Ps, LD, Ss, LD, tr, tc, lane);
#pragma unroll
        for (int r = 0; r < 4; ++r) RWY[((size_t)bb * SEQ + c * RC + mrow + r) * 256 + h * 64 + ncol] = a[r];
    }
#undef RW3_LOAD
    __syncthreads();
}

DI void phase_post(const Ctx& C, int l) {
    PHASE_IDS
    const float* glu = (const float*)(C.ws + WS_GLU); const bf16_t* RWB = (const bf16_t*)(C.ws + WS_RW); const float* RWY = (const float*)(C.ws + WS_RWY);
    bf16_t* mixed = (bf16_t*)(C.ws + WS_MIXED);
    const f32x4 on = ((const f32x4*)(INF(I_SONORM) + l * 256))[P_lane];
    float lnw[4], lnb[4], rkw[4];
#pragma unroll
    for (int h = 0; h < 4; ++h) { lnw[h] = INF(I_LNW)[l * 256 + h * 64 + P_lane]; lnb[h] = INF(I_LNB)[l * 256 + h * 64 + P_lane]; rkw[h] = INF(I_RK)[l * 256 + h * 64 + P_lane]; }
    f32x4 gv = ((const f32x4*)(glu + (size_t)P_gw * 256))[P_lane];
    float y[4], rr[4], kk[4], vv[4], gg[4];
#pragma unroll
    for (int h = 0; h < 4; ++h) { const int j = h * 64 + P_lane; const bf16_t* rw = RWB + (size_t)P_gw * 1536 + j; y[h] = RWY[(size_t)P_gw * 256 + j]; rr[h] = bf2f(rw[0]); kk[h] = bf2f(rw[256]); vv[h] = bf2f(rw[512]); gg[h] = bf2f(rw[1280]); }
    for (int t = P_gw; t < T; t += C.NGW) {
        const int tn = t + C.NGW < T ? t + C.NGW : t;
        const f32x4 gvn = ((const f32x4*)(glu + (size_t)tn * 256))[P_lane];
        float yn[4], rn[4], kn[4], vn[4], gn[4];
#pragma unroll
        for (int h = 0; h < 4; ++h) { const int j = h * 64 + P_lane; const bf16_t* rw = RWB + (size_t)tn * 1536 + j; yn[h] = RWY[(size_t)tn * 256 + j]; rn[h] = bf2f(rw[0]); kn[h] = bf2f(rw[256]); vn[h] = bf2f(rw[512]); gn[h] = bf2f(rw[1280]); }
        const float ss = wave_sum(gv.x * gv.x + gv.y * gv.y + gv.z * gv.z + gv.w * gv.w);
        const float rs = 1.f / sqrtf(ss * (1.f / 256.f) + NORM_EPS);
        *(u32x2*)(mixed + (size_t)t * DM + 512 + 4 * P_lane) = (u32x2){pk2(gv.x * rs * on.x, gv.y * rs * on.y), pk2(gv.z * rs * on.z, gv.w * rs * on.w)};
        float mean[4], dot[4];
#pragma unroll
        for (int h = 0; h < 4; ++h) { mean[h] = wave_sum(y[h]) * (1.f / 64.f); dot[h] = wave_sum(rr[h] * kk[h] * rkw[h]); }
#pragma unroll
        for (int h = 0; h < 4; ++h) { const float dv = y[h] - mean[h]; const float var = wave_sum(dv * dv) * (1.f / 64.f);
            const float yo = (dv * (1.f / sqrtf(var + 64e-5f)) * lnw[h] + lnb[h] + dot[h] * vv[h]) * gg[h];
            mixed[(size_t)t * DM + 768 + h * 64 + P_lane] = (bf16_t)f2bf(yo); }
        gv = gvn;
#pragma unroll
        for (int h = 0; h < 4; ++h) { y[h] = yn[h]; rr[h] = rn[h]; kk[h] = kn[h]; vv[h] = vn[h]; gg[h] = gn[h]; }
    }
}

DI void ce_desc(float& a, float& c) { const float hi = fmaxf(a, c), lo = fminf(a, c); a = hi; c = lo; }
DI void sort16_desc(float (&a)[16]) {
#pragma unroll
    for (int k = 2; k <= 16; k <<= 1)
#pragma unroll
        for (int j = k >> 1; j > 0; j >>= 1)
#pragma unroll
            for (int i = 0; i < 16; ++i) { const int l = i ^ j; if (l > i) { if ((i & k) == 0) ce_desc(a[i], a[l]); else ce_desc(a[l], a[i]); } }
}
DI void merge16_desc(float (&t)[16], const float (&g)[16]) {
#pragma unroll
    for (int i = 0; i < 16; ++i) t[i] = fmaxf(t[i], g[15 - i]);
#pragma unroll
    for (int j = 8; j > 0; j >>= 1)
#pragma unroll
        for (int i = 0; i < 16; ++i) { const int l = i ^ j; if (l > i) ce_desc(t[i], t[l]); }
}
DI void phase_topk(const Ctx& C, int l) {
    PHASE_IDS
    const bf16_t* qp = (const bf16_t*)(C.ws + WS_QP); const bf16_t* subk = (const bf16_t*)(C.ws + WS_SUBK);
    int* IDX = (int*)(C.ws + WS_IDX); float* GATE = (float*)(C.ws + WS_GATE);
    unsigned* scr = (unsigned*)C.lds + P_wave * 2048;
    const float NEG = -3.0e38f;
    for (int task = P_gw; task < (T / 32) * 8; task += C.NGW) {
        const int tile = task >> 3, h = task & 7;
        float LA[16], LB[16];
        {
        int lane0; asm volatile("v_mbcnt_lo_u32_b32 %0, -1, 0\n\tv_mbcnt_hi_u32_b32 %0, -1, %0" : "=v"(lane0)); const int r32 = lane0 & 31, hi = lane0 >> 5;
#pragma unroll
        for (int m = 0; m < 2; ++m) {
            bf16x8 bq[8];
#pragma unroll
            for (int d0 = 0; d0 < 8; ++d0) bq[d0] = *(const bf16x8*)(qp + (size_t)(tile * 32 + r32) * 2048 + h * 256 + m * 128 + d0 * 16 + hi * 8);
            float Lm[16];
#pragma unroll
            for (int i = 0; i < 16; ++i) Lm[i] = NEG;
#pragma unroll
            for (int k = 0; k < 4; ++k) {
                f32x16 acc;
#pragma unroll
                for (int r = 0; r < 16; ++r) acc[r] = 0.f;
                const bf16_t* kp = subk + ((size_t)((l * 8 + h) * 2 + m) * 128 + k * 32 + r32) * 128 + hi * 8;
                bf16x8 akf[8];
#pragma unroll
                for (int d0 = 0; d0 < 8; ++d0) akf[d0] = *(const bf16x8*)(kp + d0 * 16);
                __builtin_amdgcn_sched_barrier(0);
#pragma unroll
                for (int d0 = 0; d0 < 8; ++d0) acc = __builtin_amdgcn_mfma_f32_32x32x16_bf16(akf[d0], bq[d0], acc, 0, 0, 0);
                float gv[16];
#pragma unroll
                for (int r = 0; r < 16; ++r) { const unsigned key = 32 * k + (r & 3) + 8 * (r >> 2) + 4 * hi; const float av = acc[r];
                    gv[r] = __builtin_bit_cast(float, (__builtin_bit_cast(unsigned, av) & ~127u) | key); }
                sort16_desc(gv);
                if (k == 0) {
#pragma unroll
                    for (int i = 0; i < 16; ++i) Lm[i] = gv[i];
                } else merge16_desc(Lm, gv);
                __builtin_amdgcn_sched_barrier(0);
            }
            float ot[16];
#pragma unroll
            for (int i = 0; i < 16; ++i) ot[i] = other_half(Lm[i], hi);
            merge16_desc(Lm, ot);
#pragma unroll
            for (int i = 0; i < 16; ++i) { if (m == 0) LA[i] = Lm[i]; else LB[i] = Lm[i]; }
        }
        }
        int lane; asm volatile("v_mbcnt_lo_u32_b32 %0, -1, 0\n\tv_mbcnt_hi_u32_b32 %0, -1, %0" : "=v"(lane)); const int r32 = lane & 31, hi = lane >> 5;
#pragma unroll
        for (int i = 0; i < 16; ++i) { scr[i * 64 + lane] = __builtin_bit_cast(unsigned, LA[i]) & 127u; scr[(16 + i) * 64 + lane] = __builtin_bit_cast(unsigned, LB[i]) & 127u; }
        float L2[16];
        { float cv[64]; int cnt = 0;
#pragma unroll
          for (int i = 0; i < 16; ++i) {
              const float sa = __builtin_bit_cast(float, __builtin_bit_cast(unsigned, LA[i]) & ~127u);
#pragma unroll
              for (int j = 0; j < 16; ++j) if ((i + 1) * (j + 1) <= 16) {
                  const float sb = __builtin_bit_cast(float, __builtin_bit_cast(unsigned, LB[j]) & ~127u);
                  cv[cnt++] = __builtin_bit_cast(float, (__builtin_bit_cast(unsigned, sa + sb) & ~255u) | (unsigned)(i * 16 + j)); } }
#pragma unroll
          for (int q = 50; q < 64; ++q) cv[q] = NEG;
#pragma unroll
          for (int gI = 0; gI < 4; ++gI) { float gv[16];
#pragma unroll
              for (int q = 0; q < 16; ++q) gv[q] = cv[16 * gI + q];
              sort16_desc(gv);
              if (gI == 0) {
#pragma unroll
                  for (int q = 0; q < 16; ++q) L2[q] = gv[q];
              } else merge16_desc(L2, gv);
              __builtin_amdgcn_sched_barrier(0); } }
        float sc[16], den = 0.f;
#pragma unroll
        for (int q = 0; q < 16; ++q) { sc[q] = __builtin_bit_cast(float, __builtin_bit_cast(unsigned, L2[q]) & ~255u); }
        { const float m0 = sc[0];
#pragma unroll
        for (int q = 0; q < 16; ++q) { sc[q] = __expf(sc[q] - m0); den += sc[q]; } }
        const float rden = 1.f / den;
        if (hi == 0) {
            const size_t ob = (size_t)(tile * 32 + r32) * 128 + h * 16;
#pragma unroll
            for (int q = 0; q < 16; ++q) { const unsigned bits = __builtin_bit_cast(unsigned, L2[q]); const unsigned i = (bits >> 4) & 15u, j = bits & 15u;
                const unsigned e = scr[i * 64 + lane] * 128u + scr[(16 + j) * 64 + lane];
                IDX[ob + q] = (int)e; GATE[ob + q] = sc[q] * rden; }
        }
    }
}

DI void dec16(const u32x4 w, f32x2 (&o)[8]) {
    o[0] = __builtin_amdgcn_cvt_pk_f32_fp8((int)w.x, false); o[1] = __builtin_amdgcn_cvt_pk_f32_fp8((int)w.x, true);
    o[2] = __builtin_amdgcn_cvt_pk_f32_fp8((int)w.y, false); o[3] = __builtin_amdgcn_cvt_pk_f32_fp8((int)w.y, true);
    o[4] = __builtin_amdgcn_cvt_pk_f32_fp8((int)w.z, false); o[5] = __builtin_amdgcn_cvt_pk_f32_fp8((int)w.z, true);
    o[6] = __builtin_amdgcn_cvt_pk_f32_fp8((int)w.w, false); o[7] = __builtin_amdgcn_cvt_pk_f32_fp8((int)w.w, true);
}
DI float bperm_f(int lane_idx, float v) { return __builtin_bit_cast(float, __builtin_amdgcn_ds_bpermute(lane_idx << 2, __builtin_bit_cast(int, v))); }
DI void phase_gather_u(const Ctx& C, int l) {
    PHASE_IDS
    const int s = (int)blockIdx.x & 7, r = (int)blockIdx.x >> 3, tstride = (C.G >> 3) * NWAVES;
    const int lane = P_lane, sub = lane >> 3, chunk = lane & 7;
    int* wi = (int*)C.lds + P_wave * 128;
    const unsigned char* U8 = C.ws + WS_U8 + (size_t)l * NEXP * DM + s * 128; const unsigned lo16 = 16u * (unsigned)chunk;
    const bf16_t* H2 = (const bf16_t*)(C.ws + WS_H) + s * 128 + 16 * chunk;
    const int* IDX = (const int*)(C.ws + WS_IDX); bf16_t* PART = (bf16_t*)(C.ws + WS_PART);
    const int t0 = r * NWAVES + P_wave;
    if (t0 >= T) return;
    int i0 = IDX[(size_t)t0 * 128 + lane], i1 = IDX[(size_t)t0 * 128 + 64 + lane];
    u32x4 ha = *(const u32x4*)(H2 + (size_t)t0 * DM), hb = *(const u32x4*)(H2 + (size_t)t0 * DM + 8);
    for (int t = t0; t < T; t += tstride) {
        wi[lane] = i0; wi[64 + lane] = i1;
        f32x2 hf[8];
        hf[0] = (f32x2){bflo(ha.x), bfhi(ha.x)}; hf[1] = (f32x2){bflo(ha.y), bfhi(ha.y)}; hf[2] = (f32x2){bflo(ha.z), bfhi(ha.z)}; hf[3] = (f32x2){bflo(ha.w), bfhi(ha.w)};
        hf[4] = (f32x2){bflo(hb.x), bfhi(hb.x)}; hf[5] = (f32x2){bflo(hb.y), bfhi(hb.y)}; hf[6] = (f32x2){bflo(hb.z), bfhi(hb.z)}; hf[7] = (f32x2){bflo(hb.w), bfhi(hb.w)};
        { const int tn = t + tstride < T ? t + tstride : t;
          i0 = IDX[(size_t)tn * 128 + lane]; i1 = IDX[(size_t)tn * 128 + 64 + lane]; ha = *(const u32x4*)(H2 + (size_t)tn * DM); hb = *(const u32x4*)(H2 + (size_t)tn * DM + 8); }
        float pd[16];
#pragma unroll
        for (int half = 0; half < 2; ++half) {
            u32x4 rw[8];
#pragma unroll
            for (int i = 0; i < 8; ++i) { const int e = wi[(half * 8 + i) * 8 + sub]; rw[i] = *(const u32x4*)(U8 + (((unsigned)e << 10) + lo16)); }
#pragma unroll
            for (int i = 0; i < 8; i += 2) {
                f32x2 d[8], e[8]; dec16(rw[i], d); dec16(rw[i + 1], e);
                f32x2 a0 = d[0] * hf[0], a1 = d[1] * hf[1], b0 = e[0] * hf[0], b1 = e[1] * hf[1];
#pragma unroll
                for (int k = 2; k < 8; k += 2) { a0 += d[k] * hf[k]; b0 += e[k] * hf[k]; a1 += d[k + 1] * hf[k + 1]; b1 += e[k + 1] * hf[k + 1]; }
                a0 += a1; b0 += b1;
                pd[half * 8 + i] = a0.x + a0.y; pd[half * 8 + i + 1] = b0.x + b0.y; __builtin_amdgcn_sched_barrier(0); }
        }
        float w1[8], w2[4];
#pragma unroll
        for (int k = 0; k < 8; ++k) { const float keep = (chunk & 4) ? pd[8 + k] : pd[k], send = (chunk & 4) ? pd[k] : pd[8 + k]; w1[k] = keep + dpp_f<0x141>(send); }
#pragma unroll
        for (int k = 0; k < 4; ++k) { const float keep = (chunk & 2) ? w1[4 + k] : w1[k], send = (chunk & 2) ? w1[k] : w1[4 + k]; w2[k] = keep + dpp_f<0x4E>(send); }
        const float o0 = ((chunk & 1) ? w2[2] : w2[0]) + dpp_f<0xB1>((chunk & 1) ? w2[0] : w2[2]), o1 = ((chunk & 1) ? w2[3] : w2[1]) + dpp_f<0xB1>((chunk & 1) ? w2[1] : w2[3]);
        bf16_t* pp = PART + ((size_t)t * 8 + s) * 128 + sub;
        pp[(2 * chunk) * 8] = (bf16_t)f2bf(o0); pp[(2 * chunk + 1) * 8] = (bf16_t)f2bf(o1);
    }
}
DI void phase_gather_c(const Ctx& C, int l) {
    PHASE_IDS
    const float* SU = (const float*)(C.ws + WS_SU) + l * NEXP; const float* SV = (const float*)(C.ws + WS_SV) + l * NEXP;
    const int* IDX = (const int*)(C.ws + WS_IDX); const float* GATE = (const float*)(C.ws + WS_GATE); float* COEF = (float*)(C.ws + WS_COEF); const bf16_t* PART = (const bf16_t*)(C.ws + WS_PART);
    for (int t = P_gw; t < T; t += C.NGW) {
#pragma unroll
        for (int hq = 0; hq < 2; ++hq) { const int p = hq * 64 + P_lane; const int e = IDX[(size_t)t * 128 + p]; float d = 0.f;
#pragma unroll
            for (int s = 0; s < 8; ++s) d += bf2f(PART[((size_t)t * 8 + s) * 128 + p]);
            COEF[(size_t)t * 128 + p] = GATE[(size_t)t * 128 + p] * gelu_erf(d * SU[e]) * SV[e]; }
    }
}
DI void phase_gather_v(const Ctx& C, int l) {
    PHASE_IDS
    const int s = (int)blockIdx.x & 7, r = (int)blockIdx.x >> 3, tstride = (C.G >> 3) * NWAVES;
    const int lane = P_lane, hi = lane >> 5, b4 = (lane >> 4) & 1, b3 = (lane >> 3) & 1, sub = lane >> 3, chunk = lane & 7;
    int* wi = (int*)C.lds + P_wave * 256; float* wc = (float*)(wi + 128);
    const unsigned char* V8 = C.ws + WS_V8 + (size_t)l * NEXP * DM + s * 128; const unsigned lo16 = 16u * (unsigned)chunk;
    const int* IDX = (const int*)(C.ws + WS_IDX); const float* COEF = (const float*)(C.ws + WS_COEF);
    const int tv0 = r * NWAVES + P_wave;
    if (tv0 >= T) return;
    int i0 = IDX[(size_t)tv0 * 128 + lane], i1 = IDX[(size_t)tv0 * 128 + 64 + lane]; float c0 = COEF[(size_t)tv0 * 128 + lane], c1 = COEF[(size_t)tv0 * 128 + 64 + lane];
    for (int t = tv0; t < T; t += tstride) {
        wi[lane] = i0; wi[64 + lane] = i1; wc[lane] = c0; wc[64 + lane] = c1;
        { const int tn = t + tstride < T ? t + tstride : t;
          i0 = IDX[(size_t)tn * 128 + lane]; i1 = IDX[(size_t)tn * 128 + 64 + lane]; c0 = COEF[(size_t)tn * 128 + lane]; c1 = COEF[(size_t)tn * 128 + 64 + lane]; }
        f32x2 acc[8];
#pragma unroll
        for (int k = 0; k < 8; ++k) acc[k] = (f32x2){0.f, 0.f};
#pragma unroll
        for (int half = 0; half < 2; ++half) {
            u32x4 rw[8]; float cf[8];
#pragma unroll
            for (int i = 0; i < 8; ++i) { const int ii = (half * 8 + i) * 8 + sub; const int e = wi[ii]; cf[i] = wc[ii]; rw[i] = *(const u32x4*)(V8 + (((unsigned)e << 10) + lo16)); }
#pragma unroll
            for (int i = 0; i < 8; ++i) { f32x2 d[8]; dec16(rw[i], d); const f32x2 c2 = (f32x2){cf[i], cf[i]};
#pragma unroll
                for (int k = 0; k < 8; ++k) acc[k] += c2 * d[k];
                __builtin_amdgcn_sched_barrier(0); }
        }
        f32x2 q1[4], q2[2], q3;
#pragma unroll
        for (int i = 0; i < 4; ++i) { const f32x2 keep = hi ? acc[4 + i] : acc[i], send = hi ? acc[i] : acc[4 + i]; q1[i] = keep + (f32x2){other_half(send.x, hi), other_half(send.y, hi)}; }
#pragma unroll
        for (int i = 0; i < 2; ++i) { const f32x2 keep = b4 ? q1[2 + i] : q1[i], send = b4 ? q1[i] : q1[2 + i]; q2[i] = keep + (f32x2){xor16(send.x), xor16(send.y)}; }
        { const f32x2 keep = b3 ? q2[1] : q2[0], send = b3 ? q2[0] : q2[1]; q3 = keep + (f32x2){xor8(send.x), xor8(send.y)}; }
        f32x2* op = (f32x2*)(C.out + (size_t)t * DM + s * 128 + 16 * chunk + 2 * (4 * hi + 2 * b4 + b3));
        *op = *op + q3;
    }
}

struct EpiResF32 {
    static constexpr bool PERM = false, AFTER_DRAIN = false;
    const float* R; float* Cc; int ldc;
    __device__ __forceinline__ void operator()(const pg8::f32x4 (&acc)[2][2][4][2], const pg8::Unit& u, int wr, int wc, int fr, int fq) const {
        int ln_; asm volatile("v_mbcnt_lo_u32_b32 %0, -1, 0\n\tv_mbcnt_hi_u32_b32 %0, -1, %0" : "=v"(ln_)); const int fr_ = ln_ & 15, fq_ = ln_ >> 4; (void)fr; (void)fq;
        const int row0 = u.pm * 256 + wr * 64 + fr_, col0 = u.pn * 256 + wc * 32 + 4 * fq_;
#pragma unroll
        for (int ai = 0; ai < 2; ++ai)
#pragma unroll
            for (int m = 0; m < 4; ++m) { const size_t ro = (size_t)(row0 + ai * 128 + m * 16) * ldc + col0;
#pragma unroll
                for (int bj = 0; bj < 2; ++bj)
#pragma unroll
                    for (int n = 0; n < 2; ++n) { const pg8::f32x4 r = *(const pg8::f32x4*)(R + ro + bj * 128 + n * 16); *(pg8::f32x4*)(Cc + ro + bj * 128 + n * 16) = acc[ai][bj][m][n] + r; } __builtin_amdgcn_sched_barrier(0); }
    }
};
struct EpiGlu {
    static constexpr bool PERM = false, AFTER_DRAIN = false;
    const bf16_t* YG; const float* bias; float* Gg;
    __device__ __forceinline__ void operator()(const pg8::f32x4 (&acc)[2][2][4][2], const pg8::Unit& u, int wr, int wc, int fr, int fq) const {
        int ln_; asm volatile("v_mbcnt_lo_u32_b32 %0, -1, 0\n\tv_mbcnt_hi_u32_b32 %0, -1, %0" : "=v"(ln_)); const int fr_ = ln_ & 15, fq_ = ln_ >> 4; (void)fr; (void)fq;
        const int row0 = u.pm * 256 + wr * 64 + fr_, col0 = wc * 32 + 4 * fq_;
#pragma unroll
        for (int ai = 0; ai < 2; ++ai)
#pragma unroll
            for (int m = 0; m < 4; ++m) { const size_t ro = (size_t)(row0 + ai * 128 + m * 16) * 256 + col0;
#pragma unroll
                for (int bj = 0; bj < 2; ++bj)
#pragma unroll
                    for (int n = 0; n < 2; ++n) { const size_t o = ro + bj * 128 + n * 16; const pg8::f32x4 bv = *(const pg8::f32x4*)(bias + col0 + bj * 128 + n * 16);
                        const u32x2 y = *(const u32x2*)(YG + o); const pg8::f32x4 a = acc[ai][bj][m][n] + bv;
                        pg8::f32x4 r; r.x = bflo(y.x) * sigmoidf_(a.x); r.y = bfhi(y.x) * sigmoidf_(a.y); r.z = bflo(y.y) * sigmoidf_(a.z); r.w = bfhi(y.y) * sigmoidf_(a.w);
                        *(pg8::f32x4*)(Gg + o) = r; } __builtin_amdgcn_sched_barrier(0); }
    }
};

#ifndef MK_ONLY
#define MK_ONLY -1
#endif
#define PH_EN(k) ((MK_ONLY) < 0 || (MK_ONLY) == (k))
constexpr int PH_PER_LAYER = 15, NPHASES = 1 + DEPTH * PH_PER_LAYER;
__global__ void __launch_bounds__(NTHR, 2) fwd(Args args) {
    extern __shared__ __attribute__((aligned(16))) unsigned char lds_raw[];
    Ctx C;
    C.in = args.in; C.out = args.out; C.ws = args.ws; C.lds = (char*)lds_raw;
    C.G = gridDim.x; { const int bx = blockIdx.x; C.vcu = (C.G % 8 == 0) ? (bx % 8) * (C.G / 8) + bx / 8 : bx; }
    C.NGW = C.G * NWAVES; C.wave = __builtin_amdgcn_readfirstlane((int)threadIdx.x >> 6);
    volatile LAS unsigned* MISC = (volatile LAS unsigned*)((LAS unsigned char*)lds_raw + MISC_OFF);
    if (threadIdx.x < 64) MISC[threadIdx.x] = 0u;
    __syncthreads();
    XcdBarrier bar; bar.bar = (unsigned*)(args.ws + WS_CTL) + 4096 + args.bli * XCD_BAR_WORDS; bar.x = 0; bar.st = MISC + 8;
    const bool multi = (args.ph_hi - args.ph_lo) > 1;
    if (multi) bar = xcd_barrier_post((unsigned*)(args.ws + WS_CTL) + 4096 + args.bli * XCD_BAR_WORDS, MISC + 8);
    LAS unsigned char* ldsp = (LAS unsigned char*)lds_raw;

#ifndef MK_SPLIT_MIXERS
#define MK_SPLIT_MIXERS 0
#endif
#ifndef MK_NOISE
#define MK_NOISE 0
#endif
#ifndef MK_RWKV_NAIVE
#define MK_RWKV_NAIVE 0
#endif
#ifndef MK_REPK
#define MK_REPK -1
#endif
#define REPS_(k) ((MK_REPK) == (k) ? 2 : 1)
#define IN_(P) (args.ph_lo <= (P) && (P) < args.ph_hi)
#define RUNP_(k, stmt) for (int r_ = 0; r_ < REPS_(k); ++r_) { if (r_) xcd_barrier(bar, C.wave); stmt; }
#define SEAM_(P) do { if (IN_(P) && IN_((P) + 1)) xcd_barrier(bar, C.wave); } while (0)
#define GEMM_(EPI, EXPR_E, A_, BT_, M_, N_, K_) do { pg8::Gemm g{(const bf16_t*)(A_), (const bf16_t*)(BT_), (M_), (N_), (K_)}; pg8::StaticOrder S; S.init((M_), (N_), C.G, (int)blockIdx.x); EPI E EXPR_E; \
        pg8::gemm_phase<EPI, pg8::StaticOrder>(ldsp, g, S, E, nullptr, C.wave); } while (0)
#define LAYER_(L) do { constexpr int l = (L); constexpr int P0 = 1 + (L) * PH_PER_LAYER; \
    if (IN_(P0 + 0)) { RUNP_(0, phase_rmsnorm<false>(C, (l == 0) ? (const float*)C.in[I_X] : (const float*)C.out, INF(I_NORM_MIX) + l * DM, (bf16_t*)(C.ws + WS_H))) } SEAM_(P0 + 0); \
    if (IN_(P0 + 1)) { RUNP_(1, GEMM_(pg8::EpiBf16<0>, ({(bf16_t*)(C.ws + WS_COLS), INCP, nullptr, 0, 0}), C.ws + WS_H, (const bf16_t*)(C.ws + WS_WTIN) + (size_t)l * INCP * DM, T, INCP, DM)) } SEAM_(P0 + 1); \
    if (IN_(P0 + 2)) { if (PH_EN(2)) phase_prep(C, l); } SEAM_(P0 + 2); \
    if (IN_(P0 + 3)) { for (int r_ = 0; r_ < REPS_(3); ++r_) { if (r_) xcd_barrier(bar, C.wave); if (!MK_RWKV_NAIVE) for (int q_ = 0; q_ < REPS_(32); ++q_) phase_rw1(C, l, 0, C.G); \
                       if (C.G == 256) { if (C.vcu < 128) phase_ssm(C, l, 0, 128); phase_attn_queue(C, l, 0); } else { phase_ssm(C, l, 0, C.G); phase_attn(C, l, 0, C.G); } } } SEAM_(P0 + 3); \
    if (IN_(P0 + 4)) for (int r_ = 0; r_ < REPS_(4); ++r_) { if (r_) xcd_barrier(bar, C.wave); if (C.G == 256) { if (C.vcu < 32) phase_rw2(C, l, 0, 32); phase_attn_queue(C, l, 1); } else phase_rw2(C, l, 0, C.G); } SEAM_(P0 + 4); \
    if (IN_(P0 + 5)) { if (!MK_RWKV_NAIVE) RUNP_(5, phase_rw3(C, l, 0, C.G)) } \
    if (IN_(P0 + 6)) { if (PH_EN(6)) GEMM_(EpiGlu, ({(const bf16_t*)(C.ws + WS_YG), INF(I_BGLU) + l * 256, (float*)(C.ws + WS_GLU)}), C.ws + WS_YG, (const bf16_t*)(C.ws + WS_WTGLU) + (size_t)l * 256 * 256, T, 256, 256); } SEAM_(P0 + 6); \
    if (IN_(P0 + 7)) { RUNP_(7, phase_post(C, l)) } SEAM_(P0 + 7); \
    if (IN_(P0 + 8)) { if (PH_EN(8)) GEMM_(EpiResF32, ({(l == 0) ? (const float*)C.in[I_X] : (const float*)C.out, C.out, DM}), C.ws + WS_MIXED, (const bf16_t*)(C.ws + WS_WTOUT) + (size_t)l * DM * DM, T, DM, DM); } SEAM_(P0 + 8); \
    if (IN_(P0 + 9)) { RUNP_(9, phase_rmsnorm<false>(C, C.out, INF(I_NORM_FFN) + l * DM, (bf16_t*)(C.ws + WS_H))) } SEAM_(P0 + 9); \
    if (IN_(P0 + 10)) { if (PH_EN(10)) GEMM_(pg8::EpiBf16<0>, ({(bf16_t*)(C.ws + WS_QP), 2048, nullptr, 0, 0}), C.ws + WS_H, (const bf16_t*)(C.ws + WS_WTQ) + (size_t)l * 2048 * DM, T, 2048, DM); } SEAM_(P0 + 10); \
    if (IN_(P0 + 11)) { for (int r_ = 0; r_ < REPS_(11); ++r_) { if (r_) xcd_barrier(bar, C.wave); phase_topk(C, l); } } SEAM_(P0 + 11); \
    if (IN_(P0 + 12)) { for (int r_ = 0; r_ < REPS_(12); ++r_) { if (r_) xcd_barrier(bar, C.wave); phase_gather_u(C, l); } } SEAM_(P0 + 12); \
    if (IN_(P0 + 13)) { RUNP_(13, phase_gather_c(C, l)) } SEAM_(P0 + 13); \
    if (IN_(P0 + 14)) { phase_gather_v(C, l); } SEAM_(P0 + 14); \
    } while (0)
    if (IN_(0)) { if (PH_EN(100)) phase_prologue(C); } SEAM_(0);
    LAYER_(0); LAYER_(1); LAYER_(2); LAYER_(3);
}
}

extern "C" void kernel_launch(void* const* d_in, const int* in_sizes, int n_in, void* d_out, int out_size, void* d_ws, size_t ws_size, hipStream_t stream) {
    using namespace mk;
    static int grid = 0;
    if (grid == 0) {
        if (n_in != N_IN || out_size != T * DM || ws_size < WS_END) { fprintf(stderr, "kernel_launch: unexpected shapes (n_in %d, out %d, ws %zu)\n", n_in, out_size, ws_size); grid = -1; return; }
        int dev = 0, cus = 0;
        if (hipGetDevice(&dev) != hipSuccess || hipDeviceGetAttribute(&cus, hipDeviceAttributeMultiprocessorCount, dev) != hipSuccess) { grid = -1; return; }
        if (hipFuncSetAttribute((const void*)fwd, hipFuncAttributeMaxDynamicSharedMemorySize, LDS_BYTES) != hipSuccess) { fprintf(stderr, "kernel_launch: hipFuncSetAttribute failed\n"); grid = -1; return; }
        int per_cu = 0;
        if (hipOccupancyMaxActiveBlocksPerMultiprocessor(&per_cu, (const void*)fwd, NTHR, LDS_BYTES) != hipSuccess || per_cu < 1) fprintf(stderr, "kernel_launch: occupancy query says %d\n", per_cu);
        (void)hipGetLastError();
        grid = cus;
    }
    if (grid < 0) return;
    (void)hipMemsetAsync((char*)d_ws + WS_CTL, 0, CTL_BYTES, stream);
    Args a{};
    for (int i = 0; i < N_IN; ++i) a.in[i] = d_in[i];
    a.out = (float*)d_out; a.ws = (unsigned char*)d_ws;
#if MK_DEBUG
    {
        auto run = [&](int p) { a.ph_lo = p; a.ph_hi = p + 1; hipLaunchKernelGGL(fwd, dim3(grid), dim3(NTHR), LDS_BYTES, stream, a); };
        auto chk = [&](int stage, int blocks, int thr, int ldsb) { hipLaunchKernelGGL(dbg_check, dim3(blocks), dim3(thr), ldsb, stream, a, stage, (int)MK_DBG_LAYER); };
        static bool attr = false; if (!attr) { (void)hipFuncSetAttribute((const void*)dbg_check, hipFuncAttributeMaxDynamicSharedMemorySize, 65536); attr = true; }
        run(0); chk(20, 1, 256, 0);
        for (int l = 0; l < MK_DBG_LAYER; ++l) for (int k = 0; k < PH_PER_LAYER; ++k) run(1 + l * PH_PER_LAYER + k);
        const int base = 1 + MK_DBG_LAYER * PH_PER_LAYER;
        run(base + 0); chk(1, 8, 256, 0);
        run(base + 1); chk(2, 16, 256, 0); chk(34, 16, 256, 0); chk(35, 64, 256, 0); chk(37, 64, 256, 0);
        run(base + 2); chk(46, 256, 256, 0); chk(38, 16, 256, 0); chk(3, 2, 256, 65536); chk(4, 2, 256, 0);
        run(base + 3);
        run(base + 4); chk(5, 16, 256, 0); chk(6, 1, 256, 0);
        run(base + 5); chk(7, 8, 256, 0);
        run(base + 6); run(base + 7); chk(8, 4, 64, 65536); chk(9, 4, 256, 0);
        run(base + 8); chk(10, 16, 256, 0);
        run(base + 9); chk(11, 8, 256, 0);
        run(base + 10); chk(12, 16, 256, 0);
        run(base + 11); chk(61, 4, 256, 65536); chk(13, 8, 64, 65536); chk(140, 4, 256, 0);
        run(base + 12); run(base + 13); chk(141, 16, 256, 0); run(base + 14); chk(14, 4, 256, 0);
#ifdef MK_DBG_VAL
        hipLaunchKernelGGL(dbg_encode_val, dim3(1024), dim3(256), 0, stream, a, MK_DBG_VAL);
#elif defined(MK_DBG_LVL)
        hipLaunchKernelGGL(dbg_encode_lvl, dim3(1024), dim3(256), 0, stream, a, MK_DBG_LVL);
#else
        hipLaunchKernelGGL(dbg_encode, dim3(1024), dim3(256), 0, stream, a, MK_DBG_SET);
#endif
    }
#elif defined(MK_CUTS)
    { const int cuts[] = {0, MK_CUTS, NPHASES}; const int nc = (int)(sizeof(cuts) / sizeof(int));
      for (int i = 0; i + 1 < nc; ++i) { a.ph_lo = cuts[i]; a.ph_hi = cuts[i + 1]; a.bli = i; hipLaunchKernelGGL(fwd, dim3(grid), dim3(NTHR), LDS_BYTES, stream, a); } }
#elif MK_ONE_LAUNCH
    a.ph_lo = 0; a.ph_hi = NPHASES;
    hipLaunchKernelGGL(fwd, dim3(grid), dim3(NTHR), LDS_BYTES, stream, a);
#else
    for (int p = 0; p < NPHASES; ++p) { a.ph_lo = p; a.ph_hi = p + 1; hipLaunchKernelGGL(fwd, dim3(grid), dim3(NTHR), LDS_BYTES, stream, a); }
#endif
}
```

```cpp
#include <hip/hip_runtime.h>
#include <cstdio>
#include <cstdint>
#define MK_ONE_LAUNCH 1
#ifndef MK_ONE_LAUNCH
#define MK_ONE_LAUNCH 0
#endif
#ifndef MK_DEBUG
#define MK_DEBUG 0
#endif
#ifndef MK_DBG_LAYER
#define MK_DBG_LAYER 0
#endif
#ifndef MK_DBG_SET
#define MK_DBG_SET 5,6,7,13,14,4
#endif
namespace pg8 {
#define PG8_LAS __attribute__((address_space(3)))
typedef unsigned short bf16_t;
typedef short bf16x8 __attribute__((ext_vector_type(8)));
typedef float f32x4 __attribute__((ext_vector_type(4)));
typedef unsigned u32x4 __attribute__((ext_vector_type(4)));
constexpr int BM = 256, BK = 64, HALF = 128, HTB = HALF * BK * 2  , STAGE_BYTES = 8 * HTB, NXCD = 8, WGM = 8;

__host__ __device__ __forceinline__ int lds_byte(int r, int c) { const int st = (r >> 4) * 2 + (c >> 5), rr = r & 15, cc = c & 31, ob = rr * 64 + cc * 2; return st * 1024 + (ob ^ (((ob >> 9) & 1) << 5)); }
__host__ __device__ __forceinline__ void stage_rc(int b, int& R, int& C) { const int st = b / 1024, sb = b % 1024, swz = sb ^ (((sb >> 9) & 1) << 5); R = (st >> 1) * 16 + swz / 64; C = (st & 1) * 32 + (swz % 64) / 2; }
__host__ __device__ __forceinline__ int perm32(int rho) { const int n = rho >> 4, i = rho & 15; return 8 * (i >> 2) + 4 * n + (i & 3); }

struct Unit { int pm, pn; };
struct Gemm { const bf16_t* A; const bf16_t* Bt; int M, N, K; };

struct StaticOrder {
    int nM, nN, nwg, G, c;
    __host__ __device__ void init(int M, int N, int G_, int c_) { nM = M / BM; nN = N / BM; nwg = nM * nN; G = G_; c = c_; }
    __host__ __device__ bool next(int i, Unit& u) const {
        const long L = (long)i * G + c; if (L >= nwg) return false;
        int wgid = (int)L; { const int q = nwg / NXCD, r = nwg % NXCD, xcd = wgid % NXCD, off = wgid / NXCD; wgid = (xcd < r ? xcd * (q + 1) : r * (q + 1) + (xcd - r) * q) + off; }
        const int nig = WGM * nN, gid = wgid / nig, fm = gid * WGM, gsz = (nM - fm) < WGM ? (nM - fm) : WGM;
        u.pm = fm + ((wgid % nig) % gsz); u.pn = (wgid % nig) / gsz; return true;
    }
    __device__ __forceinline__ void a_ready(const Unit&) const {}
    __device__ __forceinline__ void done(const Unit&) const {}
};

__device__ __forceinline__ unsigned cvt_pk_bf16(float lo, float hi) { unsigned r; asm volatile("v_cvt_pk_bf16_f32 %0, %1, %2" : "=v"(r) : "v"(lo), "v"(hi)); return r; }
typedef float f32x2 __attribute__((ext_vector_type(2)));
__device__ __forceinline__ f32x2 gelu_pk(f32x2 v) {
    const f32x2 av = __builtin_elementwise_abs(v), d = av * 0.2316418882f + 1.0f;
    f32x2 t; t.x = __builtin_amdgcn_rcpf(d.x); t.y = __builtin_amdgcn_rcpf(d.y);
    f32x2 q = t * 0.5307027145f + (-0.7265760135f); q = q * t + 0.7107068705f; q = q * t + (-0.142248368f); q = q * t + 0.127414796f; q = q * t;
    const f32x2 s = (v * v) * (-0.72134752044f);
    f32x2 e; e.x = __builtin_amdgcn_exp2f(s.x); e.y = __builtin_amdgcn_exp2f(s.y);
    const f32x2 m = v * (q * e), r = v - m;
    f32x2 o; o.x = v.x < 0.f ? m.x : r.x; o.y = v.y < 0.f ? m.y : r.y; return o;
}

struct EpiF32 {
    static constexpr bool PERM = false, AFTER_DRAIN = false;
    float* C; int ldc; const float* bias;
    __device__ __forceinline__ void operator()(const f32x4 (&acc)[2][2][4][2], const Unit& u, int wr, int wc, int fr, int fq) const {
        const int row0 = u.pm * BM + wr * 64 + fr, col0 = u.pn * BM + wc * 32 + 4 * fq;
        f32x4 bv[2][2];
#pragma unroll
        for (int bj = 0; bj < 2; ++bj)
#pragma unroll
            for (int n = 0; n < 2; ++n) bv[bj][n] = bias ? *(const f32x4*)(bias + col0 + bj * HALF + n * 16) : (f32x4){0.f, 0.f, 0.f, 0.f};
#pragma unroll
        for (int ai = 0; ai < 2; ++ai)
#pragma unroll
            for (int m = 0; m < 4; ++m) { float* rowp = C + (size_t)(row0 + ai * HALF + m * 16) * ldc + col0;
#pragma unroll
                for (int bj = 0; bj < 2; ++bj)
#pragma unroll
                    for (int n = 0; n < 2; ++n) *(f32x4*)(rowp + bj * HALF + n * 16) = acc[ai][bj][m][n] + bv[bj][n]; }
    }
};
template <int ACT  > struct EpiBf16 {
    static constexpr bool PERM = true, AFTER_DRAIN = false;
    bf16_t* O; int ldc; const float* bias; int split_cols; size_t split_stride;
    __device__ __forceinline__ void operator()(const f32x4 (&acc)[2][2][4][2], const Unit& u, int wr, int wc, int fr_in, int fq_in) const {
        int ln_; asm volatile("v_mbcnt_lo_u32_b32 %0, -1, 0\n\tv_mbcnt_hi_u32_b32 %0, -1, %0" : "=v"(ln_)); const int fr = ln_ & 15, fq = ln_ >> 4; (void)fr_in; (void)fq_in;
        const int row0 = u.pm * BM + wr * 64 + fr; int colt = u.pn * BM; bf16_t* base = O;
        if (split_cols) { const int t = colt / split_cols; base += (size_t)t * split_stride; colt -= t * split_cols; }
        const int col0 = colt + wc * 32 + 8 * fq, bcol0 = u.pn * BM + wc * 32 + 8 * fq;
        f32x4 bv[2][2];
#pragma unroll
        for (int bj = 0; bj < 2; ++bj)
#pragma unroll
            for (int n = 0; n < 2; ++n) bv[bj][n] = bias ? *(const f32x4*)(bias + bcol0 + bj * HALF + 4 * n) : (f32x4){0.f, 0.f, 0.f, 0.f};
#pragma unroll
        for (int ai = 0; ai < 2; ++ai)
#pragma unroll
            for (int m = 0; m < 4; ++m) { bf16_t* rowp = base + (size_t)(row0 + ai * HALF + m * 16) * ldc + col0;
#pragma unroll
                for (int bj = 0; bj < 2; ++bj) { f32x4 v0 = acc[ai][bj][m][0] + bv[bj][0], v1 = acc[ai][bj][m][1] + bv[bj][1];
                    if (ACT == 1) { f32x2 a = gelu_pk((f32x2){v0[0], v0[1]}), b = gelu_pk((f32x2){v0[2], v0[3]}), c = gelu_pk((f32x2){v1[0], v1[1]}), d = gelu_pk((f32x2){v1[2], v1[3]});
                        v0 = (f32x4){a.x, a.y, b.x, b.y}; v1 = (f32x4){c.x, c.y, d.x, d.y}; }
                    if (ACT == 2) {
#pragma unroll
                        for (int j = 0; j < 4; ++j) { v0[j] = 0.5f * v0[j] * (1.0f + erff(v0[j] * 0.70710678f)); v1[j] = 0.5f * v1[j] * (1.0f + erff(v1[j] * 0.70710678f)); } }
                    u32x4 w; w.x = cvt_pk_bf16(v0[0], v0[1]); w.y = cvt_pk_bf16(v0[2], v0[3]); w.z = cvt_pk_bf16(v1[0], v1[1]); w.w = cvt_pk_bf16(v1[2], v1[3]);
                    *(u32x4*)(rowp + bj * HALF) = w; } }
    }
};

template <class Epi, class Sched, bool STAMP = false>
__device__ __forceinline__ void gemm_phase(PG8_LAS unsigned char* lds, const Gemm g, const Sched& S, const Epi& E, unsigned long long* stamps, int wave_in) {
    int lane_; asm volatile("v_mbcnt_lo_u32_b32 %0, -1, 0\n\tv_mbcnt_hi_u32_b32 %0, -1, %0" : "=v"(lane_)); const int tid = wave_in * 64 + lane_; const int wid = wave_in, lane = tid & 63, wr = wid >> 2, wc = wid & 3, fr = lane & 15, fq = lane >> 4;
    const int K = g.K, nt = K / BK;
    int ts_lo = 0, ts_hi = 0, nts = 0; const unsigned long long rt_entry = STAMP ? (unsigned long long)wall_clock64() : 0ull;
#define PG8_STAMP() do { if (STAMP && wid == 0 && nts < 64) { const unsigned long long _c = (unsigned long long)clock64(); \
        ts_lo = (lane == nts) ? (int)(unsigned)_c : ts_lo; ts_hi = (lane == nts) ? (int)(unsigned)(_c >> 32) : ts_hi; ++nts; } } while (0)
    PG8_STAMP();
    unsigned voffA[2], voffB[2];
#pragma unroll
    for (int i = 0; i < 2; ++i) { int R, C; stage_rc(tid * 16 + i * 8192, R, C); const int Rb = Epi::PERM ? ((R & ~31) + perm32(R & 31)) : R;
        voffA[i] = (unsigned)(R * K + C) * 2u; voffB[i] = (unsigned)(Rb * K + C) * 2u; }
    const size_t kstep = (size_t)(BK * 2);
    const size_t hstep = (size_t)HALF * K * 2;
    const size_t tstep = 2 * hstep;
    const unsigned ldsw = (unsigned)wid * 1024u;
    const int aoff = lds_byte(wr * 64 + fr, fq * 8), boff = lds_byte(wc * 32 + fr, fq * 8);
#define PG8_SA(b, h) (((b) * 2 + (h)) * HTB)
#define PG8_SB(b, h) ((4 + (b) * 2 + (h)) * HTB)
#define PG8_STAGE(bufoff, gbase, voff) do { _Pragma("unroll") for (int _i = 0; _i < 2; ++_i) \
        __builtin_amdgcn_global_load_lds((const unsigned*)((const char*)(gbase) + (voff)[_i]), (PG8_LAS unsigned*)(lds + (bufoff) + ldsw + _i * 8192), 16, 0, 0); } while (0)
#define PG8_LDA(dst, b, h) do { _Pragma("unroll") for (int m = 0; m < 4; ++m) _Pragma("unroll") for (int k = 0; k < 2; ++k) dst[m][k] = *(const PG8_LAS bf16x8*)(lds + PG8_SA(b, h) + aoff + m * 2048 + k * 1024); } while (0)
#define PG8_LDB(dst, b, h) do { _Pragma("unroll") for (int n = 0; n < 2; ++n) _Pragma("unroll") for (int k = 0; k < 2; ++k) dst[n][k] = *(const PG8_LAS bf16x8*)(lds + PG8_SB(b, h) + boff + n * 2048 + k * 1024); } while (0)
#define PG8_MMA(ai, bj, At, Bt) do { __builtin_amdgcn_s_setprio(1); _Pragma("unroll") for (int m = 0; m < 4; ++m) _Pragma("unroll") for (int n = 0; n < 2; ++n) _Pragma("unroll") for (int k = 0; k < 2; ++k) \
        acc[ai][bj][m][n] = __builtin_amdgcn_mfma_f32_16x16x32_bf16(Bt[n][k], At[m][k], acc[ai][bj][m][n], 0, 0, 0); __builtin_amdgcn_s_setprio(0); } while (0)
#define PG8_WAIT_V(n) asm volatile("s_waitcnt vmcnt(" #n ")" ::: "memory")
#define PG8_WAIT_L(n) asm volatile("s_waitcnt lgkmcnt(" #n ")" ::: "memory")
#define PG8_BAR __builtin_amdgcn_s_barrier()
#define PG8_SCHED __builtin_amdgcn_sched_barrier(0)
    Unit cur, nxt; int ui = 0;
    if (!S.next(0, cur)) return;
    f32x4 acc[2][2][4][2];
#pragma unroll
    for (int a = 0; a < 2; ++a)
#pragma unroll
        for (int b = 0; b < 2; ++b)
#pragma unroll
            for (int m = 0; m < 4; ++m)
#pragma unroll
                for (int n = 0; n < 2; ++n) acc[a][b][m][n] = (f32x4){0.f, 0.f, 0.f, 0.f};
    bf16x8 At[4][2], B0[2][2], B1[2][2];
    const char* cA = (const char*)g.A + (size_t)cur.pm * tstep; const char* cB = (const char*)g.Bt + (size_t)cur.pn * tstep;
    S.a_ready(cur);
    PG8_STAGE(PG8_SB(0, 0), cB, voffB); PG8_STAGE(PG8_SA(0, 0), cA, voffA); PG8_STAGE(PG8_SB(0, 1), cB + hstep, voffB); PG8_STAGE(PG8_SA(0, 1), cA + hstep, voffA);
    if (wr == 1) PG8_BAR;
    PG8_WAIT_V(4); PG8_BAR;
    PG8_STAGE(PG8_SB(1, 0), cB + kstep, voffB); PG8_STAGE(PG8_SA(1, 0), cA + kstep, voffA); PG8_STAGE(PG8_SB(1, 1), cB + hstep + kstep, voffB);
    PG8_WAIT_V(6); PG8_BAR;
    PG8_STAMP();
    for (;;) {
        const bool has_next = S.next(ui + 1, nxt);
        const char* nA = has_next ? (const char*)g.A + (size_t)nxt.pm * tstep : cA; const char* nB = has_next ? (const char*)g.Bt + (size_t)nxt.pn * tstep : cB;
        for (int t = 0; t < nt; t += 2) {
            const bool last = (t == nt - 2);
            const char* a1 = cA + (size_t)(t + 1) * kstep;
            const char* a2 = last ? nA : cA + (size_t)(t + 2) * kstep; const char* b2 = last ? nB : cB + (size_t)(t + 2) * kstep;
            const char* a3 = a2 + kstep; const char* b3 = b2 + kstep;
            if (last && has_next) S.a_ready(nxt);
            PG8_LDB(B0, 0, 0); PG8_SCHED; PG8_LDA(At, 0, 0); PG8_STAGE(PG8_SA(1, 1), a1 + hstep, voffA);
            PG8_WAIT_L(8); PG8_BAR; PG8_WAIT_L(0); PG8_MMA(0, 0, At, B0); PG8_BAR; PG8_SCHED;
            PG8_LDB(B1, 0, 1); PG8_STAGE(PG8_SB(0, 0), b2, voffB);
            PG8_BAR; PG8_WAIT_L(0); PG8_MMA(0, 1, At, B1); PG8_BAR;
            PG8_LDA(At, 0, 1); PG8_STAGE(PG8_SA(0, 0), a2, voffA);
            PG8_BAR; PG8_WAIT_L(0); PG8_MMA(1, 0, At, B0); PG8_BAR; PG8_SCHED;
            PG8_STAGE(PG8_SB(0, 1), b2 + hstep, voffB);
            PG8_WAIT_V(6); PG8_BAR; PG8_MMA(1, 1, At, B1); PG8_BAR;
            PG8_LDB(B0, 1, 0); PG8_SCHED; PG8_LDA(At, 1, 0); PG8_STAGE(PG8_SA(0, 1), a2 + hstep, voffA);
            PG8_WAIT_L(8); PG8_BAR; PG8_WAIT_L(0); PG8_MMA(0, 0, At, B0); PG8_BAR; PG8_SCHED;
            PG8_LDB(B1, 1, 1); PG8_STAGE(PG8_SB(1, 0), b3, voffB);
            PG8_BAR; PG8_WAIT_L(0); PG8_MMA(0, 1, At, B1); PG8_BAR;
            PG8_LDA(At, 1, 1); PG8_STAGE(PG8_SA(1, 0), a3, voffA);
            PG8_BAR; PG8_WAIT_L(0); PG8_MMA(1, 0, At, B0); PG8_BAR; PG8_SCHED;
            PG8_STAGE(PG8_SB(1, 1), b3 + hstep, voffB);
            PG8_WAIT_V(6); PG8_BAR; PG8_MMA(1, 1, At, B1); PG8_BAR;
        }
        PG8_STAMP();
        if constexpr (!Epi::AFTER_DRAIN) { E(acc, cur, wr, wc, fr, fq); S.done(cur); }
        PG8_STAMP();
        if (!has_next) break;
#pragma unroll
        for (int a = 0; a < 2; ++a)
#pragma unroll
            for (int b = 0; b < 2; ++b)
#pragma unroll
                for (int m = 0; m < 4; ++m)
#pragma unroll
                    for (int n = 0; n < 2; ++n) acc[a][b][m][n] = (f32x4){0.f, 0.f, 0.f, 0.f};
        cur = nxt; cA = nA; cB = nB; ++ui;
    }
    PG8_WAIT_V(0);
    if (wr == 0) PG8_BAR;
    PG8_BAR;
    if constexpr (Epi::AFTER_DRAIN) { E.fused(acc, cur, wr, wc, fr, fq, lds, wid, lane); S.done(cur); }
    PG8_STAMP();
    if (STAMP && wid == 0) { stamps[lane] = lane < nts ? (((unsigned long long)(unsigned)ts_hi << 32) | (unsigned)ts_lo) : 0ull;
        if (lane == 62) stamps[62] = rt_entry; if (lane == 63) stamps[63] = (unsigned long long)wall_clock64(); }
#undef PG8_STAMP
#undef PG8_SA
#undef PG8_SB
#undef PG8_STAGE
#undef PG8_LDA
#undef PG8_LDB
#undef PG8_MMA
#undef PG8_WAIT_V
#undef PG8_WAIT_L
#undef PG8_BAR
#undef PG8_SCHED
}
}

namespace mk {
#define DI __device__ __forceinline__
#define LAS __attribute__((address_space(3)))
typedef unsigned short bf16_t;
typedef float f32x4 __attribute__((ext_vector_type(4)));
typedef float f32x2 __attribute__((ext_vector_type(2)));
typedef float f32x16 __attribute__((ext_vector_type(16)));
typedef short bf16x8 __attribute__((ext_vector_type(8)));
typedef short s16x4 __attribute__((ext_vector_type(4)));
typedef unsigned u32x4 __attribute__((ext_vector_type(4)));
typedef unsigned u32x2 __attribute__((ext_vector_type(2)));

constexpr int NB = 8, SEQ = 4096, T = NB * SEQ, DM = 1024, DEPTH = 4;
constexpr int INC = 2688, INCP = 2816;
constexpr int NEXP = 16384;
constexpr float NORM_EPS = 1e-6f;
constexpr int NWAVES = 8, NTHR = 512;

enum { I_X = 0, I_POS, I_NORM_MIX, I_W_IN, I_QN, I_KN, I_LAM, I_SUBLN, I_SLRE, I_SLIM, I_SBRE, I_SBIM, I_SCRE, I_SCIM, I_SD, I_SLOGDT,
       I_WGLU, I_BGLU, I_SONORM, I_MU, I_DECUP, I_DECW0, I_AAAUP, I_AAAA0, I_GATEUP, I_KK, I_KA, I_RK, I_LNW, I_LNB, I_WOUT, I_NORM_FFN,
       I_WQ, I_SUBK, I_PU, I_PV, N_IN };

constexpr size_t MiB = 1u << 20;
constexpr size_t WS_CTL = 0, CTL_BYTES = 1 * MiB;
constexpr size_t WS_WTIN = 1 * MiB;
constexpr size_t WS_WTOUT = WS_WTIN + 22 * MiB;
constexpr size_t WS_WTQ = WS_WTOUT + 8 * MiB;
constexpr size_t WS_WTGLU = WS_WTQ + 16 * MiB;
constexpr size_t WS_SUBK = WS_WTGLU + 1 * MiB;
constexpr size_t WS_ROPE = WS_SUBK + 2 * MiB;
constexpr size_t WS_SSMP = WS_ROPE + 2 * MiB;
constexpr size_t WS_U8 = WS_SSMP + 1 * MiB;
constexpr size_t WS_V8 = WS_U8 + 64 * MiB;
constexpr size_t WS_SU = WS_V8 + 64 * MiB;
constexpr size_t WS_SV = WS_SU + 1 * MiB;
constexpr size_t WS_H = WS_SV + 1 * MiB;
constexpr size_t WS_COLS = WS_H + 64 * MiB;
constexpr size_t WS_MIXED = WS_COLS + 176 * MiB;
constexpr size_t WS_X = WS_MIXED + 64 * MiB;
constexpr size_t WS_RW = WS_X;
constexpr size_t WS_RWW = WS_X + 96 * MiB;
constexpr size_t WS_PART = WS_X;
constexpr size_t WS_QP = WS_X, WS_IDX = WS_X + 128 * MiB, WS_GATE = WS_IDX + 16 * MiB, WS_COEF = WS_GATE + 16 * MiB;
constexpr size_t WS_YG = WS_X + 224 * MiB;
constexpr size_t WS_GLU = WS_YG + 16 * MiB;
constexpr size_t WS_RWY = WS_GLU + 32 * MiB;
constexpr size_t WS_RWC = WS_RWY + 32 * MiB;
constexpr size_t WS_RWS = WS_H;
constexpr size_t WS_H8 = WS_COLS;
constexpr size_t WS_END = WS_RWC + 192 * MiB;
static_assert(WS_END <= 1024 * MiB, "workspace map");
constexpr int SSMP_STRIDE = 2048 + 2 * 16 * 16 * 64;

constexpr int LDS_BYTES = 155648;
constexpr int MISC_OFF = LDS_BYTES - 256;

DI unsigned f2bf(float f) { unsigned u = __builtin_bit_cast(unsigned, f); return (u + 0x7fffu + ((u >> 16) & 1u)) >> 16; }
DI unsigned pk2(float lo, float hi) { return f2bf(lo) | (f2bf(hi) << 16); }
DI float bflo(unsigned w) { return __builtin_bit_cast(float, w << 16); }
DI float bfhi(unsigned w) { return __builtin_bit_cast(float, w & 0xffff0000u); }
DI float bf2f(bf16_t b) { return __builtin_bit_cast(float, ((unsigned)b) << 16); }
template <int CTRL> DI float dpp_f(float x) { return __builtin_bit_cast(float, __builtin_amdgcn_update_dpp(0, __builtin_bit_cast(int, x), CTRL, 0xF, 0xF, true)); }
DI float sum4(float x) { x += dpp_f<0xB1>(x); x += dpp_f<0x4E>(x); return x; }
DI float sum8(float x) { x = sum4(x); x += dpp_f<0x141>(x); return x; }
DI float sum16(float x) { x = sum8(x); x += dpp_f<0x140>(x); return x; }
DI float sum32(float x) { x = sum16(x); x += __builtin_bit_cast(float, __builtin_amdgcn_ds_swizzle(__builtin_bit_cast(int, x), 0x401F)); return x; }
DI float other_half(float x, int hi) { unsigned a = __builtin_bit_cast(unsigned, x), c = a; asm volatile("" : "+v"(c));
    auto r = __builtin_amdgcn_permlane32_swap(a, c, false, false);
    return __builtin_bit_cast(float, hi ? r[0] : r[1]); }
DI float sum_halves(float x, int hi) { return x + other_half(x, hi); }
DI float wave_sum(float v) { const float s = sum32(v);
    return __builtin_bit_cast(float, __builtin_amdgcn_readlane(__builtin_bit_cast(int, s), 0)) + __builtin_bit_cast(float, __builtin_amdgcn_readlane(__builtin_bit_cast(int, s), 32)); }
DI float wave_max(float v) {
    v = fmaxf(v, dpp_f<0xB1>(v)); v = fmaxf(v, dpp_f<0x4E>(v)); v = fmaxf(v, dpp_f<0x141>(v)); v = fmaxf(v, dpp_f<0x140>(v));
    v = fmaxf(v, __builtin_bit_cast(float, __builtin_amdgcn_ds_swizzle(__builtin_bit_cast(int, v), 0x401F)));
    return fmaxf(__builtin_bit_cast(float, __builtin_amdgcn_readlane(__builtin_bit_cast(int, v), 0)), __builtin_bit_cast(float, __builtin_amdgcn_readlane(__builtin_bit_cast(int, v), 32)));
}
DI float xor16(float v) { return __builtin_bit_cast(float, __builtin_amdgcn_ds_swizzle(__builtin_bit_cast(int, v), 0x401F)); }
DI float xor8(float v) { return dpp_f<0x128>(v); }
DI float sigmoidf_(float x) { return 1.f / (1.f + __expf(-x)); }
DI float gelu_erf(float x) { return 0.5f * x * (1.f + erff(x * 0.70710678118654752f)); }


DI void sincos_red(double r, double& s, double& c) {
    const double k = rint(r * 0.63661977236758134308); const double y = r - k * 1.57079632679489661923; const double y2 = y * y;
    double sp = -7.6471637318198164759e-13; sp = sp * y2 + 1.6059043836821614599e-10; sp = sp * y2 - 2.5052108385441718775e-8; sp = sp * y2 + 2.7557319223985890653e-6;
    sp = sp * y2 - 1.9841269841269841270e-4; sp = sp * y2 + 8.3333333333333333333e-3; sp = sp * y2 - 1.6666666666666666667e-1; const double sy = y + y * y2 * sp;
    double cp = 4.7794773323873852974e-14; cp = cp * y2 - 1.1470745597729724714e-11; cp = cp * y2 + 2.0876756987868098979e-9; cp = cp * y2 - 2.7557319223985890653e-7;
    cp = cp * y2 + 2.4801587301587301587e-5; cp = cp * y2 - 1.3888888888888888889e-3; cp = cp * y2 + 4.1666666666666666667e-2; cp = cp * y2 - 0.5; const double cy = 1.0 + y2 * cp;
    const int q = ((int)k) & 3;
    s = (q == 0) ? sy : (q == 1) ? cy : (q == 2) ? -sy : -cy;
    c = (q == 0) ? cy : (q == 1) ? -sy : (q == 2) ? -cy : sy;
}
#define XB_TMO      128
#define XB_XCNT(j)  (256  + 64 * (j))
#define XB_XSUB(j)  (1280 + 64 * (j))
#define XB_XGEN(j)  (2304 + 64 * (j))
#define XB_TOP      3328
#define XB_TOPGEN   3392
#define XCD_BAR_WORDS 3456
#define XB_SPIN_CAP (1u << 22)
DI unsigned xb_ld(unsigned* p)              { return __hip_atomic_load(p, __ATOMIC_RELAXED, __HIP_MEMORY_SCOPE_AGENT); }
DI unsigned xb_add(unsigned* p, unsigned v) { return __hip_atomic_fetch_add(p, v, __ATOMIC_RELAXED, __HIP_MEMORY_SCOPE_AGENT); }
DI unsigned xb_xcc_id() { return (unsigned)__builtin_amdgcn_s_getreg((3 << 11) | 20) & 0xFu; }
#define XB_SPIN(cond, bar) do { unsigned _sp = 0; while (cond) { __builtin_amdgcn_s_sleep(1); \
    if ((++_sp & 255u) == 0u) { if (xb_ld(&(bar)[XB_TMO])) break; if (_sp > XB_SPIN_CAP) { atomicAdd(&(bar)[XB_TMO], 1u); break; } } } } while (0)
struct XcdBarrier { unsigned* bar; unsigned x; volatile LAS unsigned* st; };
DI XcdBarrier xcd_barrier_post(unsigned* bar, volatile LAS unsigned* st) {
    XcdBarrier b; b.bar = bar; b.x = xb_xcc_id(); b.st = st;
    if (threadIdx.x == 0) (void)xb_add(&bar[XB_XCNT(b.x)], 1u);
    return b;
}
DI void xcd_barrier_complete(unsigned* bar, unsigned x, unsigned& nloc, unsigned& nx) {
    const unsigned G = gridDim.x * gridDim.y * gridDim.z;
    unsigned sum, cnt, mine, sp = 0u;
    for (;;) {
        sum = 0u; cnt = 0u; mine = 0u;
#pragma unroll
        for (unsigned j = 0; j < 16; ++j) { const unsigned c = xb_ld(&bar[XB_XCNT(j)]); sum += c; cnt += (c > 0u) ? 1u : 0u; mine = (j == x) ? c : mine; }
        if (sum == G) break;
        __builtin_amdgcn_s_sleep(1);
        if ((++sp & 255u) == 0u) { if (xb_ld(&bar[XB_TMO])) break; if (sp > XB_SPIN_CAP) { atomicAdd(&bar[XB_TMO], 1u); break; } }
    }
    nloc = mine > 0u ? mine : 1u; nx = cnt > 0u ? cnt : 1u;
}
DI void xcd_barrier(const XcdBarrier& b, int wave) {
    asm volatile("s_waitcnt vmcnt(0)" ::: "memory");
    __syncthreads();
    int ln_; asm volatile("v_mbcnt_lo_u32_b32 %0, -1, 0\n\tv_mbcnt_hi_u32_b32 %0, -1, %0" : "=v"(ln_));
    if (wave == 0 && ln_ == 0) {
        unsigned* bar = b.bar;
        __builtin_amdgcn_s_waitcnt(0);
        unsigned nloc = b.st[0], nx = b.st[1];
        if (nloc == 0u) { xcd_barrier_complete(bar, b.x, nloc, nx); b.st[0] = nloc; b.st[1] = nx; }
        const unsigned old = xb_add(&bar[XB_XSUB(b.x)], 1u);
        const unsigned gen = old / nloc;
        if (old + 1u == (gen + 1u) * nloc) {
            __builtin_amdgcn_fence(__ATOMIC_RELEASE, "agent");
            asm volatile("s_waitcnt vmcnt(0)" ::: "memory");
            const unsigned og = xb_add(&bar[XB_TOP], 1u);
            const unsigned tg = og / nx;
            if (og + 1u == (tg + 1u) * nx) xb_add(&bar[XB_TOPGEN], 1u);
            else XB_SPIN(xb_ld(&bar[XB_TOPGEN]) == tg, bar);
            __builtin_amdgcn_fence(__ATOMIC_ACQUIRE, "agent");
            xb_add(&bar[XB_XGEN(b.x)], 1u);
            asm volatile("s_waitcnt vmcnt(0)" ::: "memory");
        } else {
            XB_SPIN(xb_ld(&bar[XB_XGEN(b.x)]) == gen, bar);
            __builtin_amdgcn_fence(__ATOMIC_ACQUIRE, "agent");
            asm volatile("s_waitcnt vmcnt(0)" ::: "memory");
        }
    }
    __syncthreads();
}

struct Args { const void* in[N_IN]; float* out; unsigned char* ws; int ph_lo, ph_hi, bli, pad; };
struct Ctx {
    const void* const* in; float* out; unsigned char* ws; char* lds;
    int G, vcu, NGW, wave;
};
#define INF(i) ((const float*)C.in[i])
#define PHASE_IDS int lane_; asm volatile("v_mbcnt_lo_u32_b32 %0, -1, 0\n\tv_mbcnt_hi_u32_b32 %0, -1, %0" : "=v"(lane_)); const int P_lane = lane_, P_wave = C.wave, P_tid = C.wave * 64 + lane_, P_gw = C.vcu * NWAVES + C.wave; (void)P_tid; (void)P_lane; (void)P_gw; (void)P_wave;

DI void p0_transpose_item(const float* W, int K, int N, bf16_t* WT, float* scr, int item, int lane) {
    const int nblk = N / 32, kb = item / nblk, nb = item % nblk, k0 = 64 * kb, n0 = 32 * nb;
#pragma unroll 8
    for (int i = 0; i < 32; ++i) { const int kk = 2 * i + (lane >> 5); scr[kk * 33 + (lane & 31)] = W[(size_t)(k0 + kk) * N + n0 + (lane & 31)]; }
    asm volatile("s_waitcnt lgkmcnt(0)" ::: "memory");
    const int c = lane & 7;
#pragma unroll
    for (int j = 0; j < 4; ++j) { const int n = (lane >> 3) + 8 * j; const float* s = scr + (8 * c) * 33 + n;
        u32x4 o; o.x = pk2(s[0 * 33], s[1 * 33]); o.y = pk2(s[2 * 33], s[3 * 33]); o.z = pk2(s[4 * 33], s[5 * 33]); o.w = pk2(s[6 * 33], s[7 * 33]);
        *(u32x4*)(WT + (size_t)(n0 + n) * K + k0 + 8 * c) = o; }
    asm volatile("s_waitcnt lgkmcnt(0)" ::: "memory");
}
DI void phase_prologue(const Ctx& C) {
    PHASE_IDS
    float* scr = (float*)(C.lds + P_wave * 16384);
    constexpr int I_IN = 16 * (INC / 32), I_OUT = 16 * 32, I_Q = 16 * 64, I_G = 4 * 8, I_L = I_IN + I_OUT + I_Q + I_G;
    for (int it = P_gw; it < DEPTH * I_L; it += C.NGW) {
        const int l = it / I_L; int r = it % I_L;
        if (r < I_IN) { p0_transpose_item(INF(I_W_IN) + (size_t)l * DM * INC, DM, INC, (bf16_t*)(C.ws + WS_WTIN) + (size_t)l * INCP * DM, scr, r, P_lane); continue; } r -= I_IN;
        if (r < I_OUT) { p0_transpose_item(INF(I_WOUT) + (size_t)l * DM * DM, DM, DM, (bf16_t*)(C.ws + WS_WTOUT) + (size_t)l * DM * DM, scr, r, P_lane); continue; } r -= I_OUT;
        if (r < I_Q) { p0_transpose_item(INF(I_WQ) + (size_t)l * DM * 2048, DM, 2048, (bf16_t*)(C.ws + WS_WTQ) + (size_t)l * 2048 * DM, scr, r, P_lane); continue; } r -= I_Q;
        p0_transpose_item(INF(I_WGLU) + (size_t)l * 256 * 256, 256, 256, (bf16_t*)(C.ws + WS_WTGLU) + (size_t)l * 256 * 256, scr, r, P_lane);
    }
    const size_t gt = (size_t)blockIdx.x * NTHR + P_tid, NGT = (size_t)C.G * NTHR;
    for (size_t i = gt; i < (size_t)DEPTH * 16384; i += NGT) { const size_t l = i / 16384, o = i % 16384;
        *(u32x4*)(C.ws + WS_WTIN + (l * INCP * DM + (size_t)INC * DM) * 2 + o * 16) = (u32x4){0u, 0u, 0u, 0u}; }
    for (size_t i = gt; i < (size_t)DEPTH * 16 * 128 * 128 / 8; i += NGT) { const f32x4 a = ((const f32x4*)INF(I_SUBK))[2 * i], b = ((const f32x4*)INF(I_SUBK))[2 * i + 1];
        ((u32x4*)(C.ws + WS_SUBK))[i] = (u32x4){pk2(a.x, a.y), pk2(a.z, a.w), pk2(b.x, b.y), pk2(b.z, b.w)}; }
    for (int row = P_gw; row < 2 * DEPTH * NEXP; row += 2 * C.NGW) {
        const int row2 = row + C.NGW; const bool has2 = row2 < 2 * DEPTH * NEXP;
        const int tab = row >= DEPTH * NEXP, r = tab ? row - DEPTH * NEXP : row;
        const int tab2 = row2 >= DEPTH * NEXP, r2 = has2 ? (tab2 ? row2 - DEPTH * NEXP : row2) : r;
        const f32x4* src = (const f32x4*)((tab ? INF(I_PV) : INF(I_PU)) + (size_t)r * DM);
        const f32x4* src2 = (const f32x4*)(((has2 ? tab2 : tab) ? INF(I_PV) : INF(I_PU)) + (size_t)r2 * DM);
        f32x4 v[4], v2[4]; float am = 0.f, am2 = 0.f;
#pragma unroll
        for (int j = 0; j < 4; ++j) v[j] = __builtin_nontemporal_load(src + P_lane + 64 * j);
#pragma unroll
        for (int j = 0; j < 4; ++j) v2[j] = __builtin_nontemporal_load(src2 + P_lane + 64 * j);
#pragma unroll
        for (int j = 0; j < 4; ++j) { am = fmaxf(fmaxf(am, fmaxf(fabsf(v[j].x), fabsf(v[j].y))), fmaxf(fabsf(v[j].z), fabsf(v[j].w))); am2 = fmaxf(fmaxf(am2, fmaxf(fabsf(v2[j].x), fabsf(v2[j].y))), fmaxf(fabsf(v2[j].z), fabsf(v2[j].w))); }
        am = wave_max(am); am2 = wave_max(am2);
        { const float sc = am > 0.f ? 440.f / am : 1.f;
          unsigned* dst = (unsigned*)(C.ws + (tab ? WS_V8 : WS_U8)) + (size_t)r * 256;
#pragma unroll
          for (int j = 0; j < 4; ++j) { int w = __builtin_amdgcn_cvt_pk_fp8_f32(v[j].x * sc, v[j].y * sc, 0, false); w = __builtin_amdgcn_cvt_pk_fp8_f32(v[j].z * sc, v[j].w * sc, w, true); dst[P_lane + 64 * j] = (unsigned)w; }
          if (P_lane == 0) ((float*)(C.ws + (tab ? WS_SV : WS_SU)))[r] = am > 0.f ? am / 440.f : 1.f; }
        if (has2) { const float sc = am2 > 0.f ? 440.f / am2 : 1.f;
          unsigned* dst = (unsigned*)(C.ws + (tab2 ? WS_V8 : WS_U8)) + (size_t)r2 * 256;
#pragma unroll
          for (int j = 0; j < 4; ++j) { int w = __builtin_amdgcn_cvt_pk_fp8_f32(v2[j].x * sc, v2[j].y * sc, 0, false); w = __builtin_amdgcn_cvt_pk_fp8_f32(v2[j].z * sc, v2[j].w * sc, w, true); dst[P_lane + 64 * j] = (unsigned)w; }
          if (P_lane == 0) ((float*)(C.ws + (tab2 ? WS_SV : WS_SU)))[r2] = am2 > 0.f ? am2 / 440.f : 1.f; }
    }
    for (size_t i = gt; i < (size_t)T * 8; i += NGT) { const int t = (int)(i >> 3), j = (int)(i & 7);
        const double invf = exp(-(double)j * 0.125 * log(500000.0));
        const double ang = (double)((const int*)C.in[I_POS])[t] * invf;
        const double red = ang - 6.283185307179586476925 * rint(ang * 0.15915494309189533577);
        float* o = (float*)(C.ws + WS_ROPE) + (size_t)t * 16;
        double sn, cn; sincos_red(red, sn, cn); o[j] = (float)cn; o[8 + j] = (float)sn; }
    for (size_t i = gt; i < (size_t)DEPTH * 1024; i += NGT) { const int l = (int)(i >> 10), gp = (int)(i & 1023), g = gp >> 6, p = gp & 63;
        const double lr = fmin((double)INF(I_SLRE)[l * 1024 + gp], -1e-4), li = (double)INF(I_SLIM)[l * 1024 + gp];
        const double step = exp((double)INF(I_SLOGDT)[l * 16 + g]);
        const double mag = exp(lr * step); double ph = li * step; ph -= 6.283185307179586476925 * rint(ph * 0.15915494309189533577);
        double sn, cn; sincos_red(ph, sn, cn); const double are = mag * cn, aim = mag * sn;
        const double den = lr * lr + li * li;
        const double cre = ((are - 1.0) * lr + aim * li) / den, cim = (aim * lr - (are - 1.0) * li) / den;
        float* P = (float*)(C.ws + WS_SSMP) + (size_t)l * SSMP_STRIDE;
        P[gp] = (float)are; P[1024 + gp] = (float)aim;
        for (int h = 0; h < 16; ++h) { const double br = (double)INF(I_SBRE)[((size_t)l * 1024 + gp) * 16 + h], bi = (double)INF(I_SBIM)[((size_t)l * 1024 + gp) * 16 + h];
            P[2048 + (g * 16 + h) * 64 + p] = (float)(cre * br - cim * bi);
            P[2048 + 16384 + (g * 16 + h) * 64 + p] = (float)(cre * bi + cim * br); } }
}

template <bool FP8IMG> DI void phase_rmsnorm(const Ctx& C, const float* src, const float* gain, bf16_t* dst) {
    PHASE_IDS
    f32x4 g[4];
#pragma unroll
    for (int j = 0; j < 4; ++j) g[j] = ((const f32x4*)gain)[P_lane + 64 * j];
    f32x4 vn[4];
    if (P_gw < T) { const f32x4* xr = (const f32x4*)(src + (size_t)P_gw * DM) + P_lane;
#pragma unroll
        for (int j = 0; j < 4; ++j) vn[j] = xr[64 * j]; }
    for (int m = P_gw; m < T; m += C.NGW) {
        f32x4 v[4]; float s = 0.f;
#pragma unroll
        for (int j = 0; j < 4; ++j) { v[j] = vn[j]; s += (v[j].x * v[j].x + v[j].y * v[j].y) + (v[j].z * v[j].z + v[j].w * v[j].w); }
        { const int mn = m + C.NGW < T ? m + C.NGW : m; const f32x4* xr = (const f32x4*)(src + (size_t)mn * DM) + P_lane;
#pragma unroll
          for (int j = 0; j < 4; ++j) vn[j] = xr[64 * j]; }
        const float rs = 1.f / sqrtf(wave_sum(s) * (1.f / DM) + NORM_EPS);
        u32x2* o8 = (u32x2*)(dst + (size_t)m * DM) + P_lane;
#pragma unroll
        for (int j = 0; j < 4; ++j) { const f32x4 y = {v[j].x * rs * g[j].x, v[j].y * rs * g[j].y, v[j].z * rs * g[j].z, v[j].w * rs * g[j].w};
            o8[64 * j] = (u32x2){pk2(y.x, y.y), pk2(y.z, y.w)};
            if (FP8IMG) {
                f32x4 ys = y * 16.f; ys.x = fminf(fmaxf(ys.x, -440.f), 440.f); ys.y = fminf(fmaxf(ys.y, -440.f), 440.f); ys.z = fminf(fmaxf(ys.z, -440.f), 440.f); ys.w = fminf(fmaxf(ys.w, -440.f), 440.f);
                int wh = __builtin_amdgcn_cvt_pk_fp8_f32(ys.x, ys.y, 0, false); wh = __builtin_amdgcn_cvt_pk_fp8_f32(ys.z, ys.w, wh, true);
                const f32x2 h01 = __builtin_amdgcn_cvt_pk_f32_fp8(wh, false), h23 = __builtin_amdgcn_cvt_pk_f32_fp8(wh, true);
                int wl_ = __builtin_amdgcn_cvt_pk_fp8_f32((ys.x - h01.x) * 16.f, (ys.y - h01.y) * 16.f, 0, false); wl_ = __builtin_amdgcn_cvt_pk_fp8_f32((ys.z - h23.x) * 16.f, (ys.w - h23.y) * 16.f, wl_, true);
                unsigned* h8 = (unsigned*)(C.ws + WS_H8 + (size_t)m * 2048) + P_lane + 64 * j; h8[0] = (unsigned)wh; h8[256] = (unsigned)wl_; } }
    }
}

DI void phase_prep(const Ctx& C, int l) {
    PHASE_IDS
    bf16_t* cols = (bf16_t*)(C.ws + WS_COLS);
    {
        float* Wd = (float*)C.lds; float* Wa = Wd + 32 * 256; float* Wg = Wa + 32 * 256; float* lr = Wg + 64 * 256;
        const float* gd = INF(I_DECUP) + (size_t)l * 32 * 256; const float* ga = INF(I_AAAUP) + (size_t)l * 32 * 256; const float* gg = INF(I_GATEUP) + (size_t)l * 64 * 256;
        for (int i = P_tid; i < 32 * 256 / 4; i += NTHR) { ((f32x4*)Wd)[i] = ((const f32x4*)gd)[i]; ((f32x4*)Wa)[i] = ((const f32x4*)ga)[i]; }
        for (int i = P_tid; i < 64 * 256 / 4; i += NTHR) ((f32x4*)Wg)[i] = ((const f32x4*)gg)[i];
        const float* mu = INF(I_MU) + (size_t)l * 896;
        const int hh = P_tid >> 8, j = P_tid & 255;
        const float w0 = INF(I_DECW0)[l * 256 + j], a0 = INF(I_AAAA0)[l * 256 + j], kkw = INF(I_KK)[l * 256 + j], kaw = INF(I_KA)[l * 256 + j];
        const float mur = mu[j], muk = mu[256 + j], muv = mu[512 + j];
        bf16_t* RWB = (bf16_t*)(C.ws + WS_RW); float* RWW = (float*)(C.ws + WS_RWW);
        for (int tile = C.vcu; tile < T / 16; tile += C.G) {
            const int t0 = tile * 16;
            __syncthreads();
#pragma unroll
            for (int i = 0; i < 4; ++i) { const int v = P_tid + NTHR * i, tt = v >> 7, c = v & 127, t = t0 + tt;
                const float cur = bf2f(cols[(size_t)t * INCP + 1792 + 768 + c]);
                const float prev = (t % SEQ) ? bf2f(cols[(size_t)(t - 1) * INCP + 1792 + 768 + c]) : 0.f;
                const float x = cur + (prev - cur) * mu[768 + c];
                lr[tt * 128 + (c < 32 ? 2 * c : (c < 64 ? 2 * (c - 32) + 1 : c))] = c < 32 ? tanhf(x) : (c < 64 ? x : sigmoidf_(x)); }
            __syncthreads();
#pragma unroll 1
            for (int pass = 0; pass < 2; ++pass) {
                const int tb = hh * 8 + pass * 4;
                float aw[4], aa[4], ag[4];
                float rc[4], kc[4], vc[4], rpv[4], kpv[4], vpv[4];
#pragma unroll
                for (int q = 0; q < 4; ++q) { const int t = t0 + tb + q; const bool first = (t % SEQ) == 0;
                    const bf16_t* cr = cols + (size_t)t * INCP + 1792; const bf16_t* pr = first ? cr : cr - INCP;
                    rc[q] = bf2f(cr[j]); kc[q] = bf2f(cr[256 + j]); vc[q] = bf2f(cr[512 + j]);
                    rpv[q] = bf2f(pr[j]); kpv[q] = bf2f(pr[256 + j]); vpv[q] = bf2f(pr[512 + j]); }
                { f32x2 awa[4], ag2[4];
#pragma unroll
                  for (int q = 0; q < 4; ++q) { awa[q] = (f32x2){0.f, 0.f}; ag2[q] = (f32x2){0.f, 0.f}; }
#pragma unroll 4
                  for (int i = 0; i < 32; ++i) { const f32x2 w2 = {Wd[i * 256 + j], Wa[i * 256 + j]};
#pragma unroll
                      for (int q = 0; q < 4; ++q) awa[q] += *(const f32x2*)(lr + (tb + q) * 128 + 2 * i) * w2; }
#pragma unroll 2
                  for (int i = 0; i < 64; i += 2) { const f32x2 w2 = {Wg[i * 256 + j], Wg[(i + 1) * 256 + j]};
#pragma unroll
                      for (int q = 0; q < 4; ++q) ag2[q] += *(const f32x2*)(lr + (tb + q) * 128 + 64 + i) * w2; }
#pragma unroll
                  for (int q = 0; q < 4; ++q) { aw[q] = awa[q].x; aa[q] = awa[q].y; ag[q] = ag2[q].x + ag2[q].y; } }
#pragma unroll
                for (int q = 0; q < 4; ++q) { const int t = t0 + tb + q; const bool first = (t % SEQ) == 0;
                    float r = rc[q], k = kc[q], v = vc[q];
                    const float rp = first ? 0.f : rpv[q], kp = first ? 0.f : kpv[q], vp = first ? 0.f : vpv[q];
                    r += (rp - r) * mur; k += (kp - k) * muk; v += (vp - v) * muv;
                    const float sg = sigmoidf_(w0 + aw[q]); const float decay = __expf(-0.60653065971263342f * sg);
                    const float a = sigmoidf_(a0 + aa[q]);
                    float kk = k * kkw; const float ss = wave_sum(kk * kk); kk = kk / fmaxf(sqrtf(ss), 1e-12f);
                    const float k2 = k * (1.f + (a - 1.f) * kaw);
                    bf16_t* o = RWB + (size_t)t * 1536 + j;
                    o[0] = (bf16_t)f2bf(r); o[256] = (bf16_t)f2bf(k2); o[512] = (bf16_t)f2bf(v); o[768] = (bf16_t)f2bf(kk); o[1024] = (bf16_t)f2bf(kk * a); o[1280] = (bf16_t)f2bf(ag[q]); RWW[(size_t)t * 256 + j] = decay; __builtin_amdgcn_sched_barrier(0); }
            }
        }
        __syncthreads();
    }
    {
        const int v16 = P_lane >> 2, qt = P_lane & 3, part = v16 >> 3, vec = v16 & 7;
        float gn[16];
#pragma unroll
        for (int i = 0; i < 16; ++i) gn[i] = (part == 0 ? INF(I_QN) : INF(I_KN))[l * 512 + vec * 64 + qt * 16 + i];
        const float qscale = part == 0 ? 0.18033688011112042f : 1.f;
        const float* rope = (const float*)(C.ws + WS_ROPE);
        for (int t = P_gw; t < T; t += C.NGW) {
            float cs[16];
#pragma unroll
            for (int i = 0; i < 4; ++i) { const f32x4 v = ((const f32x4*)(rope + (size_t)t * 16))[i]; cs[4 * i] = v.x; cs[4 * i + 1] = v.y; cs[4 * i + 2] = v.z; cs[4 * i + 3] = v.w; }
            bf16_t* p = cols + (size_t)t * INCP + v16 * 64 + qt * 16;
            const u32x4 w0 = ((const u32x4*)p)[0], w1 = ((const u32x4*)p)[1];
            float x[16];
            x[0] = bflo(w0.x); x[1] = bfhi(w0.x); x[2] = bflo(w0.y); x[3] = bfhi(w0.y); x[4] = bflo(w0.z); x[5] = bfhi(w0.z); x[6] = bflo(w0.w); x[7] = bfhi(w0.w);
            x[8] = bflo(w1.x); x[9] = bfhi(w1.x); x[10] = bflo(w1.y); x[11] = bfhi(w1.y); x[12] = bflo(w1.z); x[13] = bfhi(w1.z); x[14] = bflo(w1.w); x[15] = bfhi(w1.w);
            float ss = 0.f;
#pragma unroll
            for (int i = 0; i < 16; ++i) ss += x[i] * x[i];
            ss = sum4(ss);
            const float rs = qscale / sqrtf(ss * (1.f / 64.f) + NORM_EPS);
#pragma unroll
            for (int i = 0; i < 16; ++i) x[i] = x[i] * rs * gn[i];
            if (qt == 0) {
#pragma unroll
                for (int i = 0; i < 8; ++i) { const float r1 = x[i], r2 = x[8 + i]; x[i] = r1 * cs[i] - r2 * cs[8 + i]; x[8 + i] = r2 * cs[i] + r1 * cs[8 + i]; }
            }
            ((u32x4*)p)[0] = (u32x4){pk2(x[0], x[1]), pk2(x[2], x[3]), pk2(x[4], x[5]), pk2(x[6], x[7])};
            ((u32x4*)p)[1] = (u32x4){pk2(x[8], x[9]), pk2(x[10], x[11]), pk2(x[12], x[13]), pk2(x[14], x[15])};
        }
    }
}

typedef short v4i16_t __attribute__((ext_vector_type(4)));
DI s16x4 tr_read(const char* p) { return __builtin_bit_cast(s16x4, __builtin_amdgcn_ds_read_tr16_b64_v4i16((LAS v4i16_t*)p)); }
typedef __bf16 bf16x2_t __attribute__((ext_vector_type(2)));
DI unsigned cvtpk(float lo, float hi) { f32x2 v = {lo, hi}; bf16x2_t b = __builtin_convertvector(v, bf16x2_t); return __builtin_bit_cast(unsigned, b); }
DI int crow(int r, int hi) { return (r & 3) + 8 * (r >> 2) + 4 * hi; }
DI bf16x8 pack8(const f32x16& p, int b) { u32x4 w = {cvtpk(p[b], p[b + 1]), cvtpk(p[b + 2], p[b + 3]), cvtpk(p[b + 4], p[b + 5]), cvtpk(p[b + 6], p[b + 7])}; return __builtin_bit_cast(bf16x8, w); }
constexpr int AT_K = 0, AT_V = 16384, AT_BUF = 32768, AT_X = 65536, AT_W = 131072;

DI void attn_unit(const Ctx& C, int l, int b, int h, int qb, float lam_full, float lam_init) {
    PHASE_IDS
    const bf16_t* cols = (const bf16_t*)(C.ws + WS_COLS);
    char* lds = C.lds;
    const int tid = P_tid, lane = P_lane, wid = P_wave, r32 = lane & 31, hi = lane >> 5, m = wid >> 2, sub = wid & 3;
    const size_t tb = (size_t)b * SEQ;
    const size_t qrow = tb + qb * 128 + sub * 32 + r32;
    bf16x8 qr[4];
#pragma unroll
    for (int d0 = 0; d0 < 4; ++d0) qr[d0] = *(const bf16x8*)(cols + qrow * INCP + h * 128 + m * 64 + d0 * 16 + hi * 8);
    f32x16 o[4];
#pragma unroll
    for (int i = 0; i < 4; ++i)
#pragma unroll
        for (int r = 0; r < 16; ++r) o[i][r] = 0.f;
    float lsum = 0.f;
    const int nt = 2 * qb + 2, my_nt = 2 * qb + 1 + (sub >> 1);
    const int q4 = (lane & 15) >> 2, p4 = lane & 3, blk16 = (lane >> 4) & 1;
    unsigned goK[2], goV[2], loK[2], loV[2];
#pragma unroll
    for (int i = 0; i < 2; ++i) { const int c = tid + NTHR * i, mm = c >> 9, row = (c >> 3) & 63, ch = c & 7;
        goK[i] = (unsigned)((row * INCP + 512 + mm * 64 + ch * 8) * 2); loK[i] = (unsigned)(AT_K + mm * 8192 + row * 128 + 16 * (ch ^ ((row >> 1) & 7))); }
#pragma unroll
    for (int i = 0; i < 2; ++i) { const int c = tid + NTHR * i, row = c >> 4, ch = c & 15;
        goV[i] = (unsigned)((row * INCP + 1024 + ch * 8) * 2); loV[i] = (unsigned)(AT_V + row * 256 + 16 * (ch ^ (((row & 3) << 2) | ((row >> 2) & 3)))); }
    unsigned vo[8];
#pragma unroll
    for (int k = 0; k < 8; ++k) { const int db_ = k >> 1, rr_ = 4 * hi + q4 + 8 * (k & 1), ch_ = 4 * db_ + 2 * blk16 + (p4 >> 1);
        vo[k] = (unsigned)(rr_ * 256 + 16 * (ch_ ^ (((rr_ & 3) << 2) | ((rr_ >> 2) & 3))) + 8 * (p4 & 1)); }
    const unsigned lds32 = (unsigned)(size_t)(LAS char*)lds;
    u32x4 kreg[2], vreg[2];
    { const char* tbase = (const char*)(cols + tb * INCP + h * 128);
#pragma unroll
      for (int i = 0; i < 2; ++i) { kreg[i] = *(const u32x4*)(tbase + goK[i]); vreg[i] = *(const u32x4*)(tbase + goV[i]); } }
    __syncthreads();
    for (int kt = 0; kt < nt; ++kt) {
        char* ldb = lds + (kt & 1) * AT_BUF;
#pragma unroll
        for (int i = 0; i < 2; ++i) { *(u32x4*)(ldb + loK[i]) = kreg[i]; *(u32x4*)(ldb + loV[i]) = vreg[i]; }
        if (kt + 1 < nt) { const char* tbase = (const char*)(cols + (tb + (kt + 1) * 64) * INCP + h * 128);
#pragma unroll
            for (int i = 0; i < 2; ++i) { kreg[i] = *(const u32x4*)(tbase + goK[i]); vreg[i] = *(const u32x4*)(tbase + goV[i]); } }
        __syncthreads();
        if (kt < my_nt) {
            bf16x8 kf[8];
#pragma unroll
            for (int d0 = 0; d0 < 4; ++d0) { const char* kp = ldb + AT_K + m * 8192 + r32 * 128 + 16 * ((2 * d0 + hi) ^ ((r32 >> 1) & 7)); kf[2 * d0] = *(const bf16x8*)kp; kf[2 * d0 + 1] = *(const bf16x8*)(kp + 4096); }
            __builtin_amdgcn_sched_barrier(0);
            f32x16 p0, p1;
#pragma unroll
            for (int r = 0; r < 16; ++r) { p0[r] = 0.f; p1[r] = 0.f; }
#pragma unroll
            for (int d0 = 0; d0 < 4; ++d0) { p0 = __builtin_amdgcn_mfma_f32_32x32x16_bf16(kf[2 * d0], qr[d0], p0, 0, 0, 0); p1 = __builtin_amdgcn_mfma_f32_32x32x16_bf16(kf[2 * d0 + 1], qr[d0], p1, 0, 0, 0); }
#define AT_TR(p_) __builtin_bit_cast(s16x4, __builtin_amdgcn_ds_read_tr16_b64_v4i16((LAS v4i16_t*)(p_)))
#define AT_VFRAG(db, s4) ({ const s16x4 lo_ = AT_TR(vp[2 * (db)] + 256 * (32 * ((s4) >> 1) + 16 * ((s4) & 1))); const s16x4 hh_ = AT_TR(vp[2 * (db) + 1] + 256 * (32 * ((s4) >> 1) + 16 * ((s4) & 1))); \
                (bf16x8)__builtin_shufflevector(lo_, hh_, 0, 1, 2, 3, 4, 5, 6, 7); })
            LAS char* vp[8];
#pragma unroll
            for (int k = 0; k < 8; ++k) { unsigned a_ = lds32 + (unsigned)((kt & 1) * AT_BUF + AT_V) + vo[k]; asm volatile("" : "+v"(a_)); vp[k] = (LAS char*)(size_t)a_; }
            bf16x8 va[8];
#pragma unroll
            for (int i = 0; i < 8; ++i) va[i] = AT_VFRAG(i >> 1, i & 1);
            __builtin_amdgcn_sched_barrier(0);
            float s = 0.f;
#pragma unroll
            for (int r = 0; r < 8; ++r) { p0[r] = __builtin_amdgcn_exp2f(p0[r]); s += p0[r]; }
            bf16x8 pa[4]; pa[0] = pack8(p0, 0);
            __builtin_amdgcn_sched_barrier(0);
            bf16x8 vb[8];
#pragma unroll
            for (int i = 0; i < 8; ++i) vb[i] = AT_VFRAG(i >> 1, 2 + (i & 1));
            __builtin_amdgcn_sched_barrier(0);
#pragma unroll
            for (int j = 0; j < 16; ++j) { const int q = j >> 2, db = j & 3;
                o[db] = __builtin_amdgcn_mfma_f32_32x32x16_bf16(pa[q], q < 2 ? va[2 * db + (q & 1)] : vb[2 * db + (q & 1)], o[db], 0, 0, 0);
                if (j < 12) { const int i0 = 8 * ((q + 1) & 1) + 2 * db;
                    float e0 = __builtin_amdgcn_exp2f(q == 0 ? p0[i0] : p1[i0]), e1 = __builtin_amdgcn_exp2f(q == 0 ? p0[i0 + 1] : p1[i0 + 1]);
                    s += e0 + e1;
                    asm volatile("" : "+v"(e0), "+v"(e1), "+v"(s));
                    if (q == 0) { p0[i0] = e0; p0[i0 + 1] = e1; } else { p1[i0] = e0; p1[i0 + 1] = e1; }
                    if (db == 3) pa[q + 1] = q == 0 ? pack8(p0, 8) : (q == 1 ? pack8(p1, 0) : pack8(p1, 8)); }
                __builtin_amdgcn_sched_barrier(0); }
            lsum += s;
#undef AT_VFRAG
#undef AT_TR
        }
    }
    float* wsf = (float*)(lds + AT_W) + wid * 64;
    const float lt = sum_halves(lsum, hi);
    if (hi == 0) wsf[r32] = 1.f / lt;
    __syncthreads();
#pragma unroll
    for (int r = 0; r < 16; ++r) { const float rl = wsf[crow(r, hi)];
#pragma unroll
        for (int db = 0; db < 4; ++db) o[db][r] *= rl; }
    float* xch = (float*)(lds + AT_X) + sub * 4096;
    if (m == 1) {
#pragma unroll
        for (int r = 0; r < 16; ++r)
#pragma unroll
            for (int db = 0; db < 4; ++db) xch[crow(r, hi) * 128 + db * 32 + r32] = o[db][r];
    }
    __syncthreads();
    if (m == 0) {
        const float* subln = INF(I_SUBLN) + l * 128;
        float g[4];
#pragma unroll
        for (int db = 0; db < 4; ++db) g[db] = subln[db * 32 + r32] * (1.f - lam_init);
        bf16_t* mixed = (bf16_t*)(C.ws + WS_MIXED);
#pragma unroll
        for (int r = 0; r < 16; ++r) {
            float ss = 0.f;
#pragma unroll
            for (int db = 0; db < 4; ++db) { o[db][r] -= lam_full * xch[crow(r, hi) * 128 + db * 32 + r32]; ss += o[db][r] * o[db][r]; }
            ss = sum32(ss);
            const float rs = 1.f / sqrtf(ss * (1.f / 128.f) + NORM_EPS);
            bf16_t* orow = mixed + (tb + qb * 128 + sub * 32 + crow(r, hi)) * DM + h * 128;
#pragma unroll
            for (int db = 0; db < 4; ++db) orow[db * 32 + r32] = (bf16_t)f2bf(o[db][r] * rs * g[db]);
        }
    }
}
DI void attn_lambda(const Ctx& C, int l, int lane, float& lam_full, float& lam_init) {
    const float* lf = INF(I_LAM) + l * 256;
    const float la = wave_sum(lf[lane] * lf[64 + lane]), lb = wave_sum(lf[128 + lane] * lf[192 + lane]);
    lam_init = 0.8f - 0.6f * expf(-0.3f * (float)l);
    lam_full = expf(la) - expf(lb) + lam_init;
}
DI void phase_attn(const Ctx& C, int l, int w0, int nw) {
    PHASE_IDS
    float lam_full, lam_init; attn_lambda(C, l, P_lane, lam_full, lam_init);
    if (nw == 256) {
        for (int u = C.vcu - w0; u < 1024; u += nw) {
            const int bh = (u & 255) >> 3, s = u & 7, i = u >> 8;
            const int qb = (i == 0) ? s : (i == 1) ? 15 - s : (i == 2) ? 16 + s : 31 - s;
            attn_unit(C, l, bh >> 2, bh & 3, qb, lam_full, lam_init);
        }
    } else {
        for (int u = C.vcu - w0; u < 1024; u += nw) { const int qb = 31 - (u >> 5), bh = u & 31; attn_unit(C, l, bh >> 2, bh & 3, qb, lam_full, lam_init); }
    }
    __syncthreads();
}
DI int attn_queue_qb(int which, int k) { return which == 0 ? (k < 7 ? 31 - k : 7 - 2 * (k - 7)) : (k < 17 ? 24 - k : 6 - 2 * (k - 17)); }
DI void phase_attn_queue(const Ctx& C, int l, int which) {
    PHASE_IDS
    float lam_full, lam_init; attn_lambda(C, l, P_lane, lam_full, lam_init);
    unsigned* ticket = (unsigned*)(C.ws + WS_CTL) + 1024 + (l * 2 + which) * 64;
    volatile int* slot = (volatile int*)(C.lds + MISC_OFF + 64);
    const int count = (which == 0 ? 11 : 21) * 32;
    for (;;) {
        __syncthreads();
        if (P_tid == 0) *slot = (int)__hip_atomic_fetch_add(ticket, 1u, __ATOMIC_RELAXED, __HIP_MEMORY_SCOPE_AGENT);
        __syncthreads();
        const int u = __builtin_amdgcn_readfirstlane(*slot);
        if (u >= count) break;
        const int qb = attn_queue_qb(which, u >> 5), bh = u & 31;
        attn_unit(C, l, bh >> 2, bh & 3, qb, lam_full, lam_init);
    }
    __syncthreads();
}

DI void phase_ssm(const Ctx& C, int l, int w0, int nw) {
    PHASE_IDS
    float* L = (float*)C.lds;
    float* Uu = L;
    float* Tt = L + 2048;
    bf16_t* X2 = (bf16_t*)(L + 3072);
    bf16_t* C2 = X2 + 64 * 136;
    const bf16_t* cols = (const bf16_t*)(C.ws + WS_COLS);
    bf16_t* yg = (bf16_t*)(C.ws + WS_YG);
    const float* P = (const float*)(C.ws + WS_SSMP) + (size_t)l * SSMP_STRIDE;
    const int tid = P_tid, lane = P_lane, w = P_wave;
    for (int u = C.vcu - w0; u < 128; u += nw) {
        const int b = u >> 4, g = u & 15;
        const int p1 = tid & 63;
        f32x2 bb[16];
        { const float* pbr = P + 2048 + g * 1024 + p1; const float* pbi = pbr + 16384;
#pragma unroll
          for (int h = 0; h < 16; ++h) { bb[h].x = pbr[h * 64]; bb[h].y = pbi[h * 64]; } }
        const float a1r = P[g * 64 + p1], a1i = P[1024 + g * 64 + p1];
        float a8r, a8i;
        { double xr = (double)a1r, xi = (double)a1i;
#pragma unroll
          for (int k = 0; k < 3; ++k) { const double nr = xr * xr - xi * xi, ni = 2.0 * xr * xi; xr = nr; xi = ni; }
          a8r = (float)xr; a8i = (float)xi; }
        float xpr = 0.f, xpi = 0.f;
        __syncthreads();
        for (int i = tid; i < 16 * 128; i += NTHR) { const int h = i >> 7, k = i & 127;
            const float v = k < 64 ? INF(I_SCRE)[((size_t)l * 256 + g * 16 + h) * 64 + k] : -INF(I_SCIM)[((size_t)l * 256 + g * 16 + h) * 64 + k - 64]; C2[h * 136 + k] = (bf16_t)f2bf(v); }
        const float dsk = INF(I_SD)[l * 256 + g * 16 + (lane & 15)];
        const size_t tb = (size_t)b * SEQ;
        { const unsigned v = *(const unsigned*)(cols + (tb + (tid >> 3)) * INCP + 1536 + g * 16 + 2 * (tid & 7)); Uu[(tid >> 3) * 16 + 2 * (tid & 7)] = bflo(v); Uu[(tid >> 3) * 16 + 2 * (tid & 7) + 1] = bfhi(v); }
        __syncthreads();
        for (int ck = 0; ck < 64; ++ck) {
            const float* Uc = Uu + (ck & 1) * 1024; float* Un = Uu + ((ck + 1) & 1) * 1024;
            unsigned unext = 0u;
            if (ck + 1 < 64) unext = *(const unsigned*)(cols + (tb + (ck + 1) * 64 + (tid >> 3)) * INCP + 1536 + g * 16 + 2 * (tid & 7));
            float xlr[8], xli[8]; float cr = 0.f, ci = 0.f;
#pragma unroll
            for (int q = 0; q < 8; ++q) { const int t = 8 * w + q; const f32x4 u0 = *(const f32x4*)(Uc + t * 16), u1 = *(const f32x4*)(Uc + t * 16 + 4), u2 = *(const f32x4*)(Uc + t * 16 + 8), u3 = *(const f32x4*)(Uc + t * 16 + 12);
                f32x2 s = bb[0] * u0.x, s1 = bb[1] * u0.y, s2 = bb[2] * u0.z, s3 = bb[3] * u0.w;
                s += bb[4] * u1.x; s1 += bb[5] * u1.y; s2 += bb[6] * u1.z; s3 += bb[7] * u1.w;
                s += bb[8] * u2.x; s1 += bb[9] * u2.y; s2 += bb[10] * u2.z; s3 += bb[11] * u2.w; s += bb[12] * u3.x; s1 += bb[13] * u3.y; s2 += bb[14] * u3.z; s3 += bb[15] * u3.w;
                s = (s + s1) + (s2 + s3);
                const float nr = a1r * cr - a1i * ci + s.x, ni = a1r * ci + a1i * cr + s.y; cr = nr; ci = ni; xlr[q] = nr; xli[q] = ni; }
            { f32x2 tv; tv.x = cr; tv.y = ci; *(f32x2*)(Tt + (w * 64 + p1) * 2) = tv; }
            __syncthreads();
            Un[(tid >> 3) * 16 + 2 * (tid & 7)] = bflo(unext); Un[(tid >> 3) * 16 + 2 * (tid & 7) + 1] = bfhi(unext);
            { float kr = xpr, ki = xpi, inr = 0.f, ini = 0.f;
#pragma unroll
              for (int k = 0; k < 8; ++k) { if (k == w) { inr = kr; ini = ki; } const f32x2 tv = *(const f32x2*)(Tt + (k * 64 + p1) * 2);
                  const float nr = a8r * kr - a8i * ki + tv.x, ni = a8r * ki + a8i * kr + tv.y; kr = nr; ki = ni; }
              xpr = kr; xpi = ki;
#pragma unroll
              for (int q = 0; q < 8; ++q) { const float nr = a1r * inr - a1i * ini, ni = a1r * ini + a1i * inr; inr = nr; ini = ni;
                  X2[(8 * w + q) * 136 + p1] = (bf16_t)f2bf(xlr[q] + nr); X2[(8 * w + q) * 136 + 64 + p1] = (bf16_t)f2bf(xli[q] + ni); } }
            __syncthreads();
            if (w < 4) {
                f32x4 acc = {0.f, 0.f, 0.f, 0.f};
#pragma unroll
                for (int ks = 0; ks < 4; ++ks) { const bf16x8 af = *(const bf16x8*)(X2 + (16 * w + (lane & 15)) * 136 + 32 * ks + 8 * (lane >> 4));
                    const bf16x8 cfk = *(const bf16x8*)(C2 + (lane & 15) * 136 + 32 * ks + 8 * (lane >> 4));
                    acc = __builtin_amdgcn_mfma_f32_16x16x32_bf16(af, cfk, acc, 0, 0, 0); }
#pragma unroll
                for (int r = 0; r < 4; ++r) { const int t = 16 * w + 4 * (lane >> 4) + r; const float y = acc[r] + dsk * Uc[t * 16 + (lane & 15)];
                    yg[(tb + ck * 64 + t) * 256 + g * 16 + (lane & 15)] = (bf16_t)f2bf(gelu_erf(y)); }
            }
        }
    }
    __syncthreads();
}

constexpr int RC = 32, NCH = SEQ / RC;
constexpr int LD = 68, LA = 36, LX = 132;
DI f32x4 mf4(float a, float b, f32x4 c) { return __builtin_amdgcn_mfma_f32_16x16x4f32(a, b, c, 0, 0, 0); }
template <int K> DI void mm_cc(f32x4& acc, const float* A, int lda, const float* B, int ldb, int tr, int tc, int lane) {
    const float* ap = A + (16 * tr + (lane & 15)) * lda + 4 * (lane >> 4); const float* bp = B + (16 * tc + (lane & 15)) * ldb + 4 * (lane >> 4);
#pragma unroll
    for (int kq = 0; kq < K / 16; ++kq) { const f32x4 a = *(const f32x4*)(ap + 16 * kq), c = *(const f32x4*)(bp + 16 * kq);
        acc = mf4(a.x, c.x, acc); acc = mf4(a.y, c.y, acc); acc = mf4(a.z, c.z, acc); acc = mf4(a.w, c.w, acc); }
}
template <int K> DI void mm_cm(f32x4& acc, const float* A, int lda, const float* B, int ldb, int tr, int tc, int lane) {
    const float* ap = A + (16 * tr + (lane & 15)) * lda + 4 * (lane >> 4); const float* bp = B + (4 * (lane >> 4)) * ldb + 16 * tc + (lane & 15);
#pragma unroll
    for (int kq = 0; kq < K / 16; ++kq) { const f32x4 a = *(const f32x4*)(ap + 16 * kq); const float* b0 = bp + 16 * kq * ldb;
        acc = mf4(a.x, b0[0], acc); acc = mf4(a.y, b0[ldb], acc); acc = mf4(a.z, b0[2 * ldb], acc); acc = mf4(a.w, b0[3 * ldb], acc); }
}
template <int K> DI void mm_mm(f32x4& acc, const float* A, int lda, const float* B, int ldb, int tr, int tc, int lane) {
    const float* ap = A + (lane >> 4) * lda + 16 * tr + (lane & 15); const float* bp = B + (lane >> 4) * ldb + 16 * tc + (lane & 15);
#pragma unroll
    for (int kk = 0; kk < K / 4; ++kk) acc = mf4(ap[4 * kk * lda], bp[4 * kk * ldb], acc);
}
struct RwcPtr { float* G; float* HT; float* Pm; float* Y0; };
DI RwcPtr rwc_ptr(unsigned char* ws, int unit) { float* p = (float*)(ws + WS_RWC) + (size_t)unit * 12288; return RwcPtr{p, p + 4096, p + 8192, p + 10240}; }

DI void phase_rw1(const Ctx& C, int l, int w0, int nw) {
    PHASE_IDS
    (void)l;
    float* L0 = (float*)C.lds;
    float* AT = L0; float* RT = L0 + 2176; float* BT = L0 + 4352; float* KT = L0 + 6528; float* VV = L0 + 8704;
    float* Lm = L0 + 10880; float* AK = L0 + 12032; float* ARB = L0 + 13184; float* ARK = L0 + 14336; float* X = L0 + 15488;
    float* tot = L0 + 19712; float* gC = L0 + 20224;
    const int tid = P_tid, lane = P_lane, w = P_wave;
    const bf16_t* RWB = (const bf16_t*)(C.ws + WS_RW); const float* RWW = (const float*)(C.ws + WS_RWW);
    float iw[4], ir[4], ik[4], iv[4], ia[4], ib[4];
    { const int unit = C.vcu - w0; if (unit < 32 * NCH) { const int bh = unit / NCH, c = unit % NCH;
        const size_t tk = (size_t)(bh >> 2) * SEQ + c * RC + 4 * w; const bf16_t* base = RWB + tk * 1536 + (bh & 3) * 64 + lane; const float* bw = RWW + tk * 256 + (bh & 3) * 64 + lane;
#pragma unroll
        for (int q = 0; q < 4; ++q) { ir[q] = bf2f(base[q * 1536]); iw[q] = bw[q * 256]; ik[q] = bf2f(base[q * 1536 + 256]); iv[q] = bf2f(base[q * 1536 + 512]); ia[q] = bf2f(base[q * 1536 + 768]); ib[q] = bf2f(base[q * 1536 + 1024]); } } }
    for (int unit = C.vcu - w0; unit < 32 * NCH; unit += nw) {
        const int bh = unit / NCH, c = unit % NCH, bb = bh >> 2, h = bh & 3;
        __syncthreads();
        float g[4];
#pragma unroll
        for (int q = 0; q < 4; ++q) g[q] = q ? g[q - 1] * iw[q] : iw[q];
        tot[w * 64 + lane] = g[3];
        __syncthreads();
        float pre = 1.f, all = 1.f;
#pragma unroll
        for (int k = 0; k < 8; ++k) { const float tk = tot[k * 64 + lane]; all *= tk; if (k < w) pre *= tk; }
        if (w == 0) gC[lane] = all;
#pragma unroll
        for (int q = 0; q < 4; ++q) { const int t = 4 * w + q; const float gt = pre * g[q], gm = q ? pre * g[q - 1] : pre, ig = 1.f / gt;
            const float at = -ia[q] * gm;
            AT[t * LD + lane] = at; X[t * LX + lane] = at; RT[t * LD + lane] = ir[q] * gt; BT[t * LD + lane] = ib[q] * ig; KT[t * LD + lane] = ik[q] * ig; VV[t * LD + lane] = iv[q]; }
        { const int un = unit + nw; if (un < 32 * NCH) { const int bhn = un / NCH, cn = un % NCH;
            const size_t tk = (size_t)(bhn >> 2) * SEQ + cn * RC + 4 * w; const bf16_t* base = RWB + tk * 1536 + (bhn & 3) * 64 + lane; const float* bw = RWW + tk * 256 + (bhn & 3) * 64 + lane;
#pragma unroll
            for (int q = 0; q < 4; ++q) { ir[q] = bf2f(base[q * 1536]); iw[q] = bw[q * 256]; ik[q] = bf2f(base[q * 1536 + 256]); iv[q] = bf2f(base[q * 1536 + 512]); ia[q] = bf2f(base[q * 1536 + 768]); ib[q] = bf2f(base[q * 1536 + 1024]); } } }
        __syncthreads();
#pragma unroll
        for (int x = 0; x < 2; ++x) { const int job = 2 * w + x, mt = job >> 2, tr = (job >> 1) & 1, tc = job & 1;
            f32x4 a = {0.f, 0.f, 0.f, 0.f};
            if (tc <= tr) mm_cc<64>(a, mt < 2 ? AT : RT, LD, (mt & 1) ? KT : BT, LD, tr, tc, lane);
            const int ncol = 16 * tc + (lane & 15), mrow = 16 * tr + 4 * (lane >> 4);
#pragma unroll
            for (int r = 0; r < 4; ++r) { const bool keep = mt < 2 ? (ncol < mrow + r) : (ncol <= mrow + r); const float v = keep ? a[r] : 0.f;
                if (mt == 0) Lm[(mrow + r) * LA + (ncol & 3) * 8 + (ncol >> 2)] = v;
                else (mt == 1 ? AK : (mt == 2 ? ARB : ARK))[(mrow + r) * LA + ncol] = v; } }
        __syncthreads();
        { const int tr = w >> 2, tc = w & 3; f32x4 a = {0.f, 0.f, 0.f, 0.f}; mm_cm<32>(a, AK, LA, VV, LD, tr, tc, lane);
#pragma unroll
          for (int r = 0; r < 4; ++r) X[(16 * tr + 4 * (lane >> 4) + r) * LX + 64 + 16 * tc + (lane & 15)] = a[r]; }
        __syncthreads();
        { const int cc = tid >> 2, part = tid & 3; float u[8];
#pragma unroll
          for (int k = 0; k < 8; ++k) u[k] = 0.f;
#pragma unroll
          for (int blk = 0; blk < RC / 8; ++blk) {
              f32x4 la[8], lb[8]; float xv[8];
#pragma unroll
              for (int q = 0; q < 8; ++q) { const int t = 8 * blk + q; la[q] = *(const f32x4*)(Lm + t * LA + part * 8); lb[q] = *(const f32x4*)(Lm + t * LA + part * 8 + 4); xv[q] = X[t * LX + cc]; }
#pragma unroll
              for (int q = 0; q < 8; ++q) { const int t = 8 * blk + q;
                  float sm = la[q].x * u[0] + la[q].y * u[1] + la[q].z * u[2] + la[q].w * u[3] + lb[q].x * u[4] + lb[q].y * u[5] + lb[q].z * u[6] + lb[q].w * u[7];
                  sm = sum4(sm) + xv[q];
                  u[t >> 2] = (part == (t & 3)) ? sm : u[t >> 2]; } }
#pragma unroll
          for (int k = 0; k < 8; ++k) X[(part + 4 * k) * LX + cc] = u[k]; }
        __syncthreads();
        const RwcPtr O = rwc_ptr(C.ws, unit);
#pragma unroll
        for (int x = 0; x < 2; ++x) { const int tile = 2 * w + x, tr = tile >> 2, tc = tile & 3, ncol = 16 * tc + (lane & 15), mrow = 16 * tr + 4 * (lane >> 4);
            f32x4 gg = {0.f, 0.f, 0.f, 0.f}, hh = gg;
            mm_mm<32>(gg, BT, LD, X, LX, tr, tc, lane);
            mm_mm<32>(hh, X + 64, LX, BT, LD, tr, tc, lane); mm_mm<32>(hh, VV, LD, KT, LD, tr, tc, lane);
#pragma unroll
            for (int r = 0; r < 4; ++r) { const int row = mrow + r;
                O.G[row * 64 + ncol] = gC[row] * (gg[r] + (row == ncol ? 1.f : 0.f)); O.HT[row * 64 + ncol] = hh[r] * gC[ncol]; } }
        { const int tr = w >> 2, tc = w & 3, ncol = 16 * tc + (lane & 15), mrow = 16 * tr + 4 * (lane >> 4);
          f32x4 pp = {0.f, 0.f, 0.f, 0.f}, yy = pp;
          mm_cm<32>(pp, ARB, LA, X, LX, tr, tc, lane);
          mm_cm<32>(yy, ARB, LA, X + 64, LX, tr, tc, lane); mm_cm<32>(yy, ARK, LA, VV, LD, tr, tc, lane);
#pragma unroll
          for (int r = 0; r < 4; ++r) { const int row = mrow + r; O.Pm[row * 64 + ncol] = pp[r] + RT[row * LD + ncol]; O.Y0[row * 64 + ncol] = yy[r]; } }
    }
    __syncthreads();
}

DI void phase_rw2(const Ctx& C, int l, int w0, int nw) {
    PHASE_IDS
    (void)l;
    float* Ss = (float*)C.lds; float* Gs = Ss + 64 * LD;
    const int tid = P_tid, lane = P_lane, w = P_wave;
    const int tr = w >> 1, tc0 = 2 * (w & 1), mrow = 16 * tr + 4 * (lane >> 4);
    for (int bh = C.vcu - w0; bh < 32; bh += nw) {
        f32x4 sm[2] = {{0.f, 0.f, 0.f, 0.f}, {0.f, 0.f, 0.f, 0.f}};
        f32x4 gpre[2];
        { const RwcPtr O = rwc_ptr(C.ws, bh * NCH); gpre[0] = *(const f32x4*)(O.G + tid * 8); gpre[1] = *(const f32x4*)(O.G + tid * 8 + 4); }
        for (int c = 0; c < NCH; ++c) {
            const RwcPtr O = rwc_ptr(C.ws, bh * NCH + c);
            float* SC = (float*)(C.ws + WS_RWS) + (size_t)(bh * NCH + c) * 4096;
            float* Gc = Gs + (c & 1) * 64 * LD;
            __syncthreads();
#pragma unroll
            for (int x = 0; x < 2; ++x) { const int ncol = 16 * (tc0 + x) + (lane & 15);
#pragma unroll
                for (int r = 0; r < 4; ++r) { Ss[(mrow + r) * LD + ncol] = sm[x][r]; SC[(mrow + r) * 64 + ncol] = sm[x][r]; } }
            *(f32x4*)(Gc + (tid >> 3) * LD + 8 * (tid & 7)) = gpre[0]; *(f32x4*)(Gc + (tid >> 3) * LD + 8 * (tid & 7) + 4) = gpre[1];
            if (c + 1 < NCH) { const RwcPtr On = rwc_ptr(C.ws, bh * NCH + c + 1); gpre[0] = *(const f32x4*)(On.G + tid * 8); gpre[1] = *(const f32x4*)(On.G + tid * 8 + 4); }
            __syncthreads();
#pragma unroll
            for (int x = 0; x < 2; ++x) { const int tc = tc0 + x, ncol = 16 * tc + (lane & 15);
                f32x4 a = {O.HT[(mrow + 0) * 64 + ncol], O.HT[(mrow + 1) * 64 + ncol], O.HT[(mrow + 2) * 64 + ncol], O.HT[(mrow + 3) * 64 + ncol]};
                mm_cc<64>(a, Ss, LD, Gc, LD, tr, tc, lane); sm[x] = a; }
        }
    }
    __syncthreads();
}

DI void phase_rw3(const Ctx& C, int l, int ubeg, int uend, int ustep) {
    PHASE_IDS
    (void)l;
    float* Ps = (float*)C.lds; float* Ss = Ps + RC * LD;
    const int tid = P_tid, lane = P_lane, w = P_wave;
    const int tr = w >> 2, tc = w & 3, mrow = 16 * tr + 4 * (lane >> 4), ncol = 16 * tc + (lane & 15);
    float* RWY = (float*)(C.ws + WS_RWY);
    f32x4 ns0, ns1, np0, np1, ny;
#define RW3_LOAD(unit_) { const RwcPtr On = rwc_ptr(C.ws, (unit_)); const float* SCn = (const float*)(C.ws + WS_RWS) + (size_t)(unit_) * 4096; \
        ns0 = *(const f32x4*)(SCn + tid * 8); ns1 = *(const f32x4*)(SCn + tid * 8 + 4); \
        if (tid < 256) { np0 = *(const f32x4*)(On.Pm + tid * 8); np1 = *(const f32x4*)(On.Pm + tid * 8 + 4); } \
        ny = (f32x4){On.Y0[(mrow + 0) * 64 + ncol], On.Y0[(mrow + 1) * 64 + ncol], On.Y0[(mrow + 2) * 64 + ncol], On.Y0[(mrow + 3) * 64 + ncol]}; }
    if (ubeg < uend) RW3_LOAD(ubeg)
    for (int unit = ubeg; unit < uend; unit += ustep) {
        const int bh = unit / NCH, c = unit % NCH, bb = bh >> 2, h = bh & 3;
        __syncthreads();
        { const int row = tid >> 3, ch = 8 * (tid & 7);
          *(f32x4*)(Ss + row * LD + ch) = ns0; *(f32x4*)(Ss + row * LD + ch + 4) = ns1;
          if (tid < 256) { *(f32x4*)(Ps + row * LD + ch) = np0; *(f32x4*)(Ps + row * LD + ch + 4) = np1; } }
        f32x4 a = ny;
        if (unit + ustep < uend) RW3_LOAD(unit + ustep)
        __syncthreads();
        mm_cc<64>(a, Ps, LD, Ss, LD, tr, tc, lane);
#pragma unroll
        for (int r = 0; r < 4; ++r) RWY[((size_t)bb * SEQ + c * RC + mrow + r) * 256 + h * 64 + ncol] = a[r];
    }
#undef RW3_LOAD
    __syncthreads();
}

DI void phase_post(const Ctx& C, int l) {
    PHASE_IDS
    const float* glu = (const float*)(C.ws + WS_GLU); const bf16_t* RWB = (const bf16_t*)(C.ws + WS_RW); const float* RWY = (const float*)(C.ws + WS_RWY);
    bf16_t* mixed = (bf16_t*)(C.ws + WS_MIXED);
    const f32x4 on = ((const f32x4*)(INF(I_SONORM) + l * 256))[P_lane];
    float lnw[4], lnb[4], rkw[4];
#pragma unroll
    for (int h = 0; h < 4; ++h) { lnw[h] = INF(I_LNW)[l * 256 + h * 64 + P_lane]; lnb[h] = INF(I_LNB)[l * 256 + h * 64 + P_lane]; rkw[h] = INF(I_RK)[l * 256 + h * 64 + P_lane]; }
    f32x4 gv = ((const f32x4*)(glu + (size_t)P_gw * 256))[P_lane];
    float y[4], rr[4], kk[4], vv[4], gg[4];
#pragma unroll
    for (int h = 0; h < 4; ++h) { const int j = h * 64 + P_lane; const bf16_t* rw = RWB + (size_t)P_gw * 1536 + j; y[h] = RWY[(size_t)P_gw * 256 + j]; rr[h] = bf2f(rw[0]); kk[h] = bf2f(rw[256]); vv[h] = bf2f(rw[512]); gg[h] = bf2f(rw[1280]); }
    for (int t = P_gw; t < T; t += C.NGW) {
        const int tn = t + C.NGW < T ? t + C.NGW : t;
        const f32x4 gvn = ((const f32x4*)(glu + (size_t)tn * 256))[P_lane];
        float yn[4], rn[4], kn[4], vn[4], gn[4];
#pragma unroll
        for (int h = 0; h < 4; ++h) { const int j = h * 64 + P_lane; const bf16_t* rw = RWB + (size_t)tn * 1536 + j; yn[h] = RWY[(size_t)tn * 256 + j]; rn[h] = bf2f(rw[0]); kn[h] = bf2f(rw[256]); vn[h] = bf2f(rw[512]); gn[h] = bf2f(rw[1280]); }
        const float ss = wave_sum(gv.x * gv.x + gv.y * gv.y + gv.z * gv.z + gv.w * gv.w);
        const float rs = 1.f / sqrtf(ss * (1.f / 256.f) + NORM_EPS);
        *(u32x2*)(mixed + (size_t)t * DM + 512 + 4 * P_lane) = (u32x2){pk2(gv.x * rs * on.x, gv.y * rs * on.y), pk2(gv.z * rs * on.z, gv.w * rs * on.w)};
        float mean[4], dot[4];
#pragma unroll
        for (int h = 0; h < 4; ++h) { mean[h] = wave_sum(y[h]) * (1.f / 64.f); dot[h] = wave_sum(rr[h] * kk[h] * rkw[h]); }
#pragma unroll
        for (int h = 0; h < 4; ++h) { const float dv = y[h] - mean[h]; const float var = wave_sum(dv * dv) * (1.f / 64.f);
            const float yo = (dv * (1.f / sqrtf(var + 64e-5f)) * lnw[h] + lnb[h] + dot[h] * vv[h]) * gg[h];
            mixed[(size_t)t * DM + 768 + h * 64 + P_lane] = (bf16_t)f2bf(yo); }
        gv = gvn;
#pragma unroll
        for (int h = 0; h < 4; ++h) { y[h] = yn[h]; rr[h] = rn[h]; kk[h] = kn[h]; vv[h] = vn[h]; gg[h] = gn[h]; }
    }
}

DI void ce_desc(float& a, float& c) { const float hi = fmaxf(a, c), lo = fminf(a, c); a = hi; c = lo; }
DI void sort16_desc(float (&a)[16]) {
#pragma unroll
    for (int k = 2; k <= 16; k <<= 1)
#pragma unroll
        for (int j = k >> 1; j > 0; j >>= 1)
#pragma unroll
            for (int i = 0; i < 16; ++i) { const int l = i ^ j; if (l > i) { if ((i & k) == 0) ce_desc(a[i], a[l]); else ce_desc(a[l], a[i]); } }
}
DI void merge16_desc(float (&t)[16], const float (&g)[16]) {
#pragma unroll
    for (int i = 0; i < 16; ++i) t[i] = fmaxf(t[i], g[15 - i]);
#pragma unroll
    for (int j = 8; j > 0; j >>= 1)
#pragma unroll
        for (int i = 0; i < 16; ++i) { const int l = i ^ j; if (l > i) ce_desc(t[i], t[l]); }
}
DI void phase_topk(const Ctx& C, int l) {
    PHASE_IDS
    const bf16_t* qp = (const bf16_t*)(C.ws + WS_QP); const bf16_t* subk = (const bf16_t*)(C.ws + WS_SUBK);
    int* IDX = (int*)(C.ws + WS_IDX); float* GATE = (float*)(C.ws + WS_GATE);
    unsigned* scr = (unsigned*)C.lds + P_wave * 2048;
    const float NEG = -3.0e38f;
    for (int task = P_gw; task < (T / 32) * 8; task += C.NGW) {
        const int tile = task >> 3, h = task & 7;
        float LA[16], LB[16];
        {
        int lane0; asm volatile("v_mbcnt_lo_u32_b32 %0, -1, 0\n\tv_mbcnt_hi_u32_b32 %0, -1, %0" : "=v"(lane0)); const int r32 = lane0 & 31, hi = lane0 >> 5;
#pragma unroll
        for (int m = 0; m < 2; ++m) {
            bf16x8 bq[8];
#pragma unroll
            for (int d0 = 0; d0 < 8; ++d0) bq[d0] = *(const bf16x8*)(qp + (size_t)(tile * 32 + r32) * 2048 + h * 256 + m * 128 + d0 * 16 + hi * 8);
            float Lm[16];
#pragma unroll
            for (int i = 0; i < 16; ++i) Lm[i] = NEG;
#pragma unroll
            for (int k = 0; k < 4; ++k) {
                f32x16 acc;
#pragma unroll
                for (int r = 0; r < 16; ++r) acc[r] = 0.f;
                const bf16_t* kp = subk + ((size_t)((l * 8 + h) * 2 + m) * 128 + k * 32 + r32) * 128 + hi * 8;
                bf16x8 akf[8];
#pragma unroll
                for (int d0 = 0; d0 < 8; ++d0) akf[d0] = *(const bf16x8*)(kp + d0 * 16);
                __builtin_amdgcn_sched_barrier(0);
#pragma unroll
                for (int d0 = 0; d0 < 8; ++d0) acc = __builtin_amdgcn_mfma_f32_32x32x16_bf16(akf[d0], bq[d0], acc, 0, 0, 0);
                float gv[16];
#pragma unroll
                for (int r = 0; r < 16; ++r) { const unsigned key = 32 * k + (r & 3) + 8 * (r >> 2) + 4 * hi; const float av = acc[r];
                    gv[r] = __builtin_bit_cast(float, (__builtin_bit_cast(unsigned, av) & ~127u) | key); }
                sort16_desc(gv);
                if (k == 0) {
#pragma unroll
                    for (int i = 0; i < 16; ++i) Lm[i] = gv[i];
                } else merge16_desc(Lm, gv);
                __builtin_amdgcn_sched_barrier(0);
            }
            float ot[16];
#pragma unroll
            for (int i = 0; i < 16; ++i) ot[i] = other_half(Lm[i], hi);
            merge16_desc(Lm, ot);
#pragma unroll
            for (int i = 0; i < 16; ++i) { if (m == 0) LA[i] = Lm[i]; else LB[i] = Lm[i]; }
        }
        }
        int lane; asm volatile("v_mbcnt_lo_u32_b32 %0, -1, 0\n\tv_mbcnt_hi_u32_b32 %0, -1, %0" : "=v"(lane)); const int r32 = lane & 31, hi = lane >> 5;
#pragma unroll
        for (int i = 0; i < 16; ++i) { scr[i * 64 + lane] = __builtin_bit_cast(unsigned, LA[i]) & 127u; scr[(16 + i) * 64 + lane] = __builtin_bit_cast(unsigned, LB[i]) & 127u; }
        float L2[16];
        { float cv[64]; int cnt = 0;
#pragma unroll
          for (int i = 0; i < 16; ++i) {
              const float sa = __builtin_bit_cast(float, __builtin_bit_cast(unsigned, LA[i]) & ~127u);
#pragma unroll
              for (int j = 0; j < 16; ++j) if ((i + 1) * (j + 1) <= 16) {
                  const float sb = __builtin_bit_cast(float, __builtin_bit_cast(unsigned, LB[j]) & ~127u);
                  cv[cnt++] = __builtin_bit_cast(float, (__builtin_bit_cast(unsigned, sa + sb) & ~255u) | (unsigned)(i * 16 + j)); } }
#pragma unroll
          for (int q = 50; q < 64; ++q) cv[q] = NEG;
#pragma unroll
          for (int gI = 0; gI < 4; ++gI) { float gv[16];
#pragma unroll
              for (int q = 0; q < 16; ++q) gv[q] = cv[16 * gI + q];
              sort16_desc(gv);
              if (gI == 0) {
#pragma unroll
                  for (int q = 0; q < 16; ++q) L2[q] = gv[q];
              } else merge16_desc(L2, gv);
              __builtin_amdgcn_sched_barrier(0); } }
        float sc[16], den = 0.f;
#pragma unroll
        for (int q = 0; q < 16; ++q) { sc[q] = __builtin_bit_cast(float, __builtin_bit_cast(unsigned, L2[q]) & ~255u); }
        { const float m0 = sc[0];
#pragma unroll
        for (int q = 0; q < 16; ++q) { sc[q] = __expf(sc[q] - m0); den += sc[q]; } }
        const float rden = 1.f / den;
        if (hi == 0) {
            const size_t ob = (size_t)(tile * 32 + r32) * 128 + h * 16;
#pragma unroll
            for (int q = 0; q < 16; ++q) { const unsigned bits = __builtin_bit_cast(unsigned, L2[q]); const unsigned i = (bits >> 4) & 15u, j = bits & 15u;
                const unsigned e = scr[i * 64 + lane] * 128u + scr[(16 + j) * 64 + lane];
                IDX[ob + q] = (int)e; GATE[ob + q] = sc[q] * rden; }
        }
    }
}

DI void dec16(const u32x4 w, f32x2 (&o)[8]) {
    o[0] = __builtin_amdgcn_cvt_pk_f32_fp8((int)w.x, false); o[1] = __builtin_amdgcn_cvt_pk_f32_fp8((int)w.x, true);
    o[2] = __builtin_amdgcn_cvt_pk_f32_fp8((int)w.y, false); o[3] = __builtin_amdgcn_cvt_pk_f32_fp8((int)w.y, true);
    o[4] = __builtin_amdgcn_cvt_pk_f32_fp8((int)w.z, false); o[5] = __builtin_amdgcn_cvt_pk_f32_fp8((int)w.z, true);
    o[6] = __builtin_amdgcn_cvt_pk_f32_fp8((int)w.w, false); o[7] = __builtin_amdgcn_cvt_pk_f32_fp8((int)w.w, true);
}
DI float bperm_f(int lane_idx, float v) { return __builtin_bit_cast(float, __builtin_amdgcn_ds_bpermute(lane_idx << 2, __builtin_bit_cast(int, v))); }
DI void phase_gather_u(const Ctx& C, int l) {
    PHASE_IDS
    const int s = (int)blockIdx.x & 7, r = (int)blockIdx.x >> 3, tstride = (C.G >> 3) * NWAVES;
    const int lane = P_lane, sub = lane >> 3, chunk = lane & 7;
    int* wi = (int*)C.lds + P_wave * 128;
    const unsigned char* U8 = C.ws + WS_U8 + (size_t)l * NEXP * DM + s * 128; const unsigned lo16 = 16u * (unsigned)chunk;
    const bf16_t* H2 = (const bf16_t*)(C.ws + WS_H) + s * 128 + 16 * chunk;
    const int* IDX = (const int*)(C.ws + WS_IDX); bf16_t* PART = (bf16_t*)(C.ws + WS_PART);
    const int t0 = r * NWAVES + P_wave;
    if (t0 >= T) return;
    int i0 = IDX[(size_t)t0 * 128 + lane], i1 = IDX[(size_t)t0 * 128 + 64 + lane];
    u32x4 ha = *(const u32x4*)(H2 + (size_t)t0 * DM), hb = *(const u32x4*)(H2 + (size_t)t0 * DM + 8);
    for (int t = t0; t < T; t += tstride) {
        wi[lane] = i0; wi[64 + lane] = i1;
        f32x2 hf[8];
        hf[0] = (f32x2){bflo(ha.x), bfhi(ha.x)}; hf[1] = (f32x2){bflo(ha.y), bfhi(ha.y)}; hf[2] = (f32x2){bflo(ha.z), bfhi(ha.z)}; hf[3] = (f32x2){bflo(ha.w), bfhi(ha.w)};
        hf[4] = (f32x2){bflo(hb.x), bfhi(hb.x)}; hf[5] = (f32x2){bflo(hb.y), bfhi(hb.y)}; hf[6] = (f32x2){bflo(hb.z), bfhi(hb.z)}; hf[7] = (f32x2){bflo(hb.w), bfhi(hb.w)};
        { const int tn = t + tstride < T ? t + tstride : t;
          i0 = IDX[(size_t)tn * 128 + lane]; i1 = IDX[(size_t)tn * 128 + 64 + lane]; ha = *(const u32x4*)(H2 + (size_t)tn * DM); hb = *(const u32x4*)(H2 + (size_t)tn * DM + 8); }
        float pd[16];
#pragma unroll
        for (int half = 0; half < 2; ++half) {
            u32x4 rw[8];
#pragma unroll
            for (int i = 0; i < 8; ++i) { const int e = wi[(half * 8 + i) * 8 + sub]; rw[i] = *(const u32x4*)(U8 + (((unsigned)e << 10) + lo16)); }
#pragma unroll
            for (int i = 0; i < 8; i += 2) {
                f32x2 d[8], e[8]; dec16(rw[i], d); dec16(rw[i + 1], e);
                f32x2 a0 = d[0] * hf[0], a1 = d[1] * hf[1], b0 = e[0] * hf[0], b1 = e[1] * hf[1];
#pragma unroll
                for (int k = 2; k < 8; k += 2) { a0 += d[k] * hf[k]; b0 += e[k] * hf[k]; a1 += d[k + 1] * hf[k + 1]; b1 += e[k + 1] * hf[k + 1]; }
                a0 += a1; b0 += b1;
                pd[half * 8 + i] = a0.x + a0.y; pd[half * 8 + i + 1] = b0.x + b0.y; __builtin_amdgcn_sched_barrier(0); }
        }
        float w1[8], w2[4];
#pragma unroll
        for (int k = 0; k < 8; ++k) { const float keep = (chunk & 4) ? pd[8 + k] : pd[k], send = (chunk & 4) ? pd[k] : pd[8 + k]; w1[k] = keep + dpp_f<0x141>(send); }
#pragma unroll
        for (int k = 0; k < 4; ++k) { const float keep = (chunk & 2) ? w1[4 + k] : w1[k], send = (chunk & 2) ? w1[k] : w1[4 + k]; w2[k] = keep + dpp_f<0x4E>(send); }
        const float o0 = ((chunk & 1) ? w2[2] : w2[0]) + dpp_f<0xB1>((chunk & 1) ? w2[0] : w2[2]), o1 = ((chunk & 1) ? w2[3] : w2[1]) + dpp_f<0xB1>((chunk & 1) ? w2[1] : w2[3]);
        bf16_t* pp = PART + ((size_t)t * 8 + s) * 128 + sub;
        pp[(2 * chunk) * 8] = (bf16_t)f2bf(o0); pp[(2 * chunk + 1) * 8] = (bf16_t)f2bf(o1);
    }
}
DI void phase_gather_c(const Ctx& C, int l) {
    PHASE_IDS
    const float* SU = (const float*)(C.ws + WS_SU) + l * NEXP; const float* SV = (const float*)(C.ws + WS_SV) + l * NEXP;
    const int* IDX = (const int*)(C.ws + WS_IDX); const float* GATE = (const float*)(C.ws + WS_GATE); float* COEF = (float*)(C.ws + WS_COEF); const bf16_t* PART = (const bf16_t*)(C.ws + WS_PART);
    for (int t = P_gw; t < T; t += C.NGW) {
#pragma unroll
        for (int hq = 0; hq < 2; ++hq) { const int p = hq * 64 + P_lane; const int e = IDX[(size_t)t * 128 + p]; float d = 0.f;
#pragma unroll
            for (int s = 0; s < 8; ++s) d += bf2f(PART[((size_t)t * 8 + s) * 128 + p]);
            COEF[(size_t)t * 128 + p] = GATE[(size_t)t * 128 + p] * gelu_erf(d * SU[e]) * SV[e]; }
    }
}
DI void phase_gather_v(const Ctx& C, int l) {
    PHASE_IDS
    const int s = (int)blockIdx.x & 7, r = (int)blockIdx.x >> 3, tstride = (C.G >> 3) * NWAVES;
    const int lane = P_lane, hi = lane >> 5, b4 = (lane >> 4) & 1, b3 = (lane >> 3) & 1, sub = lane >> 3, chunk = lane & 7;
    int* wi = (int*)C.lds + P_wave * 256; float* wc = (float*)(wi + 128);
    const unsigned char* V8 = C.ws + WS_V8 + (size_t)l * NEXP * DM + s * 128; const unsigned lo16 = 16u * (unsigned)chunk;
    const int* IDX = (const int*)(C.ws + WS_IDX); const float* COEF = (const float*)(C.ws + WS_COEF);
    const int tv0 = r * NWAVES + P_wave;
    if (tv0 >= T) return;
    int i0 = IDX[(size_t)tv0 * 128 + lane], i1 = IDX[(size_t)tv0 * 128 + 64 + lane]; float c0 = COEF[(size_t)tv0 * 128 + lane], c1 = COEF[(size_t)tv0 * 128 + 64 + lane];
    for (int t = tv0; t < T; t += tstride) {
        wi[lane] = i0; wi[64 + lane] = i1; wc[lane] = c0; wc[64 + lane] = c1;
        { const int tn = t + tstride < T ? t + tstride : t;
          i0 = IDX[(size_t)tn * 128 + lane]; i1 = IDX[(size_t)tn * 128 + 64 + lane]; c0 = COEF[(size_t)tn * 128 + lane]; c1 = COEF[(size_t)tn * 128 + 64 + lane]; }
        f32x2 acc[8];
#pragma unroll
        for (int k = 0; k < 8; ++k) acc[k] = (f32x2){0.f, 0.f};
#pragma unroll
        for (int half = 0; half < 2; ++half) {
            u32x4 rw[8]; float cf[8];
#pragma unroll
            for (int i = 0; i < 8; ++i) { const int ii = (half * 8 + i) * 8 + sub; const int e = wi[ii]; cf[i] = wc[ii]; rw[i] = *(const u32x4*)(V8 + (((unsigned)e << 10) + lo16)); }
#pragma unroll
            for (int i = 0; i < 8; ++i) { f32x2 d[8]; dec16(rw[i], d); const f32x2 c2 = (f32x2){cf[i], cf[i]};
#pragma unroll
                for (int k = 0; k < 8; ++k) acc[k] += c2 * d[k];
                __builtin_amdgcn_sched_barrier(0); }
        }
        f32x2 q1[4], q2[2], q3;
#pragma unroll
        for (int i = 0; i < 4; ++i) { const f32x2 keep = hi ? acc[4 + i] : acc[i], send = hi ? acc[i] : acc[4 + i]; q1[i] = keep + (f32x2){other_half(send.x, hi), other_half(send.y, hi)}; }
#pragma unroll
        for (int i = 0; i < 2; ++i) { const f32x2 keep = b4 ? q1[2 + i] : q1[i], send = b4 ? q1[i] : q1[2 + i]; q2[i] = keep + (f32x2){xor16(send.x), xor16(send.y)}; }
        { const f32x2 keep = b3 ? q2[1] : q2[0], send = b3 ? q2[0] : q2[1]; q3 = keep + (f32x2){xor8(send.x), xor8(send.y)}; }
        f32x2* op = (f32x2*)(C.out + (size_t)t * DM + s * 128 + 16 * chunk + 2 * (4 * hi + 2 * b4 + b3));
        *op = *op + q3;
    }
}

struct EpiResF32 {
    static constexpr bool PERM = false, AFTER_DRAIN = false;
    const float* R; float* Cc; int ldc;
    __device__ __forceinline__ void operator()(const pg8::f32x4 (&acc)[2][2][4][2], const pg8::Unit& u, int wr, int wc, int fr, int fq) const {
        int ln_; asm volatile("v_mbcnt_lo_u32_b32 %0, -1, 0\n\tv_mbcnt_hi_u32_b32 %0, -1, %0" : "=v"(ln_)); const int fr_ = ln_ & 15, fq_ = ln_ >> 4; (void)fr; (void)fq;
        const int row0 = u.pm * 256 + wr * 64 + fr_, col0 = u.pn * 256 + wc * 32 + 4 * fq_;
#pragma unroll
        for (int ai = 0; ai < 2; ++ai)
#pragma unroll
            for (int m = 0; m < 4; ++m) { const size_t ro = (size_t)(row0 + ai * 128 + m * 16) * ldc + col0;
#pragma unroll
                for (int bj = 0; bj < 2; ++bj)
#pragma unroll
                    for (int n = 0; n < 2; ++n) { const pg8::f32x4 r = *(const pg8::f32x4*)(R + ro + bj * 128 + n * 16); *(pg8::f32x4*)(Cc + ro + bj * 128 + n * 16) = acc[ai][bj][m][n] + r; } __builtin_amdgcn_sched_barrier(0); }
    }
};
struct EpiGlu {
    static constexpr bool PERM = false, AFTER_DRAIN = false;
    const bf16_t* YG; const float* bias; float* Gg;
    __device__ __forceinline__ void operator()(const pg8::f32x4 (&acc)[2][2][4][2], const pg8::Unit& u, int wr, int wc, int fr, int fq) const {
        int ln_; asm volatile("v_mbcnt_lo_u32_b32 %0, -1, 0\n\tv_mbcnt_hi_u32_b32 %0, -1, %0" : "=v"(ln_)); const int fr_ = ln_ & 15, fq_ = ln_ >> 4; (void)fr; (void)fq;
        const int row0 = u.pm * 256 + wr * 64 + fr_, col0 = wc * 32 + 4 * fq_;
#pragma unroll
        for (int ai = 0; ai < 2; ++ai)
#pragma unroll
            for (int m = 0; m < 4; ++m) { const size_t ro = (size_t)(row0 + ai * 128 + m * 16) * 256 + col0;
#pragma unroll
                for (int bj = 0; bj < 2; ++bj)
#pragma unroll
                    for (int n = 0; n < 2; ++n) { const size_t o = ro + bj * 128 + n * 16; const pg8::f32x4 bv = *(const pg8::f32x4*)(bias + col0 + bj * 128 + n * 16);
                        const u32x2 y = *(const u32x2*)(YG + o); const pg8::f32x4 a = acc[ai][bj][m][n] + bv;
                        pg8::f32x4 r; r.x = bflo(y.x) * sigmoidf_(a.x); r.y = bfhi(y.x) * sigmoidf_(a.y); r.z = bflo(y.y) * sigmoidf_(a.z); r.w = bfhi(y.y) * sigmoidf_(a.w);
                        *(pg8::f32x4*)(Gg + o) = r; } __builtin_amdgcn_sched_barrier(0); }
    }
};

#ifndef MK_ONLY
#define MK_ONLY -1
#endif
#define PH_EN(k) ((MK_ONLY) < 0 || (MK_ONLY) == (k))
constexpr int PH_PER_LAYER = 15, NPHASES = 1 + DEPTH * PH_PER_LAYER;
__global__ void __launch_bounds__(NTHR, 2) fwd(Args args) {
    extern __shared__ __attribute__((aligned(16))) unsigned char lds_raw[];
    Ctx C;
    C.in = args.in; C.out = args.out; C.ws = args.ws; C.lds = (char*)lds_raw;
    C.G = gridDim.x; { const int bx = blockIdx.x; C.vcu = (C.G % 8 == 0) ? (bx % 8) * (C.G / 8) + bx / 8 : bx; }
    C.NGW = C.G * NWAVES; C.wave = __builtin_amdgcn_readfirstlane((int)threadIdx.x >> 6);
    volatile LAS unsigned* MISC = (volatile LAS unsigned*)((LAS unsigned char*)lds_raw + MISC_OFF);
    if (threadIdx.x < 64) MISC[threadIdx.x] = 0u;
    __syncthreads();
    XcdBarrier bar; bar.bar = (unsigned*)(args.ws + WS_CTL) + 4096 + args.bli * XCD_BAR_WORDS; bar.x = 0; bar.st = MISC + 8;
    const bool multi = (args.ph_hi - args.ph_lo) > 1;
    if (multi) bar = xcd_barrier_post((unsigned*)(args.ws + WS_CTL) + 4096 + args.bli * XCD_BAR_WORDS, MISC + 8);
    LAS unsigned char* ldsp = (LAS unsigned char*)lds_raw;

#ifndef MK_SPLIT_MIXERS
#define MK_SPLIT_MIXERS 0
#endif
#ifndef MK_NOISE
#define MK_NOISE 0
#endif
#ifndef MK_RWKV_NAIVE
#define MK_RWKV_NAIVE 0
#endif
#ifndef MK_REPK
#define MK_REPK -1
#endif
#define REPS_(k) ((MK_REPK) == (k) ? 2 : 1)
#define IN_(P) (args.ph_lo <= (P) && (P) < args.ph_hi)
#define RUNP_(k, stmt) for (int r_ = 0; r_ < REPS_(k); ++r_) { if (r_) xcd_barrier(bar, C.wave); stmt; }
#define SEAM_(P) do { if (IN_(P) && IN_((P) + 1)) xcd_barrier(bar, C.wave); } while (0)
#define GEMM_(EPI, EXPR_E, A_, BT_, M_, N_, K_) do { pg8::Gemm g{(const bf16_t*)(A_), (const bf16_t*)(BT_), (M_), (N_), (K_)}; pg8::StaticOrder S; S.init((M_), (N_), C.G, (int)blockIdx.x); EPI E EXPR_E; \
        pg8::gemm_phase<EPI, pg8::StaticOrder>(ldsp, g, S, E, nullptr, C.wave); } while (0)
#define LAYER_(L) do { constexpr int l = (L); constexpr int P0 = 1 + (L) * PH_PER_LAYER; \
    if (IN_(P0 + 0)) { RUNP_(0, phase_rmsnorm<false>(C, (l == 0) ? (const float*)C.in[I_X] : (const float*)C.out, INF(I_NORM_MIX) + l * DM, (bf16_t*)(C.ws + WS_H))) } SEAM_(P0 + 0); \
    if (IN_(P0 + 1)) { RUNP_(1, GEMM_(pg8::EpiBf16<0>, ({(bf16_t*)(C.ws + WS_COLS), INCP, nullptr, 0, 0}), C.ws + WS_H, (const bf16_t*)(C.ws + WS_WTIN) + (size_t)l * INCP * DM, T, INCP, DM)) } SEAM_(P0 + 1); \
    if (IN_(P0 + 2)) { if (PH_EN(2)) phase_prep(C, l); } SEAM_(P0 + 2); \
    if (IN_(P0 + 3)) { for (int r_ = 0; r_ < REPS_(3); ++r_) { if (r_) xcd_barrier(bar, C.wave); if (!MK_RWKV_NAIVE) for (int q_ = 0; q_ < REPS_(32); ++q_) phase_rw1(C, l, 0, C.G); \
                       if (C.G == 256) { if (C.vcu < 128) phase_ssm(C, l, 0, 128); phase_attn_queue(C, l, 0); } else { phase_ssm(C, l, 0, C.G); phase_attn(C, l, 0, C.G); } } } SEAM_(P0 + 3); \
    if (IN_(P0 + 4)) for (int r_ = 0; r_ < REPS_(4); ++r_) { if (r_) xcd_barrier(bar, C.wave); if (C.G == 256) { if (C.vcu < 32) phase_rw2(C, l, 0, 32); phase_attn_queue(C, l, 1); } else phase_rw2(C, l, 0, C.G); } SEAM_(P0 + 4); \
      \
    if (IN_(P0 + 5)) { if (!MK_RWKV_NAIVE) RUNP_(5, { if (C.G == 256) { const int bx_ = (int)blockIdx.x; if (bx_ < 128) phase_rw3(C, l, bx_ * 6, bx_ * 6 + 6, 1); else phase_rw3(C, l, 768 + (bx_ - 128) * 26, 768 + (bx_ - 128) * 26 + 26, 1); } else phase_rw3(C, l, C.vcu, 32 * NCH, C.G); }) } \
    if (IN_(P0 + 6)) { if (PH_EN(6)) GEMM_(EpiGlu, ({(const bf16_t*)(C.ws + WS_YG), INF(I_BGLU) + l * 256, (float*)(C.ws + WS_GLU)}), C.ws + WS_YG, (const bf16_t*)(C.ws + WS_WTGLU) + (size_t)l * 256 * 256, T, 256, 256); } SEAM_(P0 + 6); \
    if (IN_(P0 + 7)) { RUNP_(7, phase_post(C, l)) } SEAM_(P0 + 7); \
    if (IN_(P0 + 8)) { if (PH_EN(8)) GEMM_(EpiResF32, ({(l == 0) ? (const float*)C.in[I_X] : (const float*)C.out, C.out, DM}), C.ws + WS_MIXED, (const bf16_t*)(C.ws + WS_WTOUT) + (size_t)l * DM * DM, T, DM, DM); } SEAM_(P0 + 8); \
    if (IN_(P0 + 9)) { RUNP_(9, phase_rmsnorm<false>(C, C.out, INF(I_NORM_FFN) + l * DM, (bf16_t*)(C.ws + WS_H))) } SEAM_(P0 + 9); \
    if (IN_(P0 + 10)) { if (PH_EN(10)) GEMM_(pg8::EpiBf16<0>, ({(bf16_t*)(C.ws + WS_QP), 2048, nullptr, 0, 0}), C.ws + WS_H, (const bf16_t*)(C.ws + WS_WTQ) + (size_t)l * 2048 * DM, T, 2048, DM); } SEAM_(P0 + 10); \
    if (IN_(P0 + 11)) { for (int r_ = 0; r_ < REPS_(11); ++r_) { if (r_) xcd_barrier(bar, C.wave); phase_topk(C, l); } } SEAM_(P0 + 11); \
    if (IN_(P0 + 12)) { for (int r_ = 0; r_ < REPS_(12); ++r_) { if (r_) xcd_barrier(bar, C.wave); phase_gather_u(C, l); } } SEAM_(P0 + 12); \
    if (IN_(P0 + 13)) { RUNP_(13, phase_gather_c(C, l)) } SEAM_(P0 + 13); \
    if (IN_(P0 + 14)) { phase_gather_v(C, l); } SEAM_(P0 + 14); \
    } while (0)
    if (IN_(0)) { if (PH_EN(100)) phase_prologue(C); } SEAM_(0);
    LAYER_(0); LAYER_(1); LAYER_(2); LAYER_(3);
}
}

extern "C" void kernel_launch(void* const* d_in, const int* in_sizes, int n_in, void* d_out, int out_size, void* d_ws, size_t ws_size, hipStream_t stream) {
    using namespace mk;
    static int grid = 0;
    if (grid == 0) {
        if (n_in != N_IN || out_size != T * DM || ws_size < WS_END) { fprintf(stderr, "kernel_launch: unexpected shapes (n_in %d, out %d, ws %zu)\n", n_in, out_size, ws_size); grid = -1; return; }
        int dev = 0, cus = 0;
        if (hipGetDevice(&dev) != hipSuccess || hipDeviceGetAttribute(&cus, hipDeviceAttributeMultiprocessorCount, dev) != hipSuccess) { grid = -1; return; }
        if (hipFuncSetAttribute((const void*)fwd, hipFuncAttributeMaxDynamicSharedMemorySize, LDS_BYTES) != hipSuccess) { fprintf(stderr, "kernel_launch: hipFuncSetAttribute failed\n"); grid = -1; return; }
        int per_cu = 0;
        if (hipOccupancyMaxActiveBlocksPerMultiprocessor(&per_cu, (const void*)fwd, NTHR, LDS_BYTES) != hipSuccess || per_cu < 1) fprintf(stderr, "kernel_launch: occupancy query says %d\n", per_cu);
        (void)hipGetLastError();
        grid = cus;
    }
    if (grid < 0) return;
    (void)hipMemsetAsync((char*)d_ws + WS_CTL, 0, CTL_BYTES, stream);
    Args a{};
    for (int i = 0; i < N_IN; ++i) a.in[i] = d_in[i];
    a.out = (float*)d_out; a.ws = (unsigned char*)d_ws;
#if MK_DEBUG
    {
        auto run = [&](int p) { a.ph_lo = p; a.ph_hi = p + 1; hipLaunchKernelGGL(fwd, dim3(grid), dim3(NTHR), LDS_BYTES, stream, a); };
        auto chk = [&](int stage, int blocks, int thr, int ldsb) { hipLaunchKernelGGL(dbg_check, dim3(blocks), dim3(thr), ldsb, stream, a, stage, (int)MK_DBG_LAYER); };
        static bool attr = false; if (!attr) { (void)hipFuncSetAttribute((const void*)dbg_check, hipFuncAttributeMaxDynamicSharedMemorySize, 65536); attr = true; }
        run(0); chk(20, 1, 256, 0);
        for (int l = 0; l < MK_DBG_LAYER; ++l) for (int k = 0; k < PH_PER_LAYER; ++k) run(1 + l * PH_PER_LAYER + k);
        const int base = 1 + MK_DBG_LAYER * PH_PER_LAYER;
        run(base + 0); chk(1, 8, 256, 0);
        run(base + 1); chk(2, 16, 256, 0); chk(34, 16, 256, 0); chk(35, 64, 256, 0); chk(37, 64, 256, 0);
        run(base + 2); chk(46, 256, 256, 0); chk(38, 16, 256, 0); chk(3, 2, 256, 65536); chk(4, 2, 256, 0);
        run(base + 3);
        run(base + 4); chk(5, 16, 256, 0); chk(6, 1, 256, 0);
        run(base + 5); chk(7, 8, 256, 0);
        run(base + 6); run(base + 7); chk(8, 4, 64, 65536); chk(9, 4, 256, 0);
        run(base + 8); chk(10, 16, 256, 0);
        run(base + 9); chk(11, 8, 256, 0);
        run(base + 10); chk(12, 16, 256, 0);
        run(base + 11); chk(61, 4, 256, 65536); chk(13, 8, 64, 65536); chk(140, 4, 256, 0);
        run(base + 12); run(base + 13); chk(141, 16, 256, 0); run(base + 14); chk(14, 4, 256, 0);
#ifdef MK_DBG_VAL
        hipLaunchKernelGGL(dbg_encode_val, dim3(1024), dim3(256), 0, stream, a, MK_DBG_VAL);
#elif defined(MK_DBG_LVL)
        hipLaunchKernelGGL(dbg_encode_lvl, dim3(1024), dim3(256), 0, stream, a, MK_DBG_LVL);
#else
        hipLaunchKernelGGL(dbg_encode, dim3(1024), dim3(256), 0, stream, a, MK_DBG_SET);
#endif
    }
#elif defined(MK_CUTS)
    { const int cuts[] = {0, MK_CUTS, NPHASES}; const int nc = (int)(sizeof(cuts) / sizeof(int));
      for (int i = 0; i + 1 < nc; ++i) { a.ph_lo = cuts[i]; a.ph_hi = cuts[i + 1]; a.bli = i; hipLaunchKernelGGL(fwd, dim3(grid), dim3(NTHR), LDS_BYTES, stream, a); } }
#elif MK_ONE_LAUNCH
    a.ph_lo = 0; a.ph_hi = NPHASES;
    hipLaunchKernelGGL(fwd, dim3(grid), dim3(NTHR), LDS_BYTES, stream, a);
#else
    for (int p = 0; p < NPHASES; ++p) { a.ph_lo = p; a.ph_hi = p + 1; hipLaunchKernelGGL(fwd, dim3(grid), dim3(NTHR), LDS_BYTES, stream, a); }
#endif
}
```

```cpp
#include <hip/hip_runtime.h>
#include <cstdio>
#include <cstdint>
#define MK_ONE_LAUNCH 1
#ifndef MK_ONE_LAUNCH
#define MK_ONE_LAUNCH 0
#endif
#ifndef MK_DEBUG
#define MK_DEBUG 0
#endif
#ifndef MK_DBG_LAYER
#define MK_DBG_LAYER 0
#endif
#ifndef MK_DBG_SET
#define MK_DBG_SET 5,6,7,13,14,4
#endif
namespace pg8 {
#define PG8_LAS __attribute__((address_space(3)))
typedef unsigned short bf16_t;
typedef short bf16x8 __attribute__((ext_vector_type(8)));
typedef float f32x4 __attribute__((ext_vector_type(4)));
typedef unsigned u32x4 __attribute__((ext_vector_type(4)));
constexpr int BM = 256, BK = 64, HALF = 128, HTB = HALF * BK * 2  , STAGE_BYTES = 8 * HTB, NXCD = 8, WGM = 8;

__host__ __device__ __forceinline__ int lds_byte(int r, int c) { const int st = (r >> 4) * 2 + (c >> 5), rr = r & 15, cc = c & 31, ob = rr * 64 + cc * 2; return st * 1024 + (ob ^ (((ob >> 9) & 1) << 5)); }
__host__ __device__ __forceinline__ void stage_rc(int b, int& R, int& C) { const int st = b / 1024, sb = b % 1024, swz = sb ^ (((sb >> 9) & 1) << 5); R = (st >> 1) * 16 + swz / 64; C = (st & 1) * 32 + (swz % 64) / 2; }
__host__ __device__ __forceinline__ int perm32(int rho) { const int n = rho >> 4, i = rho & 15; return 8 * (i >> 2) + 4 * n + (i & 3); }

struct Unit { int pm, pn; };
struct Gemm { const bf16_t* A; const bf16_t* Bt; int M, N, K; };

struct StaticOrder {
    int nM, nN, nwg, G, c;
    __host__ __device__ void init(int M, int N, int G_, int c_) { nM = M / BM; nN = N / BM; nwg = nM * nN; G = G_; c = c_; }
    __host__ __device__ bool next(int i, Unit& u) const {
        const long L = (long)i * G + c; if (L >= nwg) return false;
        int wgid = (int)L; { const int q = nwg / NXCD, r = nwg % NXCD, xcd = wgid % NXCD, off = wgid / NXCD; wgid = (xcd < r ? xcd * (q + 1) : r * (q + 1) + (xcd - r) * q) + off; }
        const int nig = WGM * nN, gid = wgid / nig, fm = gid * WGM, gsz = (nM - fm) < WGM ? (nM - fm) : WGM;
        u.pm = fm + ((wgid % nig) % gsz); u.pn = (wgid % nig) / gsz; return true;
    }
    __device__ __forceinline__ void a_ready(const Unit&) const {}
    __device__ __forceinline__ void done(const Unit&) const {}
};

__device__ __forceinline__ unsigned cvt_pk_bf16(float lo, float hi) { unsigned r; asm volatile("v_cvt_pk_bf16_f32 %0, %1, %2" : "=v"(r) : "v"(lo), "v"(hi)); return r; }
typedef float f32x2 __attribute__((ext_vector_type(2)));
__device__ __forceinline__ f32x2 gelu_pk(f32x2 v) {
    const f32x2 av = __builtin_elementwise_abs(v), d = av * 0.2316418882f + 1.0f;
    f32x2 t; t.x = __builtin_amdgcn_rcpf(d.x); t.y = __builtin_amdgcn_rcpf(d.y);
    f32x2 q = t * 0.5307027145f + (-0.7265760135f); q = q * t + 0.7107068705f; q = q * t + (-0.142248368f); q = q * t + 0.127414796f; q = q * t;
    const f32x2 s = (v * v) * (-0.72134752044f);
    f32x2 e; e.x = __builtin_amdgcn_exp2f(s.x); e.y = __builtin_amdgcn_exp2f(s.y);
    const f32x2 m = v * (q * e), r = v - m;
    f32x2 o; o.x = v.x < 0.f ? m.x : r.x; o.y = v.y < 0.f ? m.y : r.y; return o;
}

struct EpiF32 {
    static constexpr bool PERM = false, AFTER_DRAIN = false;
    float* C; int ldc; const float* bias;
    __device__ __forceinline__ void operator()(const f32x4 (&acc)[2][2][4][2], const Unit& u, int wr, int wc, int fr, int fq) const {
        const int row0 = u.pm * BM + wr * 64 + fr, col0 = u.pn * BM + wc * 32 + 4 * fq;
        f32x4 bv[2][2];
#pragma unroll
        for (int bj = 0; bj < 2; ++bj)
#pragma unroll
            for (int n = 0; n < 2; ++n) bv[bj][n] = bias ? *(const f32x4*)(bias + col0 + bj * HALF + n * 16) : (f32x4){0.f, 0.f, 0.f, 0.f};
#pragma unroll
        for (int ai = 0; ai < 2; ++ai)
#pragma unroll
            for (int m = 0; m < 4; ++m) { float* rowp = C + (size_t)(row0 + ai * HALF + m * 16) * ldc + col0;
#pragma unroll
                for (int bj = 0; bj < 2; ++bj)
#pragma unroll
                    for (int n = 0; n < 2; ++n) *(f32x4*)(rowp + bj * HALF + n * 16) = acc[ai][bj][m][n] + bv[bj][n]; }
    }
};
template <int ACT  > struct EpiBf16 {
    static constexpr bool PERM = true, AFTER_DRAIN = false;
    bf16_t* O; int ldc; const float* bias; int split_cols; size_t split_stride;
    __device__ __forceinline__ void operator()(const f32x4 (&acc)[2][2][4][2], const Unit& u, int wr, int wc, int fr_in, int fq_in) const {
        int ln_; asm volatile("v_mbcnt_lo_u32_b32 %0, -1, 0\n\tv_mbcnt_hi_u32_b32 %0, -1, %0" : "=v"(ln_)); const int fr = ln_ & 15, fq = ln_ >> 4; (void)fr_in; (void)fq_in;
        const int row0 = u.pm * BM + wr * 64 + fr; int colt = u.pn * BM; bf16_t* base = O;
        if (split_cols) { const int t = colt / split_cols; base += (size_t)t * split_stride; colt -= t * split_cols; }
        const int col0 = colt + wc * 32 + 8 * fq, bcol0 = u.pn * BM + wc * 32 + 8 * fq;
        f32x4 bv[2][2];
#pragma unroll
        for (int bj = 0; bj < 2; ++bj)
#pragma unroll
            for (int n = 0; n < 2; ++n) bv[bj][n] = bias ? *(const f32x4*)(bias + bcol0 + bj * HALF + 4 * n) : (f32x4){0.f, 0.f, 0.f, 0.f};
#pragma unroll
        for (int ai = 0; ai < 2; ++ai)
#pragma unroll
            for (int m = 0; m < 4; ++m) { bf16_t* rowp = base + (size_t)(row0 + ai * HALF + m * 16) * ldc + col0;
#pragma unroll
                for (int bj = 0; bj < 2; ++bj) { f32x4 v0 = acc[ai][bj][m][0] + bv[bj][0], v1 = acc[ai][bj][m][1] + bv[bj][1];
                    if (ACT == 1) { f32x2 a = gelu_pk((f32x2){v0[0], v0[1]}), b = gelu_pk((f32x2){v0[2], v0[3]}), c = gelu_pk((f32x2){v1[0], v1[1]}), d = gelu_pk((f32x2){v1[2], v1[3]});
                        v0 = (f32x4){a.x, a.y, b.x, b.y}; v1 = (f32x4){c.x, c.y, d.x, d.y}; }
                    if (ACT == 2) {
#pragma unroll
                        for (int j = 0; j < 4; ++j) { v0[j] = 0.5f * v0[j] * (1.0f + erff(v0[j] * 0.70710678f)); v1[j] = 0.5f * v1[j] * (1.0f + erff(v1[j] * 0.70710678f)); } }
                    u32x4 w; w.x = cvt_pk_bf16(v0[0], v0[1]); w.y = cvt_pk_bf16(v0[2], v0[3]); w.z = cvt_pk_bf16(v1[0], v1[1]); w.w = cvt_pk_bf16(v1[2], v1[3]);
                    *(u32x4*)(rowp + bj * HALF) = w; } }
    }
};

template <class Epi, class Sched, bool STAMP = false>
__device__ __forceinline__ void gemm_phase(PG8_LAS unsigned char* lds, const Gemm g, const Sched& S, const Epi& E, unsigned long long* stamps, int wave_in) {
    int lane_; asm volatile("v_mbcnt_lo_u32_b32 %0, -1, 0\n\tv_mbcnt_hi_u32_b32 %0, -1, %0" : "=v"(lane_)); const int tid = wave_in * 64 + lane_; const int wid = wave_in, lane = tid & 63, wr = wid >> 2, wc = wid & 3, fr = lane & 15, fq = lane >> 4;
    const int K = g.K, nt = K / BK;
    int ts_lo = 0, ts_hi = 0, nts = 0; const unsigned long long rt_entry = STAMP ? (unsigned long long)wall_clock64() : 0ull;
#define PG8_STAMP() do { if (STAMP && wid == 0 && nts < 64) { const unsigned long long _c = (unsigned long long)clock64(); \
        ts_lo = (lane == nts) ? (int)(unsigned)_c : ts_lo; ts_hi = (lane == nts) ? (int)(unsigned)(_c >> 32) : ts_hi; ++nts; } } while (0)
    PG8_STAMP();
    unsigned voffA[2], voffB[2];
#pragma unroll
    for (int i = 0; i < 2; ++i) { int R, C; stage_rc(tid * 16 + i * 8192, R, C); const int Rb = Epi::PERM ? ((R & ~31) + perm32(R & 31)) : R;
        voffA[i] = (unsigned)(R * K + C) * 2u; voffB[i] = (unsigned)(Rb * K + C) * 2u; }
    const size_t kstep = (size_t)(BK * 2);
    const size_t hstep = (size_t)HALF * K * 2;
    const size_t tstep = 2 * hstep;
    const unsigned ldsw = (unsigned)wid * 1024u;
    const int aoff = lds_byte(wr * 64 + fr, fq * 8), boff = lds_byte(wc * 32 + fr, fq * 8);
#define PG8_SA(b, h) (((b) * 2 + (h)) * HTB)
#define PG8_SB(b, h) ((4 + (b) * 2 + (h)) * HTB)
#define PG8_STAGE(bufoff, gbase, voff) do { _Pragma("unroll") for (int _i = 0; _i < 2; ++_i) \
        __builtin_amdgcn_global_load_lds((const unsigned*)((const char*)(gbase) + (voff)[_i]), (PG8_LAS unsigned*)(lds + (bufoff) + ldsw + _i * 8192), 16, 0, 0); } while (0)
#define PG8_LDA(dst, b, h) do { _Pragma("unroll") for (int m = 0; m < 4; ++m) _Pragma("unroll") for (int k = 0; k < 2; ++k) dst[m][k] = *(const PG8_LAS bf16x8*)(lds + PG8_SA(b, h) + aoff + m * 2048 + k * 1024); } while (0)
#define PG8_LDB(dst, b, h) do { _Pragma("unroll") for (int n = 0; n < 2; ++n) _Pragma("unroll") for (int k = 0; k < 2; ++k) dst[n][k] = *(const PG8_LAS bf16x8*)(lds + PG8_SB(b, h) + boff + n * 2048 + k * 1024); } while (0)
#define PG8_MMA(ai, bj, At, Bt) do { __builtin_amdgcn_s_setprio(1); _Pragma("unroll") for (int m = 0; m < 4; ++m) _Pragma("unroll") for (int n = 0; n < 2; ++n) _Pragma("unroll") for (int k = 0; k < 2; ++k) \
        acc[ai][bj][m][n] = __builtin_amdgcn_mfma_f32_16x16x32_bf16(Bt[n][k], At[m][k], acc[ai][bj][m][n], 0, 0, 0); __builtin_amdgcn_s_setprio(0); } while (0)
#define PG8_WAIT_V(n) asm volatile("s_waitcnt vmcnt(" #n ")" ::: "memory")
#define PG8_WAIT_L(n) asm volatile("s_waitcnt lgkmcnt(" #n ")" ::: "memory")
#define PG8_BAR __builtin_amdgcn_s_barrier()
#define PG8_SCHED __builtin_amdgcn_sched_barrier(0)
    Unit cur, nxt; int ui = 0;
    if (!S.next(0, cur)) return;
    f32x4 acc[2][2][4][2];
#pragma unroll
    for (int a = 0; a < 2; ++a)
#pragma unroll
        for (int b = 0; b < 2; ++b)
#pragma unroll
            for (int m = 0; m < 4; ++m)
#pragma unroll
                for (int n = 0; n < 2; ++n) acc[a][b][m][n] = (f32x4){0.f, 0.f, 0.f, 0.f};
    bf16x8 At[4][2], B0[2][2], B1[2][2];
    const char* cA = (const char*)g.A + (size_t)cur.pm * tstep; const char* cB = (const char*)g.Bt + (size_t)cur.pn * tstep;
    S.a_ready(cur);
    PG8_STAGE(PG8_SB(0, 0), cB, voffB); PG8_STAGE(PG8_SA(0, 0), cA, voffA); PG8_STAGE(PG8_SB(0, 1), cB + hstep, voffB); PG8_STAGE(PG8_SA(0, 1), cA + hstep, voffA);
    if (wr == 1) PG8_BAR;
    PG8_WAIT_V(4); PG8_BAR;
    PG8_STAGE(PG8_SB(1, 0), cB + kstep, voffB); PG8_STAGE(PG8_SA(1, 0), cA + kstep, voffA); PG8_STAGE(PG8_SB(1, 1), cB + hstep + kstep, voffB);
    PG8_WAIT_V(6); PG8_BAR;
    PG8_STAMP();
    for (;;) {
        const bool has_next = S.next(ui + 1, nxt);
        const char* nA = has_next ? (const char*)g.A + (size_t)nxt.pm * tstep : cA; const char* nB = has_next ? (const char*)g.Bt + (size_t)nxt.pn * tstep : cB;
        for (int t = 0; t < nt; t += 2) {
            const bool last = (t == nt - 2);
            const char* a1 = cA + (size_t)(t + 1) * kstep;
            const char* a2 = last ? nA : cA + (size_t)(t + 2) * kstep; const char* b2 = last ? nB : cB + (size_t)(t + 2) * kstep;
            const char* a3 = a2 + kstep; const char* b3 = b2 + kstep;
            if (last && has_next) S.a_ready(nxt);
            PG8_LDB(B0, 0, 0); PG8_SCHED; PG8_LDA(At, 0, 0); PG8_STAGE(PG8_SA(1, 1), a1 + hstep, voffA);
            PG8_WAIT_L(8); PG8_BAR; PG8_WAIT_L(0); PG8_MMA(0, 0, At, B0); PG8_BAR; PG8_SCHED;
            PG8_LDB(B1, 0, 1); PG8_STAGE(PG8_SB(0, 0), b2, voffB);
            PG8_BAR; PG8_WAIT_L(0); PG8_MMA(0, 1, At, B1); PG8_BAR;
            PG8_LDA(At, 0, 1); PG8_STAGE(PG8_SA(0, 0), a2, voffA);
            PG8_BAR; PG8_WAIT_L(0); PG8_MMA(1, 0, At, B0); PG8_BAR; PG8_SCHED;
            PG8_STAGE(PG8_SB(0, 1), b2 + hstep, voffB);
            PG8_WAIT_V(6); PG8_BAR; PG8_MMA(1, 1, At, B1); PG8_BAR;
            PG8_LDB(B0, 1, 0); PG8_SCHED; PG8_LDA(At, 1, 0); PG8_STAGE(PG8_SA(0, 1), a2 + hstep, voffA);
            PG8_WAIT_L(8); PG8_BAR; PG8_WAIT_L(0); PG8_MMA(0, 0, At, B0); PG8_BAR; PG8_SCHED;
            PG8_LDB(B1, 1, 1); PG8_STAGE(PG8_SB(1, 0), b3, voffB);
            PG8_BAR; PG8_WAIT_L(0); PG8_MMA(0, 1, At, B1); PG8_BAR;
            PG8_LDA(At, 1, 1); PG8_STAGE(PG8_SA(1, 0), a3, voffA);
            PG8_BAR; PG8_WAIT_L(0); PG8_MMA(1, 0, At, B0); PG8_BAR; PG8_SCHED;
            PG8_STAGE(PG8_SB(1, 1), b3 + hstep, voffB);
            PG8_WAIT_V(6); PG8_BAR; PG8_MMA(1, 1, At, B1); PG8_BAR;
        }
        PG8_STAMP();
        if constexpr (!Epi::AFTER_DRAIN) { E(acc, cur, wr, wc, fr, fq); S.done(cur); }
        PG8_STAMP();
        if (!has_next) break;
#pragma unroll
        for (int a = 0; a < 2; ++a)
#pragma unroll
            for (int b = 0; b < 2; ++b)
#pragma unroll
                for (int m = 0; m < 4; ++m)
#pragma unroll
                    for (int n = 0; n < 2; ++n) acc[a][b][m][n] = (f32x4){0.f, 0.f, 0.f, 0.f};
        cur = nxt; cA = nA; cB = nB; ++ui;
    }
    PG8_WAIT_V(0);
    if (wr == 0) PG8_BAR;
    PG8_BAR;
    if constexpr (Epi::AFTER_DRAIN) { E.fused(acc, cur, wr, wc, fr, fq, lds, wid, lane); S.done(cur); }
    PG8_STAMP();
    if (STAMP && wid == 0) { stamps[lane] = lane < nts ? (((unsigned long long)(unsigned)ts_hi << 32) | (unsigned)ts_lo) : 0ull;
        if (lane == 62) stamps[62] = rt_entry; if (lane == 63) stamps[63] = (unsigned long long)wall_clock64(); }
#undef PG8_STAMP
#undef PG8_SA
#undef PG8_SB
#undef PG8_STAGE
#undef PG8_LDA
#undef PG8_LDB
#undef PG8_MMA
#undef PG8_WAIT_V
#undef PG8_WAIT_L
#undef PG8_BAR
#undef PG8_SCHED
}
}

namespace mk {
#define DI __device__ __forceinline__
#define LAS __attribute__((address_space(3)))
typedef unsigned short bf16_t;
typedef float f32x4 __attribute__((ext_vector_type(4)));
typedef float f32x2 __attribute__((ext_vector_type(2)));
typedef float f32x16 __attribute__((ext_vector_type(16)));
typedef short bf16x8 __attribute__((ext_vector_type(8)));
typedef short s16x4 __attribute__((ext_vector_type(4)));
typedef unsigned u32x4 __attribute__((ext_vector_type(4)));
typedef unsigned u32x2 __attribute__((ext_vector_type(2)));

constexpr int NB = 8, SEQ = 4096, T = NB * SEQ, DM = 1024, DEPTH = 4;
constexpr int INC = 2688, INCP = 2816;
constexpr int NEXP = 16384;
constexpr float NORM_EPS = 1e-6f;
constexpr int NWAVES = 8, NTHR = 512;

enum { I_X = 0, I_POS, I_NORM_MIX, I_W_IN, I_QN, I_KN, I_LAM, I_SUBLN, I_SLRE, I_SLIM, I_SBRE, I_SBIM, I_SCRE, I_SCIM, I_SD, I_SLOGDT,
       I_WGLU, I_BGLU, I_SONORM, I_MU, I_DECUP, I_DECW0, I_AAAUP, I_AAAA0, I_GATEUP, I_KK, I_KA, I_RK, I_LNW, I_LNB, I_WOUT, I_NORM_FFN,
       I_WQ, I_SUBK, I_PU, I_PV, N_IN };

constexpr size_t MiB = 1u << 20;
constexpr size_t WS_CTL = 0, CTL_BYTES = 1 * MiB;
constexpr size_t WS_WTIN = 1 * MiB;
constexpr size_t WS_WTOUT = WS_WTIN + 22 * MiB;
constexpr size_t WS_WTQ = WS_WTOUT + 8 * MiB;
constexpr size_t WS_WTGLU = WS_WTQ + 16 * MiB;
constexpr size_t WS_SUBK = WS_WTGLU + 1 * MiB;
constexpr size_t WS_ROPE = WS_SUBK + 2 * MiB;
constexpr size_t WS_SSMP = WS_ROPE + 2 * MiB;
constexpr size_t WS_U8 = WS_SSMP + 1 * MiB;
constexpr size_t WS_V8 = WS_U8 + 64 * MiB;
constexpr size_t WS_SU = WS_V8 + 64 * MiB;
constexpr size_t WS_SV = WS_SU + 1 * MiB;
constexpr size_t WS_H = WS_SV + 1 * MiB;
constexpr size_t WS_COLS = WS_H + 64 * MiB;
constexpr size_t WS_MIXED = WS_COLS + 176 * MiB;
constexpr size_t WS_X = WS_MIXED + 64 * MiB;
constexpr size_t WS_RW = WS_X;
constexpr size_t WS_RWW = WS_X + 96 * MiB;
constexpr size_t WS_PART = WS_X;
constexpr size_t WS_QP = WS_X, WS_IDX = WS_X + 128 * MiB, WS_GATE = WS_IDX + 16 * MiB, WS_COEF = WS_GATE + 16 * MiB;
constexpr size_t WS_YG = WS_X + 224 * MiB;
constexpr size_t WS_GLU = WS_YG + 16 * MiB;
constexpr size_t WS_RWY = WS_GLU + 32 * MiB;
constexpr size_t WS_RWC = WS_RWY + 32 * MiB;
constexpr size_t WS_RWS = WS_H;
constexpr size_t WS_H8 = WS_COLS;
constexpr size_t WS_END = WS_RWC + 192 * MiB;
static_assert(WS_END <= 1024 * MiB, "workspace map");
constexpr int SSMP_STRIDE = 2048 + 2 * 16 * 16 * 64;

constexpr int LDS_BYTES = 155648;
constexpr int MISC_OFF = LDS_BYTES - 256;

DI unsigned f2bf(float f) { unsigned u = __builtin_bit_cast(unsigned, f); return (u + 0x7fffu + ((u >> 16) & 1u)) >> 16; }
DI unsigned pk2(float lo, float hi) { return f2bf(lo) | (f2bf(hi) << 16); }
DI float bflo(unsigned w) { return __builtin_bit_cast(float, w << 16); }
DI float bfhi(unsigned w) { return __builtin_bit_cast(float, w & 0xffff0000u); }
DI float bf2f(bf16_t b) { return __builtin_bit_cast(float, ((unsigned)b) << 16); }
template <int CTRL> DI float dpp_f(float x) { return __builtin_bit_cast(float, __builtin_amdgcn_update_dpp(0, __builtin_bit_cast(int, x), CTRL, 0xF, 0xF, true)); }
DI float sum4(float x) { x += dpp_f<0xB1>(x); x += dpp_f<0x4E>(x); return x; }
DI float sum8(float x) { x = sum4(x); x += dpp_f<0x141>(x); return x; }
DI float sum16(float x) { x = sum8(x); x += dpp_f<0x140>(x); return x; }
DI float sum32(float x) { x = sum16(x); x += __builtin_bit_cast(float, __builtin_amdgcn_ds_swizzle(__builtin_bit_cast(int, x), 0x401F)); return x; }
DI float other_half(float x, int hi) { unsigned a = __builtin_bit_cast(unsigned, x), c = a; asm volatile("" : "+v"(c));
    auto r = __builtin_amdgcn_permlane32_swap(a, c, false, false);
    return __builtin_bit_cast(float, hi ? r[0] : r[1]); }
DI float sum_halves(float x, int hi) { return x + other_half(x, hi); }
DI float wave_sum(float v) { const float s = sum32(v);
    return __builtin_bit_cast(float, __builtin_amdgcn_readlane(__builtin_bit_cast(int, s), 0)) + __builtin_bit_cast(float, __builtin_amdgcn_readlane(__builtin_bit_cast(int, s), 32)); }
DI float wave_max(float v) {
    v = fmaxf(v, dpp_f<0xB1>(v)); v = fmaxf(v, dpp_f<0x4E>(v)); v = fmaxf(v, dpp_f<0x141>(v)); v = fmaxf(v, dpp_f<0x140>(v));
    v = fmaxf(v, __builtin_bit_cast(float, __builtin_amdgcn_ds_swizzle(__builtin_bit_cast(int, v), 0x401F)));
    return fmaxf(__builtin_bit_cast(float, __builtin_amdgcn_readlane(__builtin_bit_cast(int, v), 0)), __builtin_bit_cast(float, __builtin_amdgcn_readlane(__builtin_bit_cast(int, v), 32)));
}
DI float xor16(float v) { return __builtin_bit_cast(float, __builtin_amdgcn_ds_swizzle(__builtin_bit_cast(int, v), 0x401F)); }
DI float xor8(float v) { return dpp_f<0x128>(v); }
DI float sigmoidf_(float x) { return 1.f / (1.f + __expf(-x)); }
DI float gelu_erf(float x) { return 0.5f * x * (1.f + erff(x * 0.70710678118654752f)); }


DI void sincos_red(double r, double& s, double& c) {
    const double k = rint(r * 0.63661977236758134308); const double y = r - k * 1.57079632679489661923; const double y2 = y * y;
    double sp = -7.6471637318198164759e-13; sp = sp * y2 + 1.6059043836821614599e-10; sp = sp * y2 - 2.5052108385441718775e-8; sp = sp * y2 + 2.7557319223985890653e-6;
    sp = sp * y2 - 1.9841269841269841270e-4; sp = sp * y2 + 8.3333333333333333333e-3; sp = sp * y2 - 1.6666666666666666667e-1; const double sy = y + y * y2 * sp;
    double cp = 4.7794773323873852974e-14; cp = cp * y2 - 1.1470745597729724714e-11; cp = cp * y2 + 2.0876756987868098979e-9; cp = cp * y2 - 2.7557319223985890653e-7;
    cp = cp * y2 + 2.4801587301587301587e-5; cp = cp * y2 - 1.3888888888888888889e-3; cp = cp * y2 + 4.1666666666666666667e-2; cp = cp * y2 - 0.5; const double cy = 1.0 + y2 * cp;
    const int q = ((int)k) & 3;
    s = (q == 0) ? sy : (q == 1) ? cy : (q == 2) ? -sy : -cy;
    c = (q == 0) ? cy : (q == 1) ? -sy : (q == 2) ? -cy : sy;
}
#define XB_TMO      128
#define XB_XCNT(j)  (256  + 64 * (j))
#define XB_XSUB(j)  (1280 + 64 * (j))
#define XB_XGEN(j)  (2304 + 64 * (j))
#define XB_TOP      3328
#define XB_TOPGEN   3392
#define XCD_BAR_WORDS 3456
#define XB_SPIN_CAP (1u << 22)
DI unsigned xb_ld(unsigned* p)              { return __hip_atomic_load(p, __ATOMIC_RELAXED, __HIP_MEMORY_SCOPE_AGENT); }
DI unsigned xb_add(unsigned* p, unsigned v) { return __hip_atomic_fetch_add(p, v, __ATOMIC_RELAXED, __HIP_MEMORY_SCOPE_AGENT); }
DI unsigned xb_xcc_id() { return (unsigned)__builtin_amdgcn_s_getreg((3 << 11) | 20) & 0xFu; }
#define XB_SPIN(cond, bar) do { unsigned _sp = 0; while (cond) { __builtin_amdgcn_s_sleep(1); \
    if ((++_sp & 255u) == 0u) { if (xb_ld(&(bar)[XB_TMO])) break; if (_sp > XB_SPIN_CAP) { atomicAdd(&(bar)[XB_TMO], 1u); break; } } } } while (0)
struct XcdBarrier { unsigned* bar; unsigned x; volatile LAS unsigned* st; };
DI XcdBarrier xcd_barrier_post(unsigned* bar, volatile LAS unsigned* st) {
    XcdBarrier b; b.bar = bar; b.x = xb_xcc_id(); b.st = st;
    if (threadIdx.x == 0) (void)xb_add(&bar[XB_XCNT(b.x)], 1u);
    return b;
}
DI void xcd_barrier_complete(unsigned* bar, unsigned x, unsigned& nloc, unsigned& nx) {
    const unsigned G = gridDim.x * gridDim.y * gridDim.z;
    unsigned sum, cnt, mine, sp = 0u;
    for (;;) {
        sum = 0u; cnt = 0u; mine = 0u;
#pragma unroll
        for (unsigned j = 0; j < 16; ++j) { const unsigned c = xb_ld(&bar[XB_XCNT(j)]); sum += c; cnt += (c > 0u) ? 1u : 0u; mine = (j == x) ? c : mine; }
        if (sum == G) break;
        __builtin_amdgcn_s_sleep(1);
        if ((++sp & 255u) == 0u) { if (xb_ld(&bar[XB_TMO])) break; if (sp > XB_SPIN_CAP) { atomicAdd(&bar[XB_TMO], 1u); break; } }
    }
    nloc = mine > 0u ? mine : 1u; nx = cnt > 0u ? cnt : 1u;
}
DI void xcd_barrier(const XcdBarrier& b, int wave) {
    asm volatile("s_waitcnt vmcnt(0)" ::: "memory");
    __syncthreads();
    int ln_; asm volatile("v_mbcnt_lo_u32_b32 %0, -1, 0\n\tv_mbcnt_hi_u32_b32 %0, -1, %0" : "=v"(ln_));
    if (wave == 0 && ln_ == 0) {
        unsigned* bar = b.bar;
        __builtin_amdgcn_s_waitcnt(0);
        unsigned nloc = b.st[0], nx = b.st[1];
        if (nloc == 0u) { xcd_barrier_complete(bar, b.x, nloc, nx); b.st[0] = nloc; b.st[1] = nx; }
        const unsigned old = xb_add(&bar[XB_XSUB(b.x)], 1u);
        const unsigned gen = old / nloc;
        if (old + 1u == (gen + 1u) * nloc) {
            __builtin_amdgcn_fence(__ATOMIC_RELEASE, "agent");
            asm volatile("s_waitcnt vmcnt(0)" ::: "memory");
            const unsigned og = xb_add(&bar[XB_TOP], 1u);
            const unsigned tg = og / nx;
            if (og + 1u == (tg + 1u) * nx) xb_add(&bar[XB_TOPGEN], 1u);
            else XB_SPIN(xb_ld(&bar[XB_TOPGEN]) == tg, bar);
            __builtin_amdgcn_fence(__ATOMIC_ACQUIRE, "agent");
            xb_add(&bar[XB_XGEN(b.x)], 1u);
            asm volatile("s_waitcnt vmcnt(0)" ::: "memory");
        } else {
            XB_SPIN(xb_ld(&bar[XB_XGEN(b.x)]) == gen, bar);
            __builtin_amdgcn_fence(__ATOMIC_ACQUIRE, "agent");
            asm volatile("s_waitcnt vmcnt(0)" ::: "memory");
        }
    }
    __syncthreads();
}

struct Args { const void* in[N_IN]; float* out; unsigned char* ws; int ph_lo, ph_hi, bli, pad; };
struct Ctx {
    const void* const* in; float* out; unsigned char* ws; char* lds;
    int G, vcu, NGW, wave;
};
#define INF(i) ((const float*)C.in[i])
#define PHASE_IDS int lane_; asm volatile("v_mbcnt_lo_u32_b32 %0, -1, 0\n\tv_mbcnt_hi_u32_b32 %0, -1, %0" : "=v"(lane_)); const int P_lane = lane_, P_wave = C.wave, P_tid = C.wave * 64 + lane_, P_gw = C.vcu * NWAVES + C.wave; (void)P_tid; (void)P_lane; (void)P_gw; (void)P_wave;

DI void p0_transpose_item(const float* W, int K, int N, bf16_t* WT, float* scr, int item, int lane) {
    const int nblk = N / 32, kb = item / nblk, nb = item % nblk, k0 = 64 * kb, n0 = 32 * nb;
#pragma unroll 8
    for (int i = 0; i < 32; ++i) { const int kk = 2 * i + (lane >> 5); scr[kk * 33 + (lane & 31)] = W[(size_t)(k0 + kk) * N + n0 + (lane & 31)]; }
    asm volatile("s_waitcnt lgkmcnt(0)" ::: "memory");
    const int c = lane & 7;
#pragma unroll
    for (int j = 0; j < 4; ++j) { const int n = (lane >> 3) + 8 * j; const float* s = scr + (8 * c) * 33 + n;
        u32x4 o; o.x = pk2(s[0 * 33], s[1 * 33]); o.y = pk2(s[2 * 33], s[3 * 33]); o.z = pk2(s[4 * 33], s[5 * 33]); o.w = pk2(s[6 * 33], s[7 * 33]);
        *(u32x4*)(WT + (size_t)(n0 + n) * K + k0 + 8 * c) = o; }
    asm volatile("s_waitcnt lgkmcnt(0)" ::: "memory");
}
DI void phase_prologue(const Ctx& C) {
    PHASE_IDS
    float* scr = (float*)(C.lds + P_wave * 16384);
    constexpr int I_IN = 16 * (INC / 32), I_OUT = 16 * 32, I_Q = 16 * 64, I_G = 4 * 8, I_L = I_IN + I_OUT + I_Q + I_G;
    for (int it = P_gw; it < DEPTH * I_L; it += C.NGW) {
        const int l = it / I_L; int r = it % I_L;
        if (r < I_IN) { p0_transpose_item(INF(I_W_IN) + (size_t)l * DM * INC, DM, INC, (bf16_t*)(C.ws + WS_WTIN) + (size_t)l * INCP * DM, scr, r, P_lane); continue; } r -= I_IN;
        if (r < I_OUT) { p0_transpose_item(INF(I_WOUT) + (size_t)l * DM * DM, DM, DM, (bf16_t*)(C.ws + WS_WTOUT) + (size_t)l * DM * DM, scr, r, P_lane); continue; } r -= I_OUT;
        if (r < I_Q) { p0_transpose_item(INF(I_WQ) + (size_t)l * DM * 2048, DM, 2048, (bf16_t*)(C.ws + WS_WTQ) + (size_t)l * 2048 * DM, scr, r, P_lane); continue; } r -= I_Q;
        p0_transpose_item(INF(I_WGLU) + (size_t)l * 256 * 256, 256, 256, (bf16_t*)(C.ws + WS_WTGLU) + (size_t)l * 256 * 256, scr, r, P_lane);
    }
    const size_t gt = (size_t)blockIdx.x * NTHR + P_tid, NGT = (size_t)C.G * NTHR;
    for (size_t i = gt; i < (size_t)DEPTH * 16384; i += NGT) { const size_t l = i / 16384, o = i % 16384;
        *(u32x4*)(C.ws + WS_WTIN + (l * INCP * DM + (size_t)INC * DM) * 2 + o * 16) = (u32x4){0u, 0u, 0u, 0u}; }
    for (size_t i = gt; i < (size_t)DEPTH * 16 * 128 * 128 / 8; i += NGT) { const f32x4 a = ((const f32x4*)INF(I_SUBK))[2 * i], b = ((const f32x4*)INF(I_SUBK))[2 * i + 1];
        ((u32x4*)(C.ws + WS_SUBK))[i] = (u32x4){pk2(a.x, a.y), pk2(a.z, a.w), pk2(b.x, b.y), pk2(b.z, b.w)}; }
    for (int row = P_gw; row < 2 * DEPTH * NEXP; row += 2 * C.NGW) {
        const int row2 = row + C.NGW; const bool has2 = row2 < 2 * DEPTH * NEXP;
        const int tab = row >= DEPTH * NEXP, r = tab ? row - DEPTH * NEXP : row;
        const int tab2 = row2 >= DEPTH * NEXP, r2 = has2 ? (tab2 ? row2 - DEPTH * NEXP : row2) : r;
        const f32x4* src = (const f32x4*)((tab ? INF(I_PV) : INF(I_PU)) + (size_t)r * DM);
        const f32x4* src2 = (const f32x4*)(((has2 ? tab2 : tab) ? INF(I_PV) : INF(I_PU)) + (size_t)r2 * DM);
        f32x4 v[4], v2[4]; float am = 0.f, am2 = 0.f;
#pragma unroll
        for (int j = 0; j < 4; ++j) v[j] = __builtin_nontemporal_load(src + P_lane + 64 * j);
#pragma unroll
        for (int j = 0; j < 4; ++j) v2[j] = __builtin_nontemporal_load(src2 + P_lane + 64 * j);
#pragma unroll
        for (int j = 0; j < 4; ++j) { am = fmaxf(fmaxf(am, fmaxf(fabsf(v[j].x), fabsf(v[j].y))), fmaxf(fabsf(v[j].z), fabsf(v[j].w))); am2 = fmaxf(fmaxf(am2, fmaxf(fabsf(v2[j].x), fabsf(v2[j].y))), fmaxf(fabsf(v2[j].z), fabsf(v2[j].w))); }
        am = wave_max(am); am2 = wave_max(am2);
        { const float sc = am > 0.f ? 440.f / am : 1.f;
          unsigned* dst = (unsigned*)(C.ws + (tab ? WS_V8 : WS_U8)) + (size_t)r * 256;
#pragma unroll
          for (int j = 0; j < 4; ++j) { int w = __builtin_amdgcn_cvt_pk_fp8_f32(v[j].x * sc, v[j].y * sc, 0, false); w = __builtin_amdgcn_cvt_pk_fp8_f32(v[j].z * sc, v[j].w * sc, w, true); dst[P_lane + 64 * j] = (unsigned)w; }
          if (P_lane == 0) ((float*)(C.ws + (tab ? WS_SV : WS_SU)))[r] = am > 0.f ? am / 440.f : 1.f; }
        if (has2) { const float sc = am2 > 0.f ? 440.f / am2 : 1.f;
          unsigned* dst = (unsigned*)(C.ws + (tab2 ? WS_V8 : WS_U8)) + (size_t)r2 * 256;
#pragma unroll
          for (int j = 0; j < 4; ++j) { int w = __builtin_amdgcn_cvt_pk_fp8_f32(v2[j].x * sc, v2[j].y * sc, 0, false); w = __builtin_amdgcn_cvt_pk_fp8_f32(v2[j].z * sc, v2[j].w * sc, w, true); dst[P_lane + 64 * j] = (unsigned)w; }
          if (P_lane == 0) ((float*)(C.ws + (tab2 ? WS_SV : WS_SU)))[r2] = am2 > 0.f ? am2 / 440.f : 1.f; }
    }
    for (size_t i = gt; i < (size_t)T * 8; i += NGT) { const int t = (int)(i >> 3), j = (int)(i & 7);
        const double invf = exp(-(double)j * 0.125 * log(500000.0));
        const double ang = (double)((const int*)C.in[I_POS])[t] * invf;
        const double red = ang - 6.283185307179586476925 * rint(ang * 0.15915494309189533577);
        float* o = (float*)(C.ws + WS_ROPE) + (size_t)t * 16;
        double sn, cn; sincos_red(red, sn, cn); o[j] = (float)cn; o[8 + j] = (float)sn; }
    for (size_t i = gt; i < (size_t)DEPTH * 1024; i += NGT) { const int l = (int)(i >> 10), gp = (int)(i & 1023), g = gp >> 6, p = gp & 63;
        const double lr = fmin((double)INF(I_SLRE)[l * 1024 + gp], -1e-4), li = (double)INF(I_SLIM)[l * 1024 + gp];
        const double step = exp((double)INF(I_SLOGDT)[l * 16 + g]);
        const double mag = exp(lr * step); double ph = li * step; ph -= 6.283185307179586476925 * rint(ph * 0.15915494309189533577);
        double sn, cn; sincos_red(ph, sn, cn); const double are = mag * cn, aim = mag * sn;
        const double den = lr * lr + li * li;
        const double cre = ((are - 1.0) * lr + aim * li) / den, cim = (aim * lr - (are - 1.0) * li) / den;
        float* P = (float*)(C.ws + WS_SSMP) + (size_t)l * SSMP_STRIDE;
        P[gp] = (float)are; P[1024 + gp] = (float)aim;
        for (int h = 0; h < 16; ++h) { const double br = (double)INF(I_SBRE)[((size_t)l * 1024 + gp) * 16 + h], bi = (double)INF(I_SBIM)[((size_t)l * 1024 + gp) * 16 + h];
            P[2048 + (g * 16 + h) * 64 + p] = (float)(cre * br - cim * bi);
            P[2048 + 16384 + (g * 16 + h) * 64 + p] = (float)(cre * bi + cim * br); } }
}

template <bool FP8IMG> DI void phase_rmsnorm(const Ctx& C, const float* src, const float* gain, bf16_t* dst) {
    PHASE_IDS
    f32x4 g[4];
#pragma unroll
    for (int j = 0; j < 4; ++j) g[j] = ((const f32x4*)gain)[P_lane + 64 * j];
    f32x4 vn[4];
    if (P_gw < T) { const f32x4* xr = (const f32x4*)(src + (size_t)P_gw * DM) + P_lane;
#pragma unroll
        for (int j = 0; j < 4; ++j) vn[j] = xr[64 * j]; }
    for (int m = P_gw; m < T; m += C.NGW) {
        f32x4 v[4]; float s = 0.f;
#pragma unroll
        for (int j = 0; j < 4; ++j) { v[j] = vn[j]; s += (v[j].x * v[j].x + v[j].y * v[j].y) + (v[j].z * v[j].z + v[j].w * v[j].w); }
        { const int mn = m + C.NGW < T ? m + C.NGW : m; const f32x4* xr = (const f32x4*)(src + (size_t)mn * DM) + P_lane;
#pragma unroll
          for (int j = 0; j < 4; ++j) vn[j] = xr[64 * j]; }
        const float rs = 1.f / sqrtf(wave_sum(s) * (1.f / DM) + NORM_EPS);
        u32x2* o8 = (u32x2*)(dst + (size_t)m * DM) + P_lane;
#pragma unroll
        for (int j = 0; j < 4; ++j) { const f32x4 y = {v[j].x * rs * g[j].x, v[j].y * rs * g[j].y, v[j].z * rs * g[j].z, v[j].w * rs * g[j].w};
            o8[64 * j] = (u32x2){pk2(y.x, y.y), pk2(y.z, y.w)};
            if (FP8IMG) {
                f32x4 ys = y * 16.f; ys.x = fminf(fmaxf(ys.x, -440.f), 440.f); ys.y = fminf(fmaxf(ys.y, -440.f), 440.f); ys.z = fminf(fmaxf(ys.z, -440.f), 440.f); ys.w = fminf(fmaxf(ys.w, -440.f), 440.f);
                int wh = __builtin_amdgcn_cvt_pk_fp8_f32(ys.x, ys.y, 0, false); wh = __builtin_amdgcn_cvt_pk_fp8_f32(ys.z, ys.w, wh, true);
                const f32x2 h01 = __builtin_amdgcn_cvt_pk_f32_fp8(wh, false), h23 = __builtin_amdgcn_cvt_pk_f32_fp8(wh, true);
                int wl_ = __builtin_amdgcn_cvt_pk_fp8_f32((ys.x - h01.x) * 16.f, (ys.y - h01.y) * 16.f, 0, false); wl_ = __builtin_amdgcn_cvt_pk_fp8_f32((ys.z - h23.x) * 16.f, (ys.w - h23.y) * 16.f, wl_, true);
                unsigned* h8 = (unsigned*)(C.ws + WS_H8 + (size_t)m * 2048) + P_lane + 64 * j; h8[0] = (unsigned)wh; h8[256] = (unsigned)wl_; } }
    }
}

DI void phase_prep(const Ctx& C, int l) {
    PHASE_IDS
    bf16_t* cols = (bf16_t*)(C.ws + WS_COLS);
    {
        float* Wd = (float*)C.lds; float* Wa = Wd + 32 * 256; float* Wg = Wa + 32 * 256; float* lr = Wg + 64 * 256;
        const float* gd = INF(I_DECUP) + (size_t)l * 32 * 256; const float* ga = INF(I_AAAUP) + (size_t)l * 32 * 256; const float* gg = INF(I_GATEUP) + (size_t)l * 64 * 256;
        for (int i = P_tid; i < 32 * 256 / 4; i += NTHR) { ((f32x4*)Wd)[i] = ((const f32x4*)gd)[i]; ((f32x4*)Wa)[i] = ((const f32x4*)ga)[i]; }
        for (int i = P_tid; i < 64 * 256 / 4; i += NTHR) ((f32x4*)Wg)[i] = ((const f32x4*)gg)[i];
        const float* mu = INF(I_MU) + (size_t)l * 896;
        const int hh = P_tid >> 8, j = P_tid & 255;
        const float w0 = INF(I_DECW0)[l * 256 + j], a0 = INF(I_AAAA0)[l * 256 + j], kkw = INF(I_KK)[l * 256 + j], kaw = INF(I_KA)[l * 256 + j];
        const float mur = mu[j], muk = mu[256 + j], muv = mu[512 + j];
        bf16_t* RWB = (bf16_t*)(C.ws + WS_RW); float* RWW = (float*)(C.ws + WS_RWW);
        for (int tile = C.vcu; tile < T / 16; tile += C.G) {
            const int t0 = tile * 16;
            __syncthreads();
#pragma unroll
            for (int i = 0; i < 4; ++i) { const int v = P_tid + NTHR * i, tt = v >> 7, c = v & 127, t = t0 + tt;
                const float cur = bf2f(cols[(size_t)t * INCP + 1792 + 768 + c]);
                const float prev = (t % SEQ) ? bf2f(cols[(size_t)(t - 1) * INCP + 1792 + 768 + c]) : 0.f;
                const float x = cur + (prev - cur) * mu[768 + c];
                lr[tt * 128 + (c < 32 ? 2 * c : (c < 64 ? 2 * (c - 32) + 1 : c))] = c < 32 ? tanhf(x) : (c < 64 ? x : sigmoidf_(x)); }
            __syncthreads();
#pragma unroll 1
            for (int pass = 0; pass < 2; ++pass) {
                const int tb = hh * 8 + pass * 4;
                float aw[4], aa[4], ag[4];
                float rc[4], kc[4], vc[4], rpv[4], kpv[4], vpv[4];
#pragma unroll
                for (int q = 0; q < 4; ++q) { const int t = t0 + tb + q; const bool first = (t % SEQ) == 0;
                    const bf16_t* cr = cols + (size_t)t * INCP + 1792; const bf16_t* pr = first ? cr : cr - INCP;
                    rc[q] = bf2f(cr[j]); kc[q] = bf2f(cr[256 + j]); vc[q] = bf2f(cr[512 + j]);
                    rpv[q] = bf2f(pr[j]); kpv[q] = bf2f(pr[256 + j]); vpv[q] = bf2f(pr[512 + j]); }
                { f32x2 awa[4], ag2[4];
#pragma unroll
                  for (int q = 0; q < 4; ++q) { awa[q] = (f32x2){0.f, 0.f}; ag2[q] = (f32x2){0.f, 0.f}; }
#pragma unroll 4
                  for (int i = 0; i < 32; ++i) { const f32x2 w2 = {Wd[i * 256 + j], Wa[i * 256 + j]};
#pragma unroll
                      for (int q = 0; q < 4; ++q) awa[q] += *(const f32x2*)(lr + (tb + q) * 128 + 2 * i) * w2; }
#pragma unroll 2
                  for (int i = 0; i < 64; i += 2) { const f32x2 w2 = {Wg[i * 256 + j], Wg[(i + 1) * 256 + j]};
#pragma unroll
                      for (int q = 0; q < 4; ++q) ag2[q] += *(const f32x2*)(lr + (tb + q) * 128 + 64 + i) * w2; }
#pragma unroll
                  for (int q = 0; q < 4; ++q) { aw[q] = awa[q].x; aa[q] = awa[q].y; ag[q] = ag2[q].x + ag2[q].y; } }
#pragma unroll
                for (int q = 0; q < 4; ++q) { const int t = t0 + tb + q; const bool first = (t % SEQ) == 0;
                    float r = rc[q], k = kc[q], v = vc[q];
                    const float rp = first ? 0.f : rpv[q], kp = first ? 0.f : kpv[q], vp = first ? 0.f : vpv[q];
                    r += (rp - r) * mur; k += (kp - k) * muk; v += (vp - v) * muv;
                    const float sg = sigmoidf_(w0 + aw[q]); const float decay = __expf(-0.60653065971263342f * sg);
                    const float a = sigmoidf_(a0 + aa[q]);
                    float kk = k * kkw; const float ss = wave_sum(kk * kk); kk = kk / fmaxf(sqrtf(ss), 1e-12f);
                    const float k2 = k * (1.f + (a - 1.f) * kaw);
                    bf16_t* o = RWB + (size_t)t * 1536 + j;
                    o[0] = (bf16_t)f2bf(r); o[256] = (bf16_t)f2bf(k2); o[512] = (bf16_t)f2bf(v); o[768] = (bf16_t)f2bf(kk); o[1024] = (bf16_t)f2bf(kk * a); o[1280] = (bf16_t)f2bf(ag[q]); RWW[(size_t)t * 256 + j] = decay; __builtin_amdgcn_sched_barrier(0); }
            }
        }
        __syncthreads();
    }
    {
        const int v16 = P_lane >> 2, qt = P_lane & 3, part = v16 >> 3, vec = v16 & 7;
        float gn[16];
#pragma unroll
        for (int i = 0; i < 16; ++i) gn[i] = (part == 0 ? INF(I_QN) : INF(I_KN))[l * 512 + vec * 64 + qt * 16 + i];
        const float qscale = part == 0 ? 0.18033688011112042f : 1.f;
        const float* rope = (const float*)(C.ws + WS_ROPE);
        for (int t = P_gw; t < T; t += C.NGW) {
            float cs[16];
#pragma unroll
            for (int i = 0; i < 4; ++i) { const f32x4 v = ((const f32x4*)(rope + (size_t)t * 16))[i]; cs[4 * i] = v.x; cs[4 * i + 1] = v.y; cs[4 * i + 2] = v.z; cs[4 * i + 3] = v.w; }
            bf16_t* p = cols + (size_t)t * INCP + v16 * 64 + qt * 16;
            const u32x4 w0 = ((const u32x4*)p)[0], w1 = ((const u32x4*)p)[1];
            float x[16];
            x[0] = bflo(w0.x); x[1] = bfhi(w0.x); x[2] = bflo(w0.y); x[3] = bfhi(w0.y); x[4] = bflo(w0.z); x[5] = bfhi(w0.z); x[6] = bflo(w0.w); x[7] = bfhi(w0.w);
            x[8] = bflo(w1.x); x[9] = bfhi(w1.x); x[10] = bflo(w1.y); x[11] = bfhi(w1.y); x[12] = bflo(w1.z); x[13] = bfhi(w1.z); x[14] = bflo(w1.w); x[15] = bfhi(w1.w);
            float ss = 0.f;
#pragma unroll
            for (int i = 0; i < 16; ++i) ss += x[i] * x[i];
            ss = sum4(ss);
            const float rs = qscale / sqrtf(ss * (1.f / 64.f) + NORM_EPS);
#pragma unroll
            for (int i = 0; i < 16; ++i) x[i] = x[i] * rs * gn[i];
            if (qt == 0) {
#pragma unroll
                for (int i = 0; i < 8; ++i) { const float r1 = x[i], r2 = x[8 + i]; x[i] = r1 * cs[i] - r2 * cs[8 + i]; x[8 + i] = r2 * cs[i] + r1 * cs[8 + i]; }
            }
            ((u32x4*)p)[0] = (u32x4){pk2(x[0], x[1]), pk2(x[2], x[3]), pk2(x[4], x[5]), pk2(x[6], x[7])};
            ((u32x4*)p)[1] = (u32x4){pk2(x[8], x[9]), pk2(x[10], x[11]), pk2(x[12], x[13]), pk2(x[14], x[15])};
        }
    }
}

typedef short v4i16_t __attribute__((ext_vector_type(4)));
DI s16x4 tr_read(const char* p) { return __builtin_bit_cast(s16x4, __builtin_amdgcn_ds_read_tr16_b64_v4i16((LAS v4i16_t*)p)); }
typedef __bf16 bf16x2_t __attribute__((ext_vector_type(2)));
DI unsigned cvtpk(float lo, float hi) { f32x2 v = {lo, hi}; bf16x2_t b = __builtin_convertvector(v, bf16x2_t); return __builtin_bit_cast(unsigned, b); }
DI int crow(int r, int hi) { return (r & 3) + 8 * (r >> 2) + 4 * hi; }
DI bf16x8 pack8(const f32x16& p, int b) { u32x4 w = {cvtpk(p[b], p[b + 1]), cvtpk(p[b + 2], p[b + 3]), cvtpk(p[b + 4], p[b + 5]), cvtpk(p[b + 6], p[b + 7])}; return __builtin_bit_cast(bf16x8, w); }
constexpr int AT_K = 0, AT_V = 16384, AT_BUF = 32768, AT_X = 65536, AT_W = 131072;

DI void attn_unit(const Ctx& C, int l, int b, int h, int qb, float lam_full, float lam_init) {
    PHASE_IDS
    const bf16_t* cols = (const bf16_t*)(C.ws + WS_COLS);
    char* lds = C.lds;
    const int tid = P_tid, lane = P_lane, wid = P_wave, r32 = lane & 31, hi = lane >> 5, m = wid >> 2, sub = wid & 3;
    const size_t tb = (size_t)b * SEQ;
    const size_t qrow = tb + qb * 128 + sub * 32 + r32;
    bf16x8 qr[4];
#pragma unroll
    for (int d0 = 0; d0 < 4; ++d0) qr[d0] = *(const bf16x8*)(cols + qrow * INCP + h * 128 + m * 64 + d0 * 16 + hi * 8);
    f32x16 o[4];
#pragma unroll
    for (int i = 0; i < 4; ++i)
#pragma unroll
        for (int r = 0; r < 16; ++r) o[i][r] = 0.f;
    float lsum = 0.f;
    const int nt = 2 * qb + 2, my_nt = 2 * qb + 1 + (sub >> 1);
    const int q4 = (lane & 15) >> 2, p4 = lane & 3, blk16 = (lane >> 4) & 1;
    unsigned goK[2], goV[2], loK[2], loV[2];
#pragma unroll
    for (int i = 0; i < 2; ++i) { const int c = tid + NTHR * i, mm = c >> 9, row = (c >> 3) & 63, ch = c & 7;
        goK[i] = (unsigned)((row * INCP + 512 + mm * 64 + ch * 8) * 2); loK[i] = (unsigned)(AT_K + mm * 8192 + row * 128 + 16 * (ch ^ ((row >> 1) & 7))); }
#pragma unroll
    for (int i = 0; i < 2; ++i) { const int c = tid + NTHR * i, row = c >> 4, ch = c & 15;
        goV[i] = (unsigned)((row * INCP + 1024 + ch * 8) * 2); loV[i] = (unsigned)(AT_V + row * 256 + 16 * (ch ^ (((row & 3) << 2) | ((row >> 2) & 3)))); }
    unsigned vo[8];
#pragma unroll
    for (int k = 0; k < 8; ++k) { const int db_ = k >> 1, rr_ = 4 * hi + q4 + 8 * (k & 1), ch_ = 4 * db_ + 2 * blk16 + (p4 >> 1);
        vo[k] = (unsigned)(rr_ * 256 + 16 * (ch_ ^ (((rr_ & 3) << 2) | ((rr_ >> 2) & 3))) + 8 * (p4 & 1)); }
    const unsigned lds32 = (unsigned)(size_t)(LAS char*)lds;
    u32x4 kreg[2], vreg[2];
    { const char* tbase = (const char*)(cols + tb * INCP + h * 128);
#pragma unroll
      for (int i = 0; i < 2; ++i) { kreg[i] = *(const u32x4*)(tbase + goK[i]); vreg[i] = *(const u32x4*)(tbase + goV[i]); } }
    __syncthreads();
    for (int kt = 0; kt < nt; ++kt) {
        char* ldb = lds + (kt & 1) * AT_BUF;
#pragma unroll
        for (int i = 0; i < 2; ++i) { *(u32x4*)(ldb + loK[i]) = kreg[i]; *(u32x4*)(ldb + loV[i]) = vreg[i]; }
        if (kt + 1 < nt) { const char* tbase = (const char*)(cols + (tb + (kt + 1) * 64) * INCP + h * 128);
#pragma unroll
            for (int i = 0; i < 2; ++i) { kreg[i] = *(const u32x4*)(tbase + goK[i]); vreg[i] = *(const u32x4*)(tbase + goV[i]); } }
        __syncthreads();
        if (kt < my_nt) {
            bf16x8 kf[8];
#pragma unroll
            for (int d0 = 0; d0 < 4; ++d0) { const char* kp = ldb + AT_K + m * 8192 + r32 * 128 + 16 * ((2 * d0 + hi) ^ ((r32 >> 1) & 7)); kf[2 * d0] = *(const bf16x8*)kp; kf[2 * d0 + 1] = *(const bf16x8*)(kp + 4096); }
            __builtin_amdgcn_sched_barrier(0);
            f32x16 p0, p1;
#pragma unroll
            for (int r = 0; r < 16; ++r) { p0[r] = 0.f; p1[r] = 0.f; }
#pragma unroll
            for (int d0 = 0; d0 < 4; ++d0) { p0 = __builtin_amdgcn_mfma_f32_32x32x16_bf16(kf[2 * d0], qr[d0], p0, 0, 0, 0); p1 = __builtin_amdgcn_mfma_f32_32x32x16_bf16(kf[2 * d0 + 1], qr[d0], p1, 0, 0, 0); }
#define AT_TR(p_) __builtin_bit_cast(s16x4, __builtin_amdgcn_ds_read_tr16_b64_v4i16((LAS v4i16_t*)(p_)))
#define AT_VFRAG(db, s4) ({ const s16x4 lo_ = AT_TR(vp[2 * (db)] + 256 * (32 * ((s4) >> 1) + 16 * ((s4) & 1))); const s16x4 hh_ = AT_TR(vp[2 * (db) + 1] + 256 * (32 * ((s4) >> 1) + 16 * ((s4) & 1))); \
                (bf16x8)__builtin_shufflevector(lo_, hh_, 0, 1, 2, 3, 4, 5, 6, 7); })
            LAS char* vp[8];
#pragma unroll
            for (int k = 0; k < 8; ++k) { unsigned a_ = lds32 + (unsigned)((kt & 1) * AT_BUF + AT_V) + vo[k]; asm volatile("" : "+v"(a_)); vp[k] = (LAS char*)(size_t)a_; }
            bf16x8 va[8];
#pragma unroll
            for (int i = 0; i < 8; ++i) va[i] = AT_VFRAG(i >> 1, i & 1);
            __builtin_amdgcn_sched_barrier(0);
            float s = 0.f;
#pragma unroll
            for (int r = 0; r < 8; ++r) { p0[r] = __builtin_amdgcn_exp2f(p0[r]); s += p0[r]; }
            bf16x8 pa[4]; pa[0] = pack8(p0, 0);
            __builtin_amdgcn_sched_barrier(0);
            bf16x8 vb[8];
#pragma unroll
            for (int i = 0; i < 8; ++i) vb[i] = AT_VFRAG(i >> 1, 2 + (i & 1));
            __builtin_amdgcn_sched_barrier(0);
#pragma unroll
            for (int j = 0; j < 16; ++j) { const int q = j >> 2, db = j & 3;
                o[db] = __builtin_amdgcn_mfma_f32_32x32x16_bf16(pa[q], q < 2 ? va[2 * db + (q & 1)] : vb[2 * db + (q & 1)], o[db], 0, 0, 0);
                if (j < 12) { const int i0 = 8 * ((q + 1) & 1) + 2 * db;
                    float e0 = __builtin_amdgcn_exp2f(q == 0 ? p0[i0] : p1[i0]), e1 = __builtin_amdgcn_exp2f(q == 0 ? p0[i0 + 1] : p1[i0 + 1]);
                    s += e0 + e1;
                    asm volatile("" : "+v"(e0), "+v"(e1), "+v"(s));
                    if (q == 0) { p0[i0] = e0; p0[i0 + 1] = e1; } else { p1[i0] = e0; p1[i0 + 1] = e1; }
                    if (db == 3) pa[q + 1] = q == 0 ? pack8(p0, 8) : (q == 1 ? pack8(p1, 0) : pack8(p1, 8)); }
                __builtin_amdgcn_sched_barrier(0); }
            lsum += s;
#undef AT_VFRAG
#undef AT_TR
        }
    }
    float* wsf = (float*)(lds + AT_W) + wid * 64;
    const float lt = sum_halves(lsum, hi);
    if (hi == 0) wsf[r32] = 1.f / lt;
    __syncthreads();
#pragma unroll
    for (int r = 0; r < 16; ++r) { const float rl = wsf[crow(r, hi)];
#pragma unroll
        for (int db = 0; db < 4; ++db) o[db][r] *= rl; }
    float* xch = (float*)(lds + AT_X) + sub * 4096;
    if (m == 1) {
#pragma unroll
        for (int r = 0; r < 16; ++r)
#pragma unroll
            for (int db = 0; db < 4; ++db) xch[crow(r, hi) * 128 + db * 32 + r32] = o[db][r];
    }
    __syncthreads();
    if (m == 0) {
        const float* subln = INF(I_SUBLN) + l * 128;
        float g[4];
#pragma unroll
        for (int db = 0; db < 4; ++db) g[db] = subln[db * 32 + r32] * (1.f - lam_init);
        bf16_t* mixed = (bf16_t*)(C.ws + WS_MIXED);
#pragma unroll
        for (int r = 0; r < 16; ++r) {
            float ss = 0.f;
#pragma unroll
            for (int db = 0; db < 4; ++db) { o[db][r] -= lam_full * xch[crow(r, hi) * 128 + db * 32 + r32]; ss += o[db][r] * o[db][r]; }
            ss = sum32(ss);
            const float rs = 1.f / sqrtf(ss * (1.f / 128.f) + NORM_EPS);
            bf16_t* orow = mixed + (tb + qb * 128 + sub * 32 + crow(r, hi)) * DM + h * 128;
#pragma unroll
            for (int db = 0; db < 4; ++db) orow[db * 32 + r32] = (bf16_t)f2bf(o[db][r] * rs * g[db]);
        }
    }
}
DI void attn_lambda(const Ctx& C, int l, int lane, float& lam_full, float& lam_init) {
    const float* lf = INF(I_LAM) + l * 256;
    const float la = wave_sum(lf[lane] * lf[64 + lane]), lb = wave_sum(lf[128 + lane] * lf[192 + lane]);
    lam_init = 0.8f - 0.6f * expf(-0.3f * (float)l);
    lam_full = expf(la) - expf(lb) + lam_init;
}
DI void phase_attn(const Ctx& C, int l, int w0, int nw) {
    PHASE_IDS
    float lam_full, lam_init; attn_lambda(C, l, P_lane, lam_full, lam_init);
    if (nw == 256) {
        for (int u = C.vcu - w0; u < 1024; u += nw) {
            const int bh = (u & 255) >> 3, s = u & 7, i = u >> 8;
            const int qb = (i == 0) ? s : (i == 1) ? 15 - s : (i == 2) ? 16 + s : 31 - s;
            attn_unit(C, l, bh >> 2, bh & 3, qb, lam_full, lam_init);
        }
    } else {
        for (int u = C.vcu - w0; u < 1024; u += nw) { const int qb = 31 - (u >> 5), bh = u & 31; attn_unit(C, l, bh >> 2, bh & 3, qb, lam_full, lam_init); }
    }
    __syncthreads();
}
DI int attn_queue_qb(int which, int k) { return which == 0 ? (k < 7 ? 31 - k : 7 - 2 * (k - 7)) : (k < 17 ? 24 - k : 6 - 2 * (k - 17)); }
DI void phase_attn_queue(const Ctx& C, int l, int which) {
    PHASE_IDS
    float lam_full, lam_init; attn_lambda(C, l, P_lane, lam_full, lam_init);
    unsigned* ticket = (unsigned*)(C.ws + WS_CTL) + 1024 + (l * 2 + which) * 64;
    volatile int* slot = (volatile int*)(C.lds + MISC_OFF + 64);
    const int count = (which == 0 ? 11 : 21) * 32;
    for (;;) {
        __syncthreads();
        if (P_tid == 0) *slot = (int)__hip_atomic_fetch_add(ticket, 1u, __ATOMIC_RELAXED, __HIP_MEMORY_SCOPE_AGENT);
        __syncthreads();
        const int u = __builtin_amdgcn_readfirstlane(*slot);
        if (u >= count) break;
        const int qb = attn_queue_qb(which, u >> 5), bh = u & 31;
        attn_unit(C, l, bh >> 2, bh & 3, qb, lam_full, lam_init);
    }
    __syncthreads();
}

DI void phase_ssm(const Ctx& C, int l, int w0, int nw) {
    PHASE_IDS
    float* L = (float*)C.lds;
    float* Uu = L;
    float* Tt = L + 2048;
    bf16_t* X2 = (bf16_t*)(L + 3072);
    bf16_t* C2 = X2 + 64 * 136;
    const bf16_t* cols = (const bf16_t*)(C.ws + WS_COLS);
    bf16_t* yg = (bf16_t*)(C.ws + WS_YG);
    const float* P = (const float*)(C.ws + WS_SSMP) + (size_t)l * SSMP_STRIDE;
    const int tid = P_tid, lane = P_lane, w = P_wave;
    for (int u = C.vcu - w0; u < 128; u += nw) {
        const int b = u >> 4, g = u & 15;
        const int p1 = tid & 63;
        f32x2 bb[16];
        { const float* pbr = P + 2048 + g * 1024 + p1; const float* pbi = pbr + 16384;
#pragma unroll
          for (int h = 0; h < 16; ++h) { bb[h].x = pbr[h * 64]; bb[h].y = pbi[h * 64]; } }
        const float a1r = P[g * 64 + p1], a1i = P[1024 + g * 64 + p1];
        float a8r, a8i;
        { double xr = (double)a1r, xi = (double)a1i;
#pragma unroll
          for (int k = 0; k < 3; ++k) { const double nr = xr * xr - xi * xi, ni = 2.0 * xr * xi; xr = nr; xi = ni; }
          a8r = (float)xr; a8i = (float)xi; }
        float xpr = 0.f, xpi = 0.f;
        __syncthreads();
        for (int i = tid; i < 16 * 128; i += NTHR) { const int h = i >> 7, k = i & 127;
            const float v = k < 64 ? INF(I_SCRE)[((size_t)l * 256 + g * 16 + h) * 64 + k] : -INF(I_SCIM)[((size_t)l * 256 + g * 16 + h) * 64 + k - 64]; C2[h * 136 + k] = (bf16_t)f2bf(v); }
        const float dsk = INF(I_SD)[l * 256 + g * 16 + (lane & 15)];
        const size_t tb = (size_t)b * SEQ;
        { const unsigned v = *(const unsigned*)(cols + (tb + (tid >> 3)) * INCP + 1536 + g * 16 + 2 * (tid & 7)); Uu[(tid >> 3) * 16 + 2 * (tid & 7)] = bflo(v); Uu[(tid >> 3) * 16 + 2 * (tid & 7) + 1] = bfhi(v); }
        __syncthreads();
        for (int ck = 0; ck < 64; ++ck) {
            const float* Uc = Uu + (ck & 1) * 1024; float* Un = Uu + ((ck + 1) & 1) * 1024;
            unsigned unext = 0u;
            if (ck + 1 < 64) unext = *(const unsigned*)(cols + (tb + (ck + 1) * 64 + (tid >> 3)) * INCP + 1536 + g * 16 + 2 * (tid & 7));
            float xlr[8], xli[8]; float cr = 0.f, ci = 0.f;
#pragma unroll
            for (int q = 0; q < 8; ++q) { const int t = 8 * w + q; const f32x4 u0 = *(const f32x4*)(Uc + t * 16), u1 = *(const f32x4*)(Uc + t * 16 + 4), u2 = *(const f32x4*)(Uc + t * 16 + 8), u3 = *(const f32x4*)(Uc + t * 16 + 12);
                f32x2 s = bb[0] * u0.x, s1 = bb[1] * u0.y, s2 = bb[2] * u0.z, s3 = bb[3] * u0.w;
                s += bb[4] * u1.x; s1 += bb[5] * u1.y; s2 += bb[6] * u1.z; s3 += bb[7] * u1.w;
                s += bb[8] * u2.x; s1 += bb[9] * u2.y; s2 += bb[10] * u2.z; s3 += bb[11] * u2.w; s += bb[12] * u3.x; s1 += bb[13] * u3.y; s2 += bb[14] * u3.z; s3 += bb[15] * u3.w;
                s = (s + s1) + (s2 + s3);
                const float nr = a1r * cr - a1i * ci + s.x, ni = a1r * ci + a1i * cr + s.y; cr = nr; ci = ni; xlr[q] = nr; xli[q] = ni; }
            { f32x2 tv; tv.x = cr; tv.y = ci; *(f32x2*)(Tt + (w * 64 + p1) * 2) = tv; }
            __syncthreads();
            Un[(tid >> 3) * 16 + 2 * (tid & 7)] = bflo(unext); Un[(tid >> 3) * 16 + 2 * (tid & 7) + 1] = bfhi(unext);
            { float kr = xpr, ki = xpi, inr = 0.f, ini = 0.f;
#pragma unroll
              for (int k = 0; k < 8; ++k) { if (k == w) { inr = kr; ini = ki; } const f32x2 tv = *(const f32x2*)(Tt + (k * 64 + p1) * 2);
                  const float nr = a8r * kr - a8i * ki + tv.x, ni = a8r * ki + a8i * kr + tv.y; kr = nr; ki = ni; }
              xpr = kr; xpi = ki;
#pragma unroll
              for (int q = 0; q < 8; ++q) { const float nr = a1r * inr - a1i * ini, ni = a1r * ini + a1i * inr; inr = nr; ini = ni;
                  X2[(8 * w + q) * 136 + p1] = (bf16_t)f2bf(xlr[q] + nr); X2[(8 * w + q) * 136 + 64 + p1] = (bf16_t)f2bf(xli[q] + ni); } }
            __syncthreads();
            if (w < 4) {
                f32x4 acc = {0.f, 0.f, 0.f, 0.f};
#pragma unroll
                for (int ks = 0; ks < 4; ++ks) { const bf16x8 af = *(const bf16x8*)(X2 + (16 * w + (lane & 15)) * 136 + 32 * ks + 8 * (lane >> 4));
                    const bf16x8 cfk = *(const bf16x8*)(C2 + (lane & 15) * 136 + 32 * ks + 8 * (lane >> 4));
                    acc = __builtin_amdgcn_mfma_f32_16x16x32_bf16(af, cfk, acc, 0, 0, 0); }
#pragma unroll
                for (int r = 0; r < 4; ++r) { const int t = 16 * w + 4 * (lane >> 4) + r; const float y = acc[r] + dsk * Uc[t * 16 + (lane & 15)];
                    yg[(tb + ck * 64 + t) * 256 + g * 16 + (lane & 15)] = (bf16_t)f2bf(gelu_erf(y)); }
            }
        }
    }
    __syncthreads();
}

constexpr int RC = 32, NCH = SEQ / RC;
constexpr int LD = 68, LA = 36, LX = 132;
DI f32x4 mf4(float a, float b, f32x4 c) { return __builtin_amdgcn_mfma_f32_16x16x4f32(a, b, c, 0, 0, 0); }
template <int K> DI void mm_cc(f32x4& acc, const float* A, int lda, const float* B, int ldb, int tr, int tc, int lane) {
    const float* ap = A + (16 * tr + (lane & 15)) * lda + 4 * (lane >> 4); const float* bp = B + (16 * tc + (lane & 15)) * ldb + 4 * (lane >> 4);
#pragma unroll
    for (int kq = 0; kq < K / 16; ++kq) { const f32x4 a = *(const f32x4*)(ap + 16 * kq), c = *(const f32x4*)(bp + 16 * kq);
        acc = mf4(a.x, c.x, acc); acc = mf4(a.y, c.y, acc); acc = mf4(a.z, c.z, acc); acc = mf4(a.w, c.w, acc); }
}
template <int K> DI void mm_cm(f32x4& acc, const float* A, int lda, const float* B, int ldb, int tr, int tc, int lane) {
    const float* ap = A + (16 * tr + (lane & 15)) * lda + 4 * (lane >> 4); const float* bp = B + (4 * (lane >> 4)) * ldb + 16 * tc + (lane & 15);
#pragma unroll
    for (int kq = 0; kq < K / 16; ++kq) { const f32x4 a = *(const f32x4*)(ap + 16 * kq); const float* b0 = bp + 16 * kq * ldb;
        acc = mf4(a.x, b0[0], acc); acc = mf4(a.y, b0[ldb], acc); acc = mf4(a.z, b0[2 * ldb], acc); acc = mf4(a.w, b0[3 * ldb], acc); }
}
template <int K> DI void mm_mm(f32x4& acc, const float* A, int lda, const float* B, int ldb, int tr, int tc, int lane) {
    const float* ap = A + (lane >> 4) * lda + 16 * tr + (lane & 15); const float* bp = B + (lane >> 4) * ldb + 16 * tc + (lane & 15);
#pragma unroll
    for (int kk = 0; kk < K / 4; ++kk) acc = mf4(ap[4 * kk * lda], bp[4 * kk * ldb], acc);
}
struct RwcPtr { float* G; float* HT; float* Pm; float* Y0; };
DI RwcPtr rwc_ptr(unsigned char* ws, int unit) { float* p = (float*)(ws + WS_RWC) + (size_t)unit * 12288; return RwcPtr{p, p + 4096, p + 8192, p + 10240}; }

DI void phase_rw1(const Ctx& C, int l, int w0, int nw) {
    PHASE_IDS
    (void)l;
    float* L0 = (float*)C.lds;
    float* AT = L0; float* RT = L0 + 2176; float* BT = L0 + 4352; float* KT = L0 + 6528; float* VV = L0 + 8704;
    float* Lm = L0 + 10880; float* AK = L0 + 12032; float* ARB = L0 + 13184; float* ARK = L0 + 14336; float* X = L0 + 15488;
    float* tot = L0 + 19712; float* gC = L0 + 20224;
    const int tid = P_tid, lane = P_lane, w = P_wave;
    const bf16_t* RWB = (const bf16_t*)(C.ws + WS_RW); const float* RWW = (const float*)(C.ws + WS_RWW);
    float iw[4], ir[4], ik[4], iv[4], ia[4], ib[4];
    { const int unit = C.vcu - w0; if (unit < 32 * NCH) { const int bh = unit / NCH, c = unit % NCH;
        const size_t tk = (size_t)(bh >> 2) * SEQ + c * RC + 4 * w; const bf16_t* base = RWB + tk * 1536 + (bh & 3) * 64 + lane; const float* bw = RWW + tk * 256 + (bh & 3) * 64 + lane;
#pragma unroll
        for (int q = 0; q < 4; ++q) { ir[q] = bf2f(base[q * 1536]); iw[q] = bw[q * 256]; ik[q] = bf2f(base[q * 1536 + 256]); iv[q] = bf2f(base[q * 1536 + 512]); ia[q] = bf2f(base[q * 1536 + 768]); ib[q] = bf2f(base[q * 1536 + 1024]); } } }
    for (int unit = C.vcu - w0; unit < 32 * NCH; unit += nw) {
        const int bh = unit / NCH, c = unit % NCH, bb = bh >> 2, h = bh & 3;
        __syncthreads();
        float g[4];
#pragma unroll
        for (int q = 0; q < 4; ++q) g[q] = q ? g[q - 1] * iw[q] : iw[q];
        tot[w * 64 + lane] = g[3];
        __syncthreads();
        float pre = 1.f, all = 1.f;
#pragma unroll
        for (int k = 0; k < 8; ++k) { const float tk = tot[k * 64 + lane]; all *= tk; if (k < w) pre *= tk; }
        if (w == 0) gC[lane] = all;
#pragma unroll
        for (int q = 0; q < 4; ++q) { const int t = 4 * w + q; const float gt = pre * g[q], gm = q ? pre * g[q - 1] : pre, ig = 1.f / gt;
            const float at = -ia[q] * gm;
            AT[t * LD + lane] = at; X[t * LX + lane] = at; RT[t * LD + lane] = ir[q] * gt; BT[t * LD + lane] = ib[q] * ig; KT[t * LD + lane] = ik[q] * ig; VV[t * LD + lane] = iv[q]; }
        { const int un = unit + nw; if (un < 32 * NCH) { const int bhn = un / NCH, cn = un % NCH;
            const size_t tk = (size_t)(bhn >> 2) * SEQ + cn * RC + 4 * w; const bf16_t* base = RWB + tk * 1536 + (bhn & 3) * 64 + lane; const float* bw = RWW + tk * 256 + (bhn & 3) * 64 + lane;
#pragma unroll
            for (int q = 0; q < 4; ++q) { ir[q] = bf2f(base[q * 1536]); iw[q] = bw[q * 256]; ik[q] = bf2f(base[q * 1536 + 256]); iv[q] = bf2f(base[q * 1536 + 512]); ia[q] = bf2f(base[q * 1536 + 768]); ib[q] = bf2f(base[q * 1536 + 1024]); } } }
        __syncthreads();
#pragma unroll
        for (int x = 0; x < 2; ++x) { const int job = 2 * w + x, mt = job >> 2, tr = (job >> 1) & 1, tc = job & 1;
            f32x4 a = {0.f, 0.f, 0.f, 0.f};
            if (tc <= tr) mm_cc<64>(a, mt < 2 ? AT : RT, LD, (mt & 1) ? KT : BT, LD, tr, tc, lane);
            const int ncol = 16 * tc + (lane & 15), mrow = 16 * tr + 4 * (lane >> 4);
#pragma unroll
            for (int r = 0; r < 4; ++r) { const bool keep = mt < 2 ? (ncol < mrow + r) : (ncol <= mrow + r); const float v = keep ? a[r] : 0.f;
                if (mt == 0) Lm[(mrow + r) * LA + (ncol & 3) * 8 + (ncol >> 2)] = v;
                else (mt == 1 ? AK : (mt == 2 ? ARB : ARK))[(mrow + r) * LA + ncol] = v; } }
        __syncthreads();
        { const int tr = w >> 2, tc = w & 3; f32x4 a = {0.f, 0.f, 0.f, 0.f}; mm_cm<32>(a, AK, LA, VV, LD, tr, tc, lane);
#pragma unroll
          for (int r = 0; r < 4; ++r) X[(16 * tr + 4 * (lane >> 4) + r) * LX + 64 + 16 * tc + (lane & 15)] = a[r]; }
        __syncthreads();
        { const int cc = tid >> 2, part = tid & 3; float u[8];
#pragma unroll
          for (int k = 0; k < 8; ++k) u[k] = 0.f;
#pragma unroll
          for (int blk = 0; blk < RC / 8; ++blk) {
              f32x4 la[8], lb[8]; float xv[8];
#pragma unroll
              for (int q = 0; q < 8; ++q) { const int t = 8 * blk + q; la[q] = *(const f32x4*)(Lm + t * LA + part * 8); lb[q] = *(const f32x4*)(Lm + t * LA + part * 8 + 4); xv[q] = X[t * LX + cc]; }
#pragma unroll
              for (int q = 0; q < 8; ++q) { const int t = 8 * blk + q;
                  float sm = la[q].x * u[0] + la[q].y * u[1] + la[q].z * u[2] + la[q].w * u[3] + lb[q].x * u[4] + lb[q].y * u[5] + lb[q].z * u[6] + lb[q].w * u[7];
                  sm = sum4(sm) + xv[q];
                  u[t >> 2] = (part == (t & 3)) ? sm : u[t >> 2]; } }
#pragma unroll
          for (int k = 0; k < 8; ++k) X[(part + 4 * k) * LX + cc] = u[k]; }
        __syncthreads();
        const RwcPtr O = rwc_ptr(C.ws, unit);
#pragma unroll
        for (int x = 0; x < 2; ++x) { const int tile = 2 * w + x, tr = tile >> 2, tc = tile & 3, ncol = 16 * tc + (lane & 15), mrow = 16 * tr + 4 * (lane >> 4);
            f32x4 gg = {0.f, 0.f, 0.f, 0.f}, hh = gg;
            mm_mm<32>(gg, BT, LD, X, LX, tr, tc, lane);
            mm_mm<32>(hh, X + 64, LX, BT, LD, tr, tc, lane); mm_mm<32>(hh, VV, LD, KT, LD, tr, tc, lane);
#pragma unroll
            for (int r = 0; r < 4; ++r) { const int row = mrow + r;
                O.G[row * 64 + ncol] = gC[row] * (gg[r] + (row == ncol ? 1.f : 0.f)); O.HT[row * 64 + ncol] = hh[r] * gC[ncol]; } }
        { const int tr = w >> 2, tc = w & 3, ncol = 16 * tc + (lane & 15), mrow = 16 * tr + 4 * (lane >> 4);
          f32x4 pp = {0.f, 0.f, 0.f, 0.f}, yy = pp;
          mm_cm<32>(pp, ARB, LA, X, LX, tr, tc, lane);
          mm_cm<32>(yy, ARB, LA, X + 64, LX, tr, tc, lane); mm_cm<32>(yy, ARK, LA, VV, LD, tr, tc, lane);
#pragma unroll
          for (int r = 0; r < 4; ++r) { const int row = mrow + r; O.Pm[row * 64 + ncol] = pp[r] + RT[row * LD + ncol]; O.Y0[row * 64 + ncol] = yy[r]; } }
    }
    __syncthreads();
}

DI void phase_rw2(const Ctx& C, int l, int w0, int nw) {
    PHASE_IDS
    (void)l;
    float* Ss = (float*)C.lds; float* Gs = Ss + 64 * LD;
    const int tid = P_tid, lane = P_lane, w = P_wave;
    const int tr = w >> 1, tc0 = 2 * (w & 1), mrow = 16 * tr + 4 * (lane >> 4);
    for (int bh = C.vcu - w0; bh < 32; bh += nw) {
        f32x4 sm[2] = {{0.f, 0.f, 0.f, 0.f}, {0.f, 0.f, 0.f, 0.f}};
        f32x4 gpre[2];
        { const RwcPtr O = rwc_ptr(C.ws, bh * NCH); gpre[0] = *(const f32x4*)(O.G + tid * 8); gpre[1] = *(const f32x4*)(O.G + tid * 8 + 4); }
        for (int c = 0; c < NCH; ++c) {
            const RwcPtr O = rwc_ptr(C.ws, bh * NCH + c);
            float* SC = (float*)(C.ws + WS_RWS) + (size_t)(bh * NCH + c) * 4096;
            float* Gc = Gs + (c & 1) * 64 * LD;
            __syncthreads();
#pragma unroll
            for (int x = 0; x < 2; ++x) { const int ncol = 16 * (tc0 + x) + (lane & 15);
#pragma unroll
                for (int r = 0; r < 4; ++r) { Ss[(mrow + r) * LD + ncol] = sm[x][r]; SC[(mrow + r) * 64 + ncol] = sm[x][r]; } }
            *(f32x4*)(Gc + (tid >> 3) * LD + 8 * (tid & 7)) = gpre[0]; *(f32x4*)(Gc + (tid >> 3) * LD + 8 * (tid & 7) + 4) = gpre[1];
            if (c + 1 < NCH) { const RwcPtr On = rwc_ptr(C.ws, bh * NCH + c + 1); gpre[0] = *(const f32x4*)(On.G + tid * 8); gpre[1] = *(const f32x4*)(On.G + tid * 8 + 4); }
            __syncthreads();
#pragma unroll
            for (int x = 0; x < 2; ++x) { const int tc = tc0 + x, ncol = 16 * tc + (lane & 15);
                f32x4 a = {O.HT[(mrow + 0) * 64 + ncol], O.HT[(mrow + 1) * 64 + ncol], O.HT[(mrow + 2) * 64 + ncol], O.HT[(mrow + 3) * 64 + ncol]};
                mm_cc<64>(a, Ss, LD, Gc, LD, tr, tc, lane); sm[x] = a; }
        }
    }
    __syncthreads();
}

DI void phase_rw3(const Ctx& C, int l, int ubeg, int uend, int ustep) {
    PHASE_IDS
    (void)l;
    float* Ps = (float*)C.lds; float* Ss = Ps + RC * LD;
    const int tid = P_tid, lane = P_lane, w = P_wave;
    const int tr = w >> 2, tc = w & 3, mrow = 16 * tr + 4 * (lane >> 4), ncol = 16 * tc + (lane & 15);
    float* RWY = (float*)(C.ws + WS_RWY);
    f32x4 ns0, ns1, np0, np1, ny;
#define RW3_LOAD(unit_) { const RwcPtr On = rwc_ptr(C.ws, (unit_)); const float* SCn = (const float*)(C.ws + WS_RWS) + (size_t)(unit_) * 4096; \
        ns0 = *(const f32x4*)(SCn + tid * 8); ns1 = *(const f32x4*)(SCn + tid * 8 + 4); \
        if (tid < 256) { np0 = *(const f32x4*)(On.Pm + tid * 8); np1 = *(const f32x4*)(On.Pm + tid * 8 + 4); } \
        ny = (f32x4){On.Y0[(mrow + 0) * 64 + ncol], On.Y0[(mrow + 1) * 64 + ncol], On.Y0[(mrow + 2) * 64 + ncol], On.Y0[(mrow + 3) * 64 + ncol]}; }
    if (ubeg < uend) RW3_LOAD(ubeg)
    for (int unit = ubeg; unit < uend; unit += ustep) {
        const int bh = unit / NCH, c = unit % NCH, bb = bh >> 2, h = bh & 3;
        __syncthreads();
        { const int row = tid >> 3, ch = 8 * (tid & 7);
          *(f32x4*)(Ss + row * LD + ch) = ns0; *(f32x4*)(Ss + row * LD + ch + 4) = ns1;
          if (tid < 256) { *(f32x4*)(Ps + row * LD + ch) = np0; *(f32x4*)(Ps + row * LD + ch + 4) = np1; } }
        f32x4 a = ny;
        if (unit + ustep < uend) RW3_LOAD(unit + ustep)
        __syncthreads();
        mm_cc<64>(a, Ps, LD, Ss, LD, tr, tc, lane);
#pragma unroll
        for (int r = 0; r < 4; ++r) RWY[((size_t)bb * SEQ + c * RC + mrow + r) * 256 + h * 64 + ncol] = a[r];
    }
#undef RW3_LOAD
    __syncthreads();
}

DI void phase_post(const Ctx& C, int l) {
    PHASE_IDS
    const float* glu = (const float*)(C.ws + WS_GLU); const bf16_t* RWB = (const bf16_t*)(C.ws + WS_RW); const float* RWY = (const float*)(C.ws + WS_RWY);
    bf16_t* mixed = (bf16_t*)(C.ws + WS_MIXED);
    const f32x4 on = ((const f32x4*)(INF(I_SONORM) + l * 256))[P_lane];
    float lnw[4], lnb[4], rkw[4];
#pragma unroll
    for (int h = 0; h < 4; ++h) { lnw[h] = INF(I_LNW)[l * 256 + h * 64 + P_lane]; lnb[h] = INF(I_LNB)[l * 256 + h * 64 + P_lane]; rkw[h] = INF(I_RK)[l * 256 + h * 64 + P_lane]; }
    f32x4 gv = ((const f32x4*)(glu + (size_t)P_gw * 256))[P_lane];
    float y[4], rr[4], kk[4], vv[4], gg[4];
#pragma unroll
    for (int h = 0; h < 4; ++h) { const int j = h * 64 + P_lane; const bf16_t* rw = RWB + (size_t)P_gw * 1536 + j; y[h] = RWY[(size_t)P_gw * 256 + j]; rr[h] = bf2f(rw[0]); kk[h] = bf2f(rw[256]); vv[h] = bf2f(rw[512]); gg[h] = bf2f(rw[1280]); }
    for (int t = P_gw; t < T; t += C.NGW) {
        const int tn = t + C.NGW < T ? t + C.NGW : t;
        const f32x4 gvn = ((const f32x4*)(glu + (size_t)tn * 256))[P_lane];
        float yn[4], rn[4], kn[4], vn[4], gn[4];
#pragma unroll
        for (int h = 0; h < 4; ++h) { const int j = h * 64 + P_lane; const bf16_t* rw = RWB + (size_t)tn * 1536 + j; yn[h] = RWY[(size_t)tn * 256 + j]; rn[h] = bf2f(rw[0]); kn[h] = bf2f(rw[256]); vn[h] = bf2f(rw[512]); gn[h] = bf2f(rw[1280]); }
        const float ss = wave_sum(gv.x * gv.x + gv.y * gv.y + gv.z * gv.z + gv.w * gv.w);
        const float rs = 1.f / sqrtf(ss * (1.f / 256.f) + NORM_EPS);
        *(u32x2*)(mixed + (size_t)t * DM + 512 + 4 * P_lane) = (u32x2){pk2(gv.x * rs * on.x, gv.y * rs * on.y), pk2(gv.z * rs * on.z, gv.w * rs * on.w)};
        float mean[4], dot[4];
#pragma unroll
        for (int h = 0; h < 4; ++h) { mean[h] = wave_sum(y[h]) * (1.f / 64.f); dot[h] = wave_sum(rr[h] * kk[h] * rkw[h]); }
#pragma unroll
        for (int h = 0; h < 4; ++h) { const float dv = y[h] - mean[h]; const float var = wave_sum(dv * dv) * (1.f / 64.f);
            const float yo = (dv * (1.f / sqrtf(var + 64e-5f)) * lnw[h] + lnb[h] + dot[h] * vv[h]) * gg[h];
            mixed[(size_t)t * DM + 768 + h * 64 + P_lane] = (bf16_t)f2bf(yo); }
        gv = gvn;
#pragma unroll
        for (int h = 0; h < 4; ++h) { y[h] = yn[h]; rr[h] = rn[h]; kk[h] = kn[h]; vv[h] = vn[h]; gg[h] = gn[h]; }
    }
}

DI void ce_desc(float& a, float& c) { const float hi = fmaxf(a, c), lo = fminf(a, c); a = hi; c = lo; }
DI void sort16_desc(float (&a)[16]) {
#pragma unroll
    for (int k = 2; k <= 16; k <<= 1)
#pragma unroll
        for (int j = k >> 1; j > 0; j >>= 1)
#pragma unroll
            for (int i = 0; i < 16; ++i) { const int l = i ^ j; if (l > i) { if ((i & k) == 0) ce_desc(a[i], a[l]); else ce_desc(a[l], a[i]); } }
}
DI void merge16_desc(float (&t)[16], const float (&g)[16]) {
#pragma unroll
    for (int i = 0; i < 16; ++i) t[i] = fmaxf(t[i], g[15 - i]);
#pragma unroll
    for (int j = 8; j > 0; j >>= 1)
#pragma unroll
        for (int i = 0; i < 16; ++i) { const int l = i ^ j; if (l > i) ce_desc(t[i], t[l]); }
}
DI void phase_topk(const Ctx& C, int l) {
    PHASE_IDS
    const bf16_t* qp = (const bf16_t*)(C.ws + WS_QP); const bf16_t* subk = (const bf16_t*)(C.ws + WS_SUBK);
    int* IDX = (int*)(C.ws + WS_IDX); float* GATE = (float*)(C.ws + WS_GATE);
    unsigned* scr = (unsigned*)C.lds + P_wave * 2048;
    const float NEG = -3.0e38f;
    for (int task = P_gw; task < (T / 32) * 8; task += C.NGW) {
        const int tile = task >> 3, h = task & 7;
        float LA[16], LB[16];
        {
        int lane0; asm volatile("v_mbcnt_lo_u32_b32 %0, -1, 0\n\tv_mbcnt_hi_u32_b32 %0, -1, %0" : "=v"(lane0)); const int r32 = lane0 & 31, hi = lane0 >> 5;
#pragma unroll
        for (int m = 0; m < 2; ++m) {
            bf16x8 bq[8];
#pragma unroll
            for (int d0 = 0; d0 < 8; ++d0) bq[d0] = *(const bf16x8*)(qp + (size_t)(tile * 32 + r32) * 2048 + h * 256 + m * 128 + d0 * 16 + hi * 8);
            float Lm[16];
#pragma unroll
            for (int i = 0; i < 16; ++i) Lm[i] = NEG;
#pragma unroll
            for (int k = 0; k < 4; ++k) {
                f32x16 acc;
#pragma unroll
                for (int r = 0; r < 16; ++r) acc[r] = 0.f;
                const bf16_t* kp = subk + ((size_t)((l * 8 + h) * 2 + m) * 128 + k * 32 + r32) * 128 + hi * 8;
                bf16x8 akf[8];
#pragma unroll
                for (int d0 = 0; d0 < 8; ++d0) akf[d0] = *(const bf16x8*)(kp + d0 * 16);
                __builtin_amdgcn_sched_barrier(0);
#pragma unroll
                for (int d0 = 0; d0 < 8; ++d0) acc = __builtin_amdgcn_mfma_f32_32x32x16_bf16(akf[d0], bq[d0], acc, 0, 0, 0);
                float gv[16];
#pragma unroll
                for (int r = 0; r < 16; ++r) { const unsigned key = 32 * k + (r & 3) + 8 * (r >> 2) + 4 * hi; const float av = acc[r];
                    gv[r] = __builtin_bit_cast(float, (__builtin_bit_cast(unsigned, av) & ~127u) | key); }
                sort16_desc(gv);
                if (k == 0) {
#pragma unroll
                    for (int i = 0; i < 16; ++i) Lm[i] = gv[i];
                } else merge16_desc(Lm, gv);
                __builtin_amdgcn_sched_barrier(0);
            }
            float ot[16];
#pragma unroll
            for (int i = 0; i < 16; ++i) ot[i] = other_half(Lm[i], hi);
            merge16_desc(Lm, ot);
#pragma unroll
            for (int i = 0; i < 16; ++i) { if (m == 0) LA[i] = Lm[i]; else LB[i] = Lm[i]; }
        }
        }
        int lane; asm volatile("v_mbcnt_lo_u32_b32 %0, -1, 0\n\tv_mbcnt_hi_u32_b32 %0, -1, %0" : "=v"(lane)); const int r32 = lane & 31, hi = lane >> 5;
#pragma unroll
        for (int i = 0; i < 16; ++i) { scr[i * 64 + lane] = __builtin_bit_cast(unsigned, LA[i]) & 127u; scr[(16 + i) * 64 + lane] = __builtin_bit_cast(unsigned, LB[i]) & 127u; }
        float L2[16];
        { float cv[64]; int cnt = 0;
#pragma unroll
          for (int i = 0; i < 16; ++i) {
              const float sa = __builtin_bit_cast(float, __builtin_bit_cast(unsigned, LA[i]) & ~127u);
#pragma unroll
              for (int j = 0; j < 16; ++j) if ((i + 1) * (j + 1) <= 16) {
                  const float sb = __builtin_bit_cast(float, __builtin_bit_cast(unsigned, LB[j]) & ~127u);
                  cv[cnt++] = __builtin_bit_cast(float, (__builtin_bit_cast(unsigned, sa + sb) & ~255u) | (unsigned)(i * 16 + j)); } }
#pragma unroll
          for (int q = 50; q < 64; ++q) cv[q] = NEG;
#pragma unroll
          for (int gI = 0; gI < 4; ++gI) { float gv[16];
#pragma unroll
              for (int q = 0; q < 16; ++q) gv[q] = cv[16 * gI + q];
              sort16_desc(gv);
              if (gI == 0) {
#pragma unroll
                  for (int q = 0; q < 16; ++q) L2[q] = gv[q];
              } else merge16_desc(L2, gv);
              __builtin_amdgcn_sched_barrier(0); } }
        float sc[16], den = 0.f;
#pragma unroll
        for (int q = 0; q < 16; ++q) { sc[q] = __builtin_bit_cast(float, __builtin_bit_cast(unsigned, L2[q]) & ~255u); }
        { const float m0 = sc[0];
#pragma unroll
        for (int q = 0; q < 16; ++q) { sc[q] = __expf(sc[q] - m0); den += sc[q]; } }
        const float rden = 1.f / den;
        if (hi == 0) {
            const size_t ob = (size_t)(tile * 32 + r32) * 128 + h * 16;
#pragma unroll
            for (int q = 0; q < 16; ++q) { const unsigned bits = __builtin_bit_cast(unsigned, L2[q]); const unsigned i = (bits >> 4) & 15u, j = bits & 15u;
                const unsigned e = scr[i * 64 + lane] * 128u + scr[(16 + j) * 64 + lane];
                IDX[ob + q] = (int)e; GATE[ob + q] = sc[q] * rden; }
        }
    }
}

DI void dec16(const u32x4 w, f32x2 (&o)[8]) {
    o[0] = __builtin_amdgcn_cvt_pk_f32_fp8((int)w.x, false); o[1] = __builtin_amdgcn_cvt_pk_f32_fp8((int)w.x, true);
    o[2] = __builtin_amdgcn_cvt_pk_f32_fp8((int)w.y, false); o[3] = __builtin_amdgcn_cvt_pk_f32_fp8((int)w.y, true);
    o[4] = __builtin_amdgcn_cvt_pk_f32_fp8((int)w.z, false); o[5] = __builtin_amdgcn_cvt_pk_f32_fp8((int)w.z, true);
    o[6] = __builtin_amdgcn_cvt_pk_f32_fp8((int)w.w, false); o[7] = __builtin_amdgcn_cvt_pk_f32_fp8((int)w.w, true);
}
DI float bperm_f(int lane_idx, float v) { return __builtin_bit_cast(float, __builtin_amdgcn_ds_bpermute(lane_idx << 2, __builtin_bit_cast(int, v))); }
DI void phase_gather_u(const Ctx& C, int l) {
    PHASE_IDS
    const int s = (int)blockIdx.x & 7, r = (int)blockIdx.x >> 3, tstride = (C.G >> 3) * NWAVES;
    const int lane = P_lane, sub = lane >> 3, chunk = lane & 7;
    int* wi = (int*)C.lds + P_wave * 128;
    const unsigned char* U8 = C.ws + WS_U8 + (size_t)l * NEXP * DM + s * 128; const unsigned lo16 = 16u * (unsigned)chunk;
    const bf16_t* H2 = (const bf16_t*)(C.ws + WS_H) + s * 128 + 16 * chunk;
    const int* IDX = (const int*)(C.ws + WS_IDX); bf16_t* PART = (bf16_t*)(C.ws + WS_PART);
    const int t0 = r * NWAVES + P_wave;
    if (t0 >= T) return;
    int i0 = IDX[(size_t)t0 * 128 + lane], i1 = IDX[(size_t)t0 * 128 + 64 + lane];
    u32x4 ha = *(const u32x4*)(H2 + (size_t)t0 * DM), hb = *(const u32x4*)(H2 + (size_t)t0 * DM + 8);
    for (int t = t0; t < T; t += tstride) {
        wi[lane] = i0; wi[64 + lane] = i1;
        f32x2 hf[8];
        hf[0] = (f32x2){bflo(ha.x), bfhi(ha.x)}; hf[1] = (f32x2){bflo(ha.y), bfhi(ha.y)}; hf[2] = (f32x2){bflo(ha.z), bfhi(ha.z)}; hf[3] = (f32x2){bflo(ha.w), bfhi(ha.w)};
        hf[4] = (f32x2){bflo(hb.x), bfhi(hb.x)}; hf[5] = (f32x2){bflo(hb.y), bfhi(hb.y)}; hf[6] = (f32x2){bflo(hb.z), bfhi(hb.z)}; hf[7] = (f32x2){bflo(hb.w), bfhi(hb.w)};
        { const int tn = t + tstride < T ? t + tstride : t;
          i0 = IDX[(size_t)tn * 128 + lane]; i1 = IDX[(size_t)tn * 128 + 64 + lane]; ha = *(const u32x4*)(H2 + (size_t)tn * DM); hb = *(const u32x4*)(H2 + (size_t)tn * DM + 8); }
        float pd[16];
#pragma unroll
        for (int half = 0; half < 2; ++half) {
            u32x4 rw[8];
#pragma unroll
            for (int i = 0; i < 8; ++i) { const int e = wi[(half * 8 + i) * 8 + sub]; rw[i] = *(const u32x4*)(U8 + (((unsigned)e << 10) + lo16)); }
#pragma unroll
            for (int i = 0; i < 8; i += 2) {
                f32x2 d[8], e[8]; dec16(rw[i], d); dec16(rw[i + 1], e);
                f32x2 a0 = d[0] * hf[0], a1 = d[1] * hf[1], b0 = e[0] * hf[0], b1 = e[1] * hf[1];
#pragma unroll
                for (int k = 2; k < 8; k += 2) { a0 += d[k] * hf[k]; b0 += e[k] * hf[k]; a1 += d[k + 1] * hf[k + 1]; b1 += e[k + 1] * hf[k + 1]; }
                a0 += a1; b0 += b1;
                pd[half * 8 + i] = a0.x + a0.y; pd[half * 8 + i + 1] = b0.x + b0.y; __builtin_amdgcn_sched_barrier(0); }
        }
        float w1[8], w2[4];
#pragma unroll
        for (int k = 0; k < 8; ++k) { const float keep = (chunk & 4) ? pd[8 + k] : pd[k], send = (chunk & 4) ? pd[k] : pd[8 + k]; w1[k] = keep + dpp_f<0x141>(send); }
#pragma unroll
        for (int k = 0; k < 4; ++k) { const float keep = (chunk & 2) ? w1[4 + k] : w1[k], send = (chunk & 2) ? w1[k] : w1[4 + k]; w2[k] = keep + dpp_f<0x4E>(send); }
        const float o0 = ((chunk & 1) ? w2[2] : w2[0]) + dpp_f<0xB1>((chunk & 1) ? w2[0] : w2[2]), o1 = ((chunk & 1) ? w2[3] : w2[1]) + dpp_f<0xB1>((chunk & 1) ? w2[1] : w2[3]);
        bf16_t* pp = PART + ((size_t)t * 8 + s) * 128 + sub;
        pp[(2 * chunk) * 8] = (bf16_t)f2bf(o0); pp[(2 * chunk + 1) * 8] = (bf16_t)f2bf(o1);
    }
}
DI void phase_gather_c(const Ctx& C, int l) {
    PHASE_IDS
    const float* SU = (const float*)(C.ws + WS_SU) + l * NEXP; const float* SV = (const float*)(C.ws + WS_SV) + l * NEXP;
    const int* IDX = (const int*)(C.ws + WS_IDX); const float* GATE = (const float*)(C.ws + WS_GATE); float* COEF = (float*)(C.ws + WS_COEF); const bf16_t* PART = (const bf16_t*)(C.ws + WS_PART);
    for (int t = P_gw; t < T; t += C.NGW) {
#pragma unroll
        for (int hq = 0; hq < 2; ++hq) { const int p = hq * 64 + P_lane; const int e = IDX[(size_t)t * 128 + p]; float d = 0.f;
#pragma unroll
            for (int s = 0; s < 8; ++s) d += bf2f(PART[((size_t)t * 8 + s) * 128 + p]);
            COEF[(size_t)t * 128 + p] = GATE[(size_t)t * 128 + p] * gelu_erf(d * SU[e]) * SV[e]; }
    }
}
DI void phase_gather_v(const Ctx& C, int l) {
    PHASE_IDS
    const int s = (int)blockIdx.x & 7, r = (int)blockIdx.x >> 3, tstride = (C.G >> 3) * NWAVES;
    const int lane = P_lane, hi = lane >> 5, b4 = (lane >> 4) & 1, b3 = (lane >> 3) & 1, sub = lane >> 3, chunk = lane & 7;
    int* wi = (int*)C.lds + P_wave * 256; float* wc = (float*)(wi + 128);
    const unsigned char* V8 = C.ws + WS_V8 + (size_t)l * NEXP * DM + s * 128; const unsigned lo16 = 16u * (unsigned)chunk;
    const int* IDX = (const int*)(C.ws + WS_IDX); const float* COEF = (const float*)(C.ws + WS_COEF);
    const int tv0 = r * NWAVES + P_wave;
    if (tv0 >= T) return;
    int i0 = IDX[(size_t)tv0 * 128 + lane], i1 = IDX[(size_t)tv0 * 128 + 64 + lane]; float c0 = COEF[(size_t)tv0 * 128 + lane], c1 = COEF[(size_t)tv0 * 128 + 64 + lane];
    for (int t = tv0; t < T; t += tstride) {
        wi[lane] = i0; wi[64 + lane] = i1; wc[lane] = c0; wc[64 + lane] = c1;
        { const int tn = t + tstride < T ? t + tstride : t;
          i0 = IDX[(size_t)tn * 128 + lane]; i1 = IDX[(size_t)tn * 128 + 64 + lane]; c0 = COEF[(size_t)tn * 128 + lane]; c1 = COEF[(size_t)tn * 128 + 64 + lane]; }
        f32x2 acc[8];
#pragma unroll
        for (int k = 0; k < 8; ++k) acc[k] = (f32x2){0.f, 0.f};
#pragma unroll
        for (int half = 0; half < 2; ++half) {
            u32x4 rw[8]; float cf[8];
#pragma unroll
            for (int i = 0; i < 8; ++i) { const int ii = (half * 8 + i) * 8 + sub; const int e = wi[ii]; cf[i] = wc[ii]; rw[i] = *(const u32x4*)(V8 + (((unsigned)e << 10) + lo16)); }
#pragma unroll
            for (int i = 0; i < 8; ++i) { f32x2 d[8]; dec16(rw[i], d); const f32x2 c2 = (f32x2){cf[i], cf[i]};
#pragma unroll
                for (int k = 0; k < 8; ++k) acc[k] += c2 * d[k];
                __builtin_amdgcn_sched_barrier(0); }
        }
        f32x2 q1[4], q2[2], q3;
#pragma unroll
        for (int i = 0; i < 4; ++i) { const f32x2 keep = hi ? acc[4 + i] : acc[i], send = hi ? acc[i] : acc[4 + i]; q1[i] = keep + (f32x2){other_half(send.x, hi), other_half(send.y, hi)}; }
#pragma unroll
        for (int i = 0; i < 2; ++i) { const f32x2 keep = b4 ? q1[2 + i] : q1[i], send = b4 ? q1[i] : q1[2 + i]; q2[i] = keep + (f32x2){xor16(send.x), xor16(send.y)}; }
        { const f32x2 keep = b3 ? q2[1] : q2[0], send = b3 ? q2[0] : q2[1]; q3 = keep + (f32x2){xor8(send.x), xor8(send.y)}; }
        f32x2* op = (f32x2*)(C.out + (size_t)t * DM + s * 128 + 16 * chunk + 2 * (4 * hi + 2 * b4 + b3));
        *op = *op + q3;
    }
}

struct EpiResF32 {
    static constexpr bool PERM = false, AFTER_DRAIN = false;
    const float* R; float* Cc; int ldc;
    __device__ __forceinline__ void operator()(const pg8::f32x4 (&acc)[2][2][4][2], const pg8::Unit& u, int wr, int wc, int fr, int fq) const {
        int ln_; asm volatile("v_mbcnt_lo_u32_b32 %0, -1, 0\n\tv_mbcnt_hi_u32_b32 %0, -1, %0" : "=v"(ln_)); const int fr_ = ln_ & 15, fq_ = ln_ >> 4; (void)fr; (void)fq;
        const int row0 = u.pm * 256 + wr * 64 + fr_, col0 = u.pn * 256 + wc * 32 + 4 * fq_;
#pragma unroll
        for (int ai = 0; ai < 2; ++ai)
#pragma unroll
            for (int m = 0; m < 4; ++m) { const size_t ro = (size_t)(row0 + ai * 128 + m * 16) * ldc + col0;
#pragma unroll
                for (int bj = 0; bj < 2; ++bj)
#pragma unroll
                    for (int n = 0; n < 2; ++n) { const pg8::f32x4 r = *(const pg8::f32x4*)(R + ro + bj * 128 + n * 16); *(pg8::f32x4*)(Cc + ro + bj * 128 + n * 16) = acc[ai][bj][m][n] + r; } __builtin_amdgcn_sched_barrier(0); }
    }
};
struct EpiGlu {
    static constexpr bool PERM = false, AFTER_DRAIN = false;
    const bf16_t* YG; const float* bias; float* Gg;
    __device__ __forceinline__ void operator()(const pg8::f32x4 (&acc)[2][2][4][2], const pg8::Unit& u, int wr, int wc, int fr, int fq) const {
        int ln_; asm volatile("v_mbcnt_lo_u32_b32 %0, -1, 0\n\tv_mbcnt_hi_u32_b32 %0, -1, %0" : "=v"(ln_)); const int fr_ = ln_ & 15, fq_ = ln_ >> 4; (void)fr; (void)fq;
        const int row0 = u.pm * 256 + wr * 64 + fr_, col0 = wc * 32 + 4 * fq_;
#pragma unroll
        for (int ai = 0; ai < 2; ++ai)
#pragma unroll
            for (int m = 0; m < 4; ++m) { const size_t ro = (size_t)(row0 + ai * 128 + m * 16) * 256 + col0;
#pragma unroll
                for (int bj = 0; bj < 2; ++bj)
#pragma unroll
                    for (int n = 0; n < 2; ++n) { const size_t o = ro + bj * 128 + n * 16; const pg8::f32x4 bv = *(const pg8::f32x4*)(bias + col0 + bj * 128 + n * 16);
                        const u32x2 y = *(const u32x2*)(YG + o); const pg8::f32x4 a = acc[ai][bj][m][n] + bv;
                        pg8::f32x4 r; r.x = bflo(y.x) * sigmoidf_(a.x); r.y = bfhi(y.x) * sigmoidf_(a.y); r.z = bflo(y.y) * sigmoidf_(a.z); r.w = bfhi(y.y) * sigmoidf_(a.w);
                        *(pg8::f32x4*)(Gg + o) = r; } __builtin_amdgcn_sched_barrier(0); }
    }
};

#ifndef MK_ONLY
#define MK_ONLY -1
#endif
#define PH_EN(k) ((MK_ONLY) < 0 || (MK_ONLY) == (k))
constexpr int PH_PER_LAYER = 15, NPHASES = 1 + DEPTH * PH_PER_LAYER;
__global__ void __launch_bounds__(NTHR, 2) fwd(Args args) {
    extern __shared__ __attribute__((aligned(16))) unsigned char lds_raw[];
    Ctx C;
    C.in = args.in; C.out = args.out; C.ws = args.ws; C.lds = (char*)lds_raw;
    C.G = gridDim.x; { const int bx = blockIdx.x; C.vcu = (C.G % 8 == 0) ? (bx % 8) * (C.G / 8) + bx / 8 : bx; }
    C.NGW = C.G * NWAVES; C.wave = __builtin_amdgcn_readfirstlane((int)threadIdx.x >> 6);
    volatile LAS unsigned* MISC = (volatile LAS unsigned*)((LAS unsigned char*)lds_raw + MISC_OFF);
    if (threadIdx.x < 64) MISC[threadIdx.x] = 0u;
    __syncthreads();
    XcdBarrier bar; bar.bar = (unsigned*)(args.ws + WS_CTL) + 4096 + args.bli * XCD_BAR_WORDS; bar.x = 0; bar.st = MISC + 8;
    const bool multi = (args.ph_hi - args.ph_lo) > 1;
    if (multi) bar = xcd_barrier_post((unsigned*)(args.ws + WS_CTL) + 4096 + args.bli * XCD_BAR_WORDS, MISC + 8);
    LAS unsigned char* ldsp = (LAS unsigned char*)lds_raw;

#ifndef MK_SPLIT_MIXERS
#define MK_SPLIT_MIXERS 0
#endif
#ifndef MK_NOISE
#define MK_NOISE 0
#endif
#ifndef MK_RWKV_NAIVE
#define MK_RWKV_NAIVE 0
#endif
#ifndef MK_REPK
#define MK_REPK -1
#endif
#define REPS_(k) ((MK_REPK) == (k) ? 2 : 1)
#define IN_(P) (args.ph_lo <= (P) && (P) < args.ph_hi)
#define RUNP_(k, stmt) for (int r_ = 0; r_ < REPS_(k); ++r_) { if (r_) xcd_barrier(bar, C.wave); stmt; }
#define SEAM_(P) do { if (IN_(P) && IN_((P) + 1)) xcd_barrier(bar, C.wave); } while (0)
#define GEMM_(EPI, EXPR_E, A_, BT_, M_, N_, K_) do { pg8::Gemm g{(const bf16_t*)(A_), (const bf16_t*)(BT_), (M_), (N_), (K_)}; pg8::StaticOrder S; S.init((M_), (N_), C.G, (int)blockIdx.x); EPI E EXPR_E; \
        pg8::gemm_phase<EPI, pg8::StaticOrder>(ldsp, g, S, E, nullptr, C.wave); } while (0)
#define LAYER_(L) do { constexpr int l = (L); constexpr int P0 = 1 + (L) * PH_PER_LAYER; \
    if (IN_(P0 + 0)) { RUNP_(0, phase_rmsnorm<false>(C, (l == 0) ? (const float*)C.in[I_X] : (const float*)C.out, INF(I_NORM_MIX) + l * DM, (bf16_t*)(C.ws + WS_H))) } SEAM_(P0 + 0); \
    if (IN_(P0 + 1)) { RUNP_(1, GEMM_(pg8::EpiBf16<0>, ({(bf16_t*)(C.ws + WS_COLS), INCP, nullptr, 0, 0}), C.ws + WS_H, (const bf16_t*)(C.ws + WS_WTIN) + (size_t)l * INCP * DM, T, INCP, DM)) } SEAM_(P0 + 1); \
    if (IN_(P0 + 2)) { if (PH_EN(2)) phase_prep(C, l); } SEAM_(P0 + 2); \
    if (IN_(P0 + 3)) { for (int r_ = 0; r_ < REPS_(3); ++r_) { if (r_) xcd_barrier(bar, C.wave); if (!MK_RWKV_NAIVE) for (int q_ = 0; q_ < REPS_(32); ++q_) phase_rw1(C, l, 0, C.G); \
                       if (C.G == 256) { if (C.vcu < 128) phase_ssm(C, l, 0, 128); phase_attn_queue(C, l, 0); } else { phase_ssm(C, l, 0, C.G); phase_attn(C, l, 0, C.G); } } } SEAM_(P0 + 3); \
    if (IN_(P0 + 4)) for (int r_ = 0; r_ < REPS_(4); ++r_) { if (r_) xcd_barrier(bar, C.wave); if (C.G == 256) { if (C.vcu < 32) phase_rw2(C, l, 0, 32); phase_attn_queue(C, l, 1); } else phase_rw2(C, l, 0, C.G); } SEAM_(P0 + 4); \
      \
    if (IN_(P0 + 5)) { if (!MK_RWKV_NAIVE) RUNP_(5, { if (C.G == 256) { const int bx_ = (int)blockIdx.x; if (bx_ < 128) phase_rw3(C, l, bx_ * 6, bx_ * 6 + 6, 1); else phase_rw3(C, l, 768 + (bx_ - 128) * 26, 768 + (bx_ - 128) * 26 + 26, 1); } else phase_rw3(C, l, C.vcu, 32 * NCH, C.G); }) } \
    if (IN_(P0 + 6)) { if (PH_EN(6)) GEMM_(EpiGlu, ({(const bf16_t*)(C.ws + WS_YG), INF(I_BGLU) + l * 256, (float*)(C.ws + WS_GLU)}), C.ws + WS_YG, (const bf16_t*)(C.ws + WS_WTGLU) + (size_t)l * 256 * 256, T, 256, 256); } SEAM_(P0 + 6); \
    if (IN_(P0 + 7)) { RUNP_(7, phase_post(C, l)) } SEAM_(P0 + 7); \
    if (IN_(P0 + 8)) { if (PH_EN(8)) GEMM_(EpiResF32, ({(l == 0) ? (const float*)C.in[I_X] : (const float*)C.out, C.out, DM}), C.ws + WS_MIXED, (const bf16_t*)(C.ws + WS_WTOUT) + (size_t)l * DM * DM, T, DM, DM); } SEAM_(P0 + 8); \
    if (IN_(P0 + 9)) { RUNP_(9, phase_rmsnorm<false>(C, C.out, INF(I_NORM_FFN) + l * DM, (bf16_t*)(C.ws + WS_H))) } SEAM_(P0 + 9); \
    if (IN_(P0 + 10)) { if (PH_EN(10)) GEMM_(pg8::EpiBf16<0>, ({(bf16_t*)(C.ws + WS_QP), 2048, nullptr, 0, 0}), C.ws + WS_H, (const bf16_t*)(C.ws + WS_WTQ) + (size_t)l * 2048 * DM, T, 2048, DM); } SEAM_(P0 + 10); \
    if (IN_(P0 + 11)) { for (int r_ = 0; r_ < REPS_(11); ++r_) { if (r_) xcd_barrier(bar, C.wave); phase_topk(C, l); } } SEAM_(P0 + 11); \
    if (IN_(P0 + 12)) { for (int r_ = 0; r_ < REPS_(12); ++r_) { if (r_) xcd_barrier(bar, C.wave); phase_gather_u(C, l); } } SEAM_(P0 + 12); \
    if (IN_(P0 + 13)) { RUNP_(13, phase_gather_c(C, l)) } SEAM_(P0 + 13); \
    if (IN_(P0 + 14)) { phase_gather_v(C, l); } SEAM_(P0 + 14); \
    } while (0)
    if (IN_(0)) { if (PH_EN(100)) phase_prologue(C); }
    LAYER_(0); LAYER_(1); LAYER_(2); LAYER_(3);
}
}

extern "C" void kernel_launch(void* const* d_in, const int* in_sizes, int n_in, void* d_out, int out_size, void* d_ws, size_t ws_size, hipStream_t stream) {
    using namespace mk;
    static int grid = 0;
    if (grid == 0) {
        if (n_in != N_IN || out_size != T * DM || ws_size < WS_END) { fprintf(stderr, "kernel_launch: unexpected shapes (n_in %d, out %d, ws %zu)\n", n_in, out_size, ws_size); grid = -1; return; }
        int dev = 0, cus = 0;
        if (hipGetDevice(&dev) != hipSuccess || hipDeviceGetAttribute(&cus, hipDeviceAttributeMultiprocessorCount, dev) != hipSuccess) { grid = -1; return; }
        if (hipFuncSetAttribute((const void*)fwd, hipFuncAttributeMaxDynamicSharedMemorySize, LDS_BYTES) != hipSuccess) { fprintf(stderr, "kernel_launch: hipFuncSetAttribute failed\n"); grid = -1; return; }
        int per_cu = 0;
        if (hipOccupancyMaxActiveBlocksPerMultiprocessor(&per_cu, (const void*)fwd, NTHR, LDS_BYTES) != hipSuccess || per_cu < 1) fprintf(stderr, "kernel_launch: occupancy query says %d\n", per_cu);
        (void)hipGetLastError();
        grid = cus;
    }
    if (grid < 0) return;
    (void)hipMemsetAsync((char*)d_ws + WS_CTL, 0, CTL_BYTES, stream);
    Args a{};
    for (int i = 0; i < N_IN; ++i) a.in[i] = d_in[i];
    a.out = (float*)d_out; a.ws = (unsigned char*)d_ws;
#if MK_DEBUG
    {
        auto run = [&](int p) { a.ph_lo = p; a.ph_hi = p + 1; hipLaunchKernelGGL(fwd, dim3(grid), dim3(NTHR), LDS_BYTES, stream, a); };
        auto chk = [&](int stage, int blocks, int thr, int ldsb) { hipLaunchKernelGGL(dbg_check, dim3(blocks), dim3(thr), ldsb, stream, a, stage, (int)MK_DBG_LAYER); };
        static bool attr = false; if (!attr) { (void)hipFuncSetAttribute((const void*)dbg_check, hipFuncAttributeMaxDynamicSharedMemorySize, 65536); attr = true; }
        run(0); chk(20, 1, 256, 0);
        for (int l = 0; l < MK_DBG_LAYER; ++l) for (int k = 0; k < PH_PER_LAYER; ++k) run(1 + l * PH_PER_LAYER + k);
        const int base = 1 + MK_DBG_LAYER * PH_PER_LAYER;
        run(base + 0); chk(1, 8, 256, 0);
        run(base + 1); chk(2, 16, 256, 0); chk(34, 16, 256, 0); chk(35, 64, 256, 0); chk(37, 64, 256, 0);
        run(base + 2); chk(46, 256, 256, 0); chk(38, 16, 256, 0); chk(3, 2, 256, 65536); chk(4, 2, 256, 0);
        run(base + 3);
        run(base + 4); chk(5, 16, 256, 0); chk(6, 1, 256, 0);
        run(base + 5); chk(7, 8, 256, 0);
        run(base + 6); run(base + 7); chk(8, 4, 64, 65536); chk(9, 4, 256, 0);
        run(base + 8); chk(10, 16, 256, 0);
        run(base + 9); chk(11, 8, 256, 0);
        run(base + 10); chk(12, 16, 256, 0);
        run(base + 11); chk(61, 4, 256, 65536); chk(13, 8, 64, 65536); chk(140, 4, 256, 0);
        run(base + 12); run(base + 13); chk(141, 16, 256, 0); run(base + 14); chk(14, 4, 256, 0);
#ifdef MK_DBG_VAL
        hipLaunchKernelGGL(dbg_encode_val, dim3(1024), dim3(256), 0, stream, a, MK_DBG_VAL);
#elif defined(MK_DBG_LVL)
        hipLaunchKernelGGL(dbg_encode_lvl, dim3(1024), dim3(256), 0, stream, a, MK_DBG_LVL);
#else
        hipLaunchKernelGGL(dbg_encode, dim3(1024), dim3(256), 0, stream, a, MK_DBG_SET);
#endif
    }
#elif defined(MK_CUTS)
    { const int cuts[] = {0, MK_CUTS, NPHASES}; const int nc = (int)(sizeof(cuts) / sizeof(int));
      for (int i = 0; i + 1 < nc; ++i) { a.ph_lo = cuts[i]; a.ph_hi = cuts[i + 1]; a.bli = i; hipLaunchKernelGGL(fwd, dim3(grid), dim3(NTHR), LDS_BYTES, stream, a); } }
#elif MK_ONE_LAUNCH
    a.ph_lo = 0; a.ph_hi = NPHASES;
    hipLaunchKernelGGL(fwd, dim3(grid), dim3(NTHR), LDS_BYTES, stream, a);
#else
    for (int p = 0; p < NPHASES; ++p) { a.ph_lo = p; a.ph_hi = p + 1; hipLaunchKernelGGL(fwd, dim3(grid), dim3(NTHR), LDS_BYTES, stream, a); }
#endif
}
```
